# Optimizing an MI355X kernel written in HIP

```python
import jax, jax.numpy as jnp
from jax import lax
import numpy as np

D_MODEL = 1024
BATCH = 4
SEQ = 8192
DEPTH = 1
DEC_BATCH = 4
DEC_SEQ = 4096
PAST_LEN = 128

GRID_W = 64
N_HEADS = 8
N_KV_HEADS = 2
HEAD_DIM = 64
ATTN_WIDTH = N_HEADS * HEAD_DIM
KV_WIDTH = N_KV_HEADS * HEAD_DIM
POOL_WINDOWS = (2, 4, 8, 16)
POOL_GROUPS = len(POOL_WINDOWS)
POOL_WIDTH = D_MODEL // 2
POOL_GROUP_WIDTH = POOL_WIDTH // POOL_GROUPS
D_FF = 2816
PLE_DIM = 256
Q_BLOCK = 128
ROPE_THETA = 10000.0
EPS = 1e-6
SPLITS = (ATTN_WIDTH,
          ATTN_WIDTH + KV_WIDTH,
          ATTN_WIDTH + 2 * KV_WIDTH,
          ATTN_WIDTH + 2 * KV_WIDTH + POOL_WIDTH,
          ATTN_WIDTH + 2 * KV_WIDTH + POOL_WIDTH + D_MODEL)
IN_WIDTH = ATTN_WIDTH + 2 * KV_WIDTH + POOL_WIDTH + 2 * D_MODEL

kernel_name = 'hybrid_gqa_axial_rope_multiscale_pool_macaron_encoder'


def rmsnorm(x, g):
    xf = x.astype(jnp.float32)
    y = xf * lax.rsqrt(jnp.mean(xf * xf, axis=-1, keepdims=True) + EPS)
    return (y * g.astype(jnp.float32)).astype(x.dtype)


def swiglu(x, w_gate, w_up, w_down):
    return (jax.nn.silu(x @ w_gate) * (x @ w_up)) @ w_down


def axial_rope_tables(T):
    rows = T // GRID_W
    row = jnp.repeat(jnp.arange(rows, dtype=jnp.float32), GRID_W)
    col = jnp.broadcast_to(jnp.arange(GRID_W, dtype=jnp.float32)[None, :], (rows, GRID_W)).reshape(-1)
    half = HEAD_DIM // 2
    inv = ROPE_THETA ** (-jnp.arange(0, half, 2, dtype=jnp.float32) / half)
    ang = jnp.stack([row[:, None] * inv, col[:, None] * inv], axis=1)
    return jnp.cos(ang), jnp.sin(ang)


def apply_rope(x, cos, sin):
    B, T, H, _ = x.shape
    xr = x.reshape(B, T, H, 2, 2, HEAD_DIM // 4)
    x1 = xr[..., 0, :]
    x2 = xr[..., 1, :]
    c = cos[None, :, None].astype(x.dtype)
    s = sin[None, :, None].astype(x.dtype)
    out = jnp.stack([x1 * c - x2 * s, x2 * c + x1 * s], axis=-2)
    return out.reshape(B, T, H, HEAD_DIM)


def blocked_gqa(q, k, v):
    B, T = q.shape[:2]
    nblk = T // Q_BLOCK
    G = N_HEADS // N_KV_HEADS
    qb = q.reshape(B, nblk, Q_BLOCK, N_KV_HEADS, G, HEAD_DIM).swapaxes(0, 1)
    scale = HEAD_DIM ** -0.5

    def block(qi):
        s = jnp.einsum('bqkgd,bskd->bkgqs', qi, k).astype(jnp.float32) * scale
        p = jax.nn.softmax(s, axis=-1).astype(v.dtype)
        return jnp.einsum('bkgqs,bskd->bqkgd', p, v)

    o = lax.map(block, qb)
    return o.swapaxes(0, 1).reshape(B, T, ATTN_WIDTH)


def centred_mean_minus_self(z, w):
    T = z.shape[1]
    left = w // 2
    right = w - 1 - left
    zf = z.astype(jnp.float32)
    csum = jnp.concatenate([jnp.zeros_like(zf[:, :1]), jnp.cumsum(zf, axis=1)], axis=1)
    t = jnp.arange(T)
    lo = jnp.maximum(t - left, 0)
    hi = jnp.minimum(t + right, T - 1)
    total = jnp.take(csum, hi + 1, axis=1) - jnp.take(csum, lo, axis=1)
    cnt = (hi - lo + 1).astype(jnp.float32)[None, :, None]
    return (total / cnt - zf).astype(z.dtype)


def multiscale_pool(z, pool_w, pool_scale):
    B, T = z.shape[:2]
    zg = z.reshape(B, T, POOL_GROUPS, POOL_GROUP_WIDTH)
    pooled = jnp.stack([centred_mean_minus_self(zg[:, :, g], POOL_WINDOWS[g]) for g in range(POOL_GROUPS)], axis=2)
    mixed = jnp.einsum('btgc,gcd->btgd', pooled, pool_w).reshape(B, T, POOL_WIDTH)
    return mixed * pool_scale


def encoder_layer(x, p, ffn1_norm, ffn1_w_gate, ffn1_w_up, ffn1_w_down, mix_norm, w_in, q_norm, k_norm,
                  w_up_attn, pool_w, pool_scale, w_up_pool, w_out, ffn2_norm, ffn2_w_gate, ffn2_w_up,
                  ffn2_w_down, ple_gate_norm, w_ple_gate, w_ple_proj, ple_post_norm):
    B, T = x.shape[:2]
    h = x + 0.5 * swiglu(rmsnorm(x, ffn1_norm), ffn1_w_gate, ffn1_w_up, ffn1_w_down)
    u = rmsnorm(h, mix_norm)
    proj = u @ w_in
    q, k, v, z, ga, gb = jnp.split(proj, SPLITS, axis=-1)
    q = rmsnorm(q.reshape(B, T, N_HEADS, HEAD_DIM), q_norm)
    k = rmsnorm(k.reshape(B, T, N_KV_HEADS, HEAD_DIM), k_norm)
    v = v.reshape(B, T, N_KV_HEADS, HEAD_DIM)
    cos, sin = axial_rope_tables(T)
    q = apply_rope(q, cos, sin)
    k = apply_rope(k, cos, sin)
    a = blocked_gqa(q, k, v) @ w_up_attn
    b = multiscale_pool(z, pool_w, pool_scale) @ w_up_pool
    m = jax.nn.sigmoid(ga) * a + jax.nn.sigmoid(gb) * b
    h = h + m @ w_out
    h = h + 0.5 * swiglu(rmsnorm(h, ffn2_norm), ffn2_w_gate, ffn2_w_up, ffn2_w_down)
    gate = jax.nn.sigmoid(rmsnorm(h, ple_gate_norm) @ w_ple_gate)
    e = rmsnorm(p @ w_ple_proj, ple_post_norm)
    return h + gate * e


def setup_inputs(seed: int = 0) -> dict:
    key = jax.random.key(seed)
    ks = jax.random.split(key, 32)
    f32 = jnp.float32

    def nrm(k, shape, fan_in):
        return jax.random.normal(k, shape, f32) * (fan_in ** -0.5)

    def gain(k, shape):
        return 1.0 + 0.05 * jax.random.normal(k, shape, f32)

    L = DEPTH
    return {
        'x_prompt': jax.random.normal(ks[0], (BATCH, SEQ, D_MODEL), f32),
        'x_sample': jax.random.normal(ks[1], (DEC_BATCH, DEC_SEQ, D_MODEL), f32),
        'p_prompt': jax.random.normal(ks[2], (DEPTH, BATCH, SEQ, PLE_DIM), f32),
        'p_sample': jax.random.normal(ks[3], (DEPTH, DEC_BATCH, DEC_SEQ, PLE_DIM), f32),
        'ffn1_norm': gain(ks[4], (L, D_MODEL)),
        'ffn1_w_gate': nrm(ks[5], (L, D_MODEL, D_FF), D_MODEL),
        'ffn1_w_up': nrm(ks[6], (L, D_MODEL, D_FF), D_MODEL),
        'ffn1_w_down': nrm(ks[7], (L, D_FF, D_MODEL), D_FF),
        'mix_norm': gain(ks[8], (L, D_MODEL)),
        'w_in': nrm(ks[9], (L, D_MODEL, IN_WIDTH), D_MODEL),
        'q_norm': gain(ks[10], (L, HEAD_DIM)),
        'k_norm': gain(ks[11], (L, HEAD_DIM)),
        'w_up_attn': nrm(ks[12], (L, ATTN_WIDTH, D_MODEL), ATTN_WIDTH),
        'pool_w': nrm(ks[13], (L, POOL_GROUPS, POOL_GROUP_WIDTH, POOL_GROUP_WIDTH), POOL_GROUP_WIDTH),
        'pool_scale': 1.0 + 0.1 * jax.random.normal(ks[14], (L, POOL_WIDTH), f32),
        'w_up_pool': nrm(ks[15], (L, POOL_WIDTH, D_MODEL), POOL_WIDTH),
        'w_out': nrm(ks[16], (L, D_MODEL, D_MODEL), D_MODEL),
        'ffn2_norm': gain(ks[17], (L, D_MODEL)),
        'ffn2_w_gate': nrm(ks[18], (L, D_MODEL, D_FF), D_MODEL),
        'ffn2_w_up': nrm(ks[19], (L, D_MODEL, D_FF), D_MODEL),
        'ffn2_w_down': nrm(ks[20], (L, D_FF, D_MODEL), D_FF),
        'ple_gate_norm': gain(ks[21], (L, D_MODEL)),
        'w_ple_gate': nrm(ks[22], (L, D_MODEL, D_MODEL), D_MODEL),
        'w_ple_proj': nrm(ks[23], (L, PLE_DIM, D_MODEL), PLE_DIM),
        'ple_post_norm': gain(ks[24], (L, D_MODEL)),
    }


def reference(x_prompt, x_sample, p_prompt, p_sample, ffn1_norm, ffn1_w_gate, ffn1_w_up, ffn1_w_down,
              mix_norm, w_in, q_norm, k_norm, w_up_attn, pool_w, pool_scale, w_up_pool, w_out,
              ffn2_norm, ffn2_w_gate, ffn2_w_up, ffn2_w_down, ple_gate_norm, w_ple_gate, w_ple_proj,
              ple_post_norm):
    weights = (ffn1_norm, ffn1_w_gate, ffn1_w_up, ffn1_w_down, mix_norm, w_in, q_norm, k_norm,
               w_up_attn, pool_w, pool_scale, w_up_pool, w_out, ffn2_norm, ffn2_w_gate, ffn2_w_up,
               ffn2_w_down, ple_gate_norm, w_ple_gate, w_ple_proj, ple_post_norm)

    def trunk(x, p):
        h = x
        for i in range(DEPTH):
            h = encoder_layer(h, p[i], *[w[i] for w in weights])
        return h

    y_prompt = trunk(x_prompt, p_prompt)
    y_sample = trunk(x_sample, p_sample)
    return (y_prompt, y_sample)
```

```cpp
#include <hip/hip_runtime.h>
#include <hip/hip_cooperative_groups.h>
#include <hip/hip_bf16.h>
#include <cstdio>
#include <cstdint>
#include <cmath>
namespace cg = cooperative_groups;

constexpr int DMODEL = 1024, MP = 4 * 8192, MS = 4 * 4096, MTOT = MP + MS;
constexpr int DFF = 2816, INW = 3328, PLE = 256;
constexpr float EPSN = 1e-6f;
constexpr size_t HK = 512u * 1024u;
constexpr size_t WS_GQK = 1 * HK;
constexpr size_t WS_SS = 2 * HK, WS_SSE = 8 * HK;
constexpr size_t WS_W1 = 16 * HK, WS_WD1 = 38 * HK, WS_WIN = 49 * HK, WS_WUA = 62 * HK, WS_WPC = 64 * HK, WS_WOUT = 66 * HK, WS_W2 = 70 * HK, WS_WD2 = 92 * HK, WS_WPG = 103 * HK, WS_WPP = 107 * HK;
constexpr size_t WS_HB = 112 * HK;
constexpr size_t WS_ACT = 304 * HK;
constexpr size_t WS_QO = WS_ACT, WS_Z = WS_ACT + 96 * HK, WS_PL = WS_ACT + 192 * HK, WS_MX = WS_ACT + 288 * HK, WS_K = WS_ACT + 480 * HK, WS_V = WS_ACT + 504 * HK, WS_PB = WS_K;
constexpr size_t WS_SGB = 832 * HK, WS_E = WS_SGB, WS_END = 1024 * HK;
static_assert(WS_WPP + 1024 * 256 * 2 <= WS_HB && WS_HB + (size_t)MTOT * 1024 * 2 <= WS_ACT && WS_ACT + (size_t)MTOT * DFF * 2 <= WS_SGB && WS_V + (size_t)MTOT * 128 * 2 <= WS_SGB && WS_SGB + (size_t)MTOT * 1024 * 2 <= WS_END, "d_ws map");
static_assert(WS_W1 + 5632 * 1024 * 2 <= WS_WD1 && WS_WD1 + 1024 * 2816 * 2 <= WS_WIN && WS_WIN + 3328 * 1024 * 2 <= WS_WUA && WS_W2 + 5632 * 1024 * 2 <= WS_WD2 && WS_WD2 + 1024 * 2816 * 2 <= WS_WPG && WS_WPG + 1024 * 1024 * 2 <= WS_WPP, "weights map");


namespace pg8 {
#define PG8_LAS __attribute__((address_space(3)))
typedef unsigned short bf16_t;
typedef short bf16x8 __attribute__((ext_vector_type(8)));
typedef float f32x4 __attribute__((ext_vector_type(4)));
typedef unsigned u32x4 __attribute__((ext_vector_type(4)));
constexpr int BM = 256, BK = 64, HALF = 128, HTB = HALF * BK * 2  , STAGE_BYTES = 8 * HTB, NXCD = 8, WGM = 8;

__host__ __device__ __forceinline__ int lds_byte(int r, int c) { const int st = (r >> 4) * 2 + (c >> 5), rr = r & 15, cc = c & 31, ob = rr * 64 + cc * 2; return st * 1024 + (ob ^ (((ob >> 9) & 1) << 5)); }
__host__ __device__ __forceinline__ void stage_rc(int b, int& R, int& C) { const int st = b / 1024, sb = b % 1024, swz = sb ^ (((sb >> 9) & 1) << 5); R = (st >> 1) * 16 + swz / 64; C = (st & 1) * 32 + (swz % 64) / 2; }
__host__ __device__ __forceinline__ int perm32(int rho) { const int n = rho >> 4, i = rho & 15; return 8 * (i >> 2) + 4 * n + (i & 3); }

struct Unit { int pm, pn; };
struct Gemm { const bf16_t* A; const bf16_t* Bt; int M, N, K; };

struct StaticOrder {
    int nM, nN, nwg, G, c;
    __host__ __device__ void init(int M, int N, int G_, int c_) { nM = M / BM; nN = N / BM; nwg = nM * nN; G = G_; c = c_; }
    __host__ __device__ bool next(int i, Unit& u) const {
        const long L = (long)i * G + c; if (L >= nwg) return false;
        int wgid = (int)L; { const int q = nwg / NXCD, r = nwg % NXCD, xcd = wgid % NXCD, off = wgid / NXCD; wgid = (xcd < r ? xcd * (q + 1) : r * (q + 1) + (xcd - r) * q) + off; }
        const int nig = WGM * nN, gid = wgid / nig, fm = gid * WGM, gsz = (nM - fm) < WGM ? (nM - fm) : WGM;
        u.pm = fm + ((wgid % nig) % gsz); u.pn = (wgid % nig) / gsz; return true;
    }
    __device__ __forceinline__ void a_ready(const Unit&) const {}
    __device__ __forceinline__ void done(const Unit&) const {}
};
__device__ __forceinline__ unsigned cvt_pk_bf16(float lo, float hi) { unsigned r; asm volatile("v_cvt_pk_bf16_f32 %0, %1, %2" : "=v"(r) : "v"(lo), "v"(hi)); return r; }
typedef unsigned u32x2 __attribute__((ext_vector_type(2)));
__device__ __forceinline__ float bf_lo(unsigned w) { return __uint_as_float(w << 16); }
__device__ __forceinline__ float bf_hi(unsigned w) { return __uint_as_float(w & 0xffff0000u); }
__device__ __forceinline__ float sigm(float x) { return __builtin_amdgcn_rcpf(1.0f + __builtin_amdgcn_exp2f(-1.4426950408889634f * x)); }
__device__ __forceinline__ float row_rstd(const float* ss, int row) {
    const f32x4* p = (const f32x4*)(ss + (size_t)row * 16);
    const f32x4 a = p[0], b = p[1], c = p[2], d = p[3];
    const float s = (((a.x + a.y) + (a.z + a.w)) + ((b.x + b.y) + (b.z + b.w))) + (((c.x + c.y) + (c.z + c.w)) + ((d.x + d.y) + (d.z + d.w)));
    return rsqrtf(s * (1.0f / 1024.0f) + EPSN);
}

template <bool ROWSCALE> struct EpiGateUp {
    static constexpr bool PERM = true, AFTER_DRAIN = false;
    bf16_t* O; int ldc; const float* ss;
    __device__ __forceinline__ void operator()(const f32x4 (&acc)[2][2][4][2], const Unit& u, int wr, int wc, int fr, int fq) const {
        const int row0 = u.pm * BM + wr * 64 + fr, col0 = u.pn * HALF + wc * 32 + 8 * fq;
#pragma unroll
        for (int ai = 0; ai < 2; ++ai)
#pragma unroll
            for (int m = 0; m < 4; ++m) { const int row = row0 + ai * HALF + m * 16; const float rs = ROWSCALE ? row_rstd(ss, row) : 1.0f;
                float o[8];
#pragma unroll
                for (int n = 0; n < 2; ++n)
#pragma unroll
                    for (int e = 0; e < 4; ++e) { const float g = acc[ai][0][m][n][e] * rs, up = acc[ai][1][m][n][e] * rs; o[n * 4 + e] = g * sigm(g) * up; }
                u32x4 w; w.x = cvt_pk_bf16(o[0], o[1]); w.y = cvt_pk_bf16(o[2], o[3]); w.z = cvt_pk_bf16(o[4], o[5]); w.w = cvt_pk_bf16(o[6], o[7]);
                *(u32x4*)(O + (size_t)row * ldc + col0) = w; asm volatile("" ::: "memory"); __builtin_amdgcn_sched_barrier(0); }
    }
};

struct EpiResid {
    static constexpr bool PERM = false, AFTER_DRAIN = false;
    const float* base0; const float* base1; float* out; bf16_t* hb; const float* gn; float* ss; float alpha;
    __device__ __forceinline__ void operator()(const f32x4 (&acc)[2][2][4][2], const Unit& u, int wr, int wc, int fr, int fq) const {
        const int row0 = u.pm * BM + wr * 64 + fr, col0 = u.pn * BM + wc * 32 + 4 * fq;
        f32x4 gv[2][2];
#pragma unroll
        for (int bj = 0; bj < 2; ++bj)
#pragma unroll
            for (int n = 0; n < 2; ++n) gv[bj][n] = *(const f32x4*)(gn + col0 + bj * HALF + n * 16);
#pragma unroll
        for (int ai = 0; ai < 2; ++ai)
#pragma unroll
            for (int m = 0; m < 4; ++m) { const int row = row0 + ai * HALF + m * 16;
                const float* bp = (row < MP ? base0 + (size_t)row * DMODEL : base1 + (size_t)(row - MP) * DMODEL) + col0;
                const size_t off = (size_t)row * DMODEL + col0; float s = 0.f;
#pragma unroll
                for (int bj = 0; bj < 2; ++bj)
#pragma unroll
                    for (int n = 0; n < 2; ++n) { const f32x4 b = *(const f32x4*)(bp + bj * HALF + n * 16); const f32x4 v = b + acc[ai][bj][m][n] * alpha;
                        *(f32x4*)(out + off + bj * HALF + n * 16) = v; s += (v.x * v.x + v.y * v.y) + (v.z * v.z + v.w * v.w);
                        const f32x4 h = v * gv[bj][n]; u32x2 w; w.x = cvt_pk_bf16(h.x, h.y); w.y = cvt_pk_bf16(h.z, h.w); *(u32x2*)(hb + off + bj * HALF + n * 16) = w; }
                s += __shfl_xor(s, 16); s += __shfl_xor(s, 32);
                if (fq == 0) ss[(size_t)row * 16 + u.pn * 4 + wc] = s;
                asm volatile("" ::: "memory"); __builtin_amdgcn_sched_barrier(0); }
    }
};

struct EpiWin {
    static constexpr bool PERM = false, AFTER_DRAIN = false;
    const float* ss; const float* gqk; unsigned char* ws; float qscale;
    __device__ __forceinline__ void operator()(const f32x4 (&acc)[2][2][4][2], const Unit& u, int wr, int wc, int fr, int fq) const {
        const int row0 = u.pm * BM + wr * 64 + fr;
        const int pn = u.pn;
        const bool is_rope = (pn < 2) || (pn == 2 && wc < 2);
        if (is_rope) {
            const float* g = gqk + ((pn < 2) ? 0 : 64); const float osc = (pn < 2) ? qscale : 1.0f;
            bf16_t* dst = (bf16_t*)(ws + ((pn < 2) ? (WS_QO + (size_t)(pn * 4 + wc) * 128) : (WS_K + (size_t)wc * 128))); const int ld = (pn < 2) ? 512 : 128;
            float inv[4];
#pragma unroll
            for (int e = 0; e < 4; ++e) inv[e] = __builtin_amdgcn_exp2f(-(float)(4 * fq + e) * 0.8304820237218406f);
#pragma unroll
            for (int m = 0; m < 4; ++m)
#pragma unroll
                for (int ai = 0; ai < 2; ++ai) { const int row = row0 + ai * HALF + m * 16; const float rs = row_rstd(ss, row);
                    int t = row < MP ? (row & 8191) : ((row - MP) & 4095); asm volatile("" : "+v"(t));
                    float s = 0.f;
#pragma unroll
                    for (int bj = 0; bj < 2; ++bj)
#pragma unroll
                        for (int n = 0; n < 2; ++n) { const f32x4 a = acc[ai][bj][m][n]; s += (a.x * a.x + a.y * a.y) + (a.z * a.z + a.w * a.w); }
                    s += __shfl_xor(s, 16); s += __shfl_xor(s, 32);
                    s *= rs * rs;
                    const float r = rsqrtf(s * (1.0f / 64.0f) + EPSN) * rs * osc;
#pragma unroll
                    for (int bj = 0; bj < 2; ++bj) { const float pos = (float)(bj == 0 ? (t >> 6) : (t & 63));
                        const f32x4 x1 = acc[ai][bj][m][0] * r * *(const f32x4*)(g + bj * 32 + 4 * fq), x2 = acc[ai][bj][m][1] * r * *(const f32x4*)(g + bj * 32 + 16 + 4 * fq); f32x4 o1, o2;
#pragma unroll
                        for (int e = 0; e < 4; ++e) { const float ang = pos * inv[e]; const float c = __cosf(ang), sn = __sinf(ang); o1[e] = x1[e] * c - x2[e] * sn; o2[e] = x2[e] * c + x1[e] * sn; }
                        u32x2 w1, w2; w1.x = cvt_pk_bf16(o1.x, o1.y); w1.y = cvt_pk_bf16(o1.z, o1.w); w2.x = cvt_pk_bf16(o2.x, o2.y); w2.y = cvt_pk_bf16(o2.z, o2.w);
                        bf16_t* p = dst + (size_t)row * ld + bj * 32 + 4 * fq; *(u32x2*)p = w1; *(u32x2*)(p + 16) = w2; }
                    asm volatile("" ::: "memory"); __builtin_amdgcn_sched_barrier(0); }
        } else if (pn == 2) {
            bf16_t* dst = (bf16_t*)(ws + WS_V) + (wc - 2) * 64 + 4 * fq;
#pragma unroll
            for (int ai = 0; ai < 2; ++ai)
#pragma unroll
                for (int m = 0; m < 4; ++m) { const int row = row0 + ai * HALF + m * 16; const float rs = row_rstd(ss, row);
#pragma unroll
                    for (int bj = 0; bj < 2; ++bj)
#pragma unroll
                        for (int n = 0; n < 2; ++n) { const f32x4 v = acc[ai][bj][m][n] * rs; u32x2 w; w.x = cvt_pk_bf16(v.x, v.y); w.y = cvt_pk_bf16(v.z, v.w); *(u32x2*)(dst + (size_t)row * 128 + bj * 32 + n * 16) = w; }
                    asm volatile("" ::: "memory"); __builtin_amdgcn_sched_barrier(0); }
        } else {
            const bool sg = pn >= 5; const int ld = sg ? 1024 : 512; const int ct = pn < 5 ? pn - 3 : (pn < 9 ? pn - 5 : pn - 9);
            bf16_t* dst = (bf16_t*)(ws + (pn < 5 ? WS_Z : (pn < 9 ? WS_MX : WS_SGB))) + ct * 256 + wc * 32 + 4 * fq;
#pragma unroll
            for (int ai = 0; ai < 2; ++ai)
#pragma unroll
                for (int m = 0; m < 4; ++m) { const int row = row0 + ai * HALF + m * 16; const float rs = row_rstd(ss, row);
#pragma unroll
                    for (int bj = 0; bj < 2; ++bj)
#pragma unroll
                        for (int n = 0; n < 2; ++n) { f32x4 v = acc[ai][bj][m][n] * rs; if (sg) { v.x = sigm(v.x); v.y = sigm(v.y); v.z = sigm(v.z); v.w = sigm(v.w); }
                            u32x2 w; w.x = cvt_pk_bf16(v.x, v.y); w.y = cvt_pk_bf16(v.z, v.w); *(u32x2*)(dst + (size_t)row * ld + bj * HALF + n * 16) = w; }
                    asm volatile("" ::: "memory"); __builtin_amdgcn_sched_barrier(0); }
        }
    }
};

template <int PASS> struct EpiGateMix {
    static constexpr bool PERM = true, AFTER_DRAIN = false;
    bf16_t* Mx; const bf16_t* SGB;
    __device__ __forceinline__ void operator()(const f32x4 (&acc)[2][2][4][2], const Unit& u, int wr, int wc, int fr, int fq) const {
        const int row0 = u.pm * BM + wr * 64 + fr, col0 = u.pn * BM + wc * 32 + 8 * fq;
#pragma unroll
        for (int ai = 0; ai < 2; ++ai)
#pragma unroll
            for (int m = 0; m < 4; ++m) { const size_t off = (size_t)(row0 + ai * HALF + m * 16) * DMODEL + col0;
#pragma unroll
                for (int bj = 0; bj < 2; ++bj) { const u32x4 a = *(const u32x4*)(Mx + off + bj * HALF); const f32x4 c0 = acc[ai][bj][m][0], c1 = acc[ai][bj][m][1]; float o[8];
                    if (PASS == 0) { o[0] = bf_lo(a.x) * c0.x; o[1] = bf_hi(a.x) * c0.y; o[2] = bf_lo(a.y) * c0.z; o[3] = bf_hi(a.y) * c0.w; o[4] = bf_lo(a.z) * c1.x; o[5] = bf_hi(a.z) * c1.y; o[6] = bf_lo(a.w) * c1.z; o[7] = bf_hi(a.w) * c1.w; }
                    else { const u32x4 g = *(const u32x4*)(SGB + off + bj * HALF);
                        o[0] = bf_lo(a.x) + bf_lo(g.x) * c0.x; o[1] = bf_hi(a.x) + bf_hi(g.x) * c0.y; o[2] = bf_lo(a.y) + bf_lo(g.y) * c0.z; o[3] = bf_hi(a.y) + bf_hi(g.y) * c0.w;
                        o[4] = bf_lo(a.z) + bf_lo(g.z) * c1.x; o[5] = bf_hi(a.z) + bf_hi(g.z) * c1.y; o[6] = bf_lo(a.w) + bf_lo(g.w) * c1.z; o[7] = bf_hi(a.w) + bf_hi(g.w) * c1.w; }
                    u32x4 w; w.x = cvt_pk_bf16(o[0], o[1]); w.y = cvt_pk_bf16(o[2], o[3]); w.z = cvt_pk_bf16(o[4], o[5]); w.w = cvt_pk_bf16(o[6], o[7]);
                    *(u32x4*)(Mx + off + bj * HALF) = w; } }
    }
};

struct EpiE {
    static constexpr bool PERM = true, AFTER_DRAIN = false;
    bf16_t* E; float* ss;
    __device__ __forceinline__ void operator()(const f32x4 (&acc)[2][2][4][2], const Unit& u, int wr, int wc, int fr, int fq) const {
        const int row0 = u.pm * BM + wr * 64 + fr, col0 = u.pn * BM + wc * 32 + 8 * fq;
#pragma unroll
        for (int ai = 0; ai < 2; ++ai)
#pragma unroll
            for (int m = 0; m < 4; ++m) { const int row = row0 + ai * HALF + m * 16; float s = 0.f;
#pragma unroll
                for (int bj = 0; bj < 2; ++bj) { const f32x4 c0 = acc[ai][bj][m][0], c1 = acc[ai][bj][m][1];
                    s += ((c0.x * c0.x + c0.y * c0.y) + (c0.z * c0.z + c0.w * c0.w)) + ((c1.x * c1.x + c1.y * c1.y) + (c1.z * c1.z + c1.w * c1.w));
                    u32x4 w; w.x = cvt_pk_bf16(c0.x, c0.y); w.y = cvt_pk_bf16(c0.z, c0.w); w.z = cvt_pk_bf16(c1.x, c1.y); w.w = cvt_pk_bf16(c1.z, c1.w);
                    *(u32x4*)(E + (size_t)row * DMODEL + col0 + bj * HALF) = w; }
                s += __shfl_xor(s, 16); s += __shfl_xor(s, 32);
                if (fq == 0) ss[(size_t)row * 16 + u.pn * 4 + wc] = s; }
    }
};

struct EpiFinal {
    static constexpr bool PERM = false, AFTER_DRAIN = false;
    float* out; const bf16_t* E; const float* ss; const float* sse; const float* gpost;
    __device__ __forceinline__ void operator()(const f32x4 (&acc)[2][2][4][2], const Unit& u, int wr, int wc, int fr, int fq) const {
        const int row0 = u.pm * BM + wr * 64 + fr, col0 = u.pn * BM + wc * 32 + 4 * fq;
        f32x4 gv[2][2];
#pragma unroll
        for (int bj = 0; bj < 2; ++bj)
#pragma unroll
            for (int n = 0; n < 2; ++n) gv[bj][n] = *(const f32x4*)(gpost + col0 + bj * HALF + n * 16);
#pragma unroll
        for (int ai = 0; ai < 2; ++ai)
#pragma unroll
            for (int m = 0; m < 4; ++m) { const int row = row0 + ai * HALF + m * 16; const float rs = row_rstd(ss, row), re = row_rstd(sse, row);
                const size_t off = (size_t)row * DMODEL + col0;
#pragma unroll
                for (int bj = 0; bj < 2; ++bj)
#pragma unroll
                    for (int n = 0; n < 2; ++n) { const f32x4 h = *(const f32x4*)(out + off + bj * HALF + n * 16); const u32x2 ew = *(const u32x2*)(E + off + bj * HALF + n * 16);
                        const f32x4 a = acc[ai][bj][m][n] * rs; f32x4 ev; ev.x = bf_lo(ew.x); ev.y = bf_hi(ew.x); ev.z = bf_lo(ew.y); ev.w = bf_hi(ew.y); ev = ev * re * gv[bj][n];
                        f32x4 y; y.x = h.x + sigm(a.x) * ev.x; y.y = h.y + sigm(a.y) * ev.y; y.z = h.z + sigm(a.z) * ev.z; y.w = h.w + sigm(a.w) * ev.w;
                        *(f32x4*)(out + off + bj * HALF + n * 16) = y; }
                asm volatile("" ::: "memory"); __builtin_amdgcn_sched_barrier(0); }
    }
};

template <class Epi, class Sched, bool ALIGN_EPI = false, bool SP2 = false>
__device__ __forceinline__ void gemm_phase(PG8_LAS unsigned char* lds, const Gemm g, const Sched& S, const Epi& E) {
    int tid = threadIdx.x; asm volatile("" : "+v"(tid));
    const int wid = __builtin_amdgcn_readfirstlane(tid >> 6), lane = tid & 63, wr = wid >> 2, wc = wid & 3, fr = lane & 15, fq = lane >> 4;
    const int K = g.K, nt = K / BK;
    unsigned voffA[2], voffB[2];
#pragma unroll
    for (int i = 0; i < 2; ++i) { int R, C; stage_rc(tid * 16 + i * 8192, R, C); const int Rb = Epi::PERM ? ((R & ~31) + perm32(R & 31)) : R;
        voffA[i] = (unsigned)(R * K + C) * 2u; voffB[i] = (unsigned)(Rb * K + C) * 2u; }
    const size_t kstep = (size_t)(BK * 2);
    const size_t hstep = (size_t)HALF * K * 2;
    const size_t tstep = 2 * hstep;
    const unsigned ldsw = (unsigned)wid * 1024u;
    const int aoff = lds_byte(wr * 64 + fr, fq * 8), boff = lds_byte(wc * 32 + fr, fq * 8);
#define PG8_SA(b, h) (((b) * 2 + (h)) * HTB)
#define PG8_SB(b, h) ((4 + (b) * 2 + (h)) * HTB)
#define PG8_STAGE(bufoff, gbase, voff) do { _Pragma("unroll") for (int _i = 0; _i < 2; ++_i) \
        __builtin_amdgcn_global_load_lds((const unsigned*)((const char*)(gbase) + (voff)[_i]), (PG8_LAS unsigned*)(lds + (bufoff) + ldsw + _i * 8192), 16, 0, 0); } while (0)
#define PG8_LDA(dst, b, h) do { _Pragma("unroll") for (int m = 0; m < 4; ++m) _Pragma("unroll") for (int k = 0; k < 2; ++k) dst[m][k] = *(const PG8_LAS bf16x8*)(lds + PG8_SA(b, h) + aoff + m * 2048 + k * 1024); } while (0)
#define PG8_LDB(dst, b, h) do { _Pragma("unroll") for (int n = 0; n < 2; ++n) _Pragma("unroll") for (int k = 0; k < 2; ++k) dst[n][k] = *(const PG8_LAS bf16x8*)(lds + PG8_SB(b, h) + boff + n * 2048 + k * 1024); } while (0)
#define PG8_MMA(ai, bj, At, Bt) do { __builtin_amdgcn_s_setprio(1); _Pragma("unroll") for (int m = 0; m < 4; ++m) _Pragma("unroll") for (int n = 0; n < 2; ++n) _Pragma("unroll") for (int k = 0; k < 2; ++k) \
        acc[ai][bj][m][n] = __builtin_amdgcn_mfma_f32_16x16x32_bf16(Bt[n][k], At[m][k], acc[ai][bj][m][n], 0, 0, 0); __builtin_amdgcn_s_setprio(0); } while (0)
#define PG8_WAIT_V(n) asm volatile("s_waitcnt vmcnt(" #n ")" ::: "memory")
#define PG8_WAIT_L(n) asm volatile("s_waitcnt lgkmcnt(" #n ")" ::: "memory")
#define PG8_BAR __builtin_amdgcn_s_barrier()
#define PG8_SCHED __builtin_amdgcn_sched_barrier(0)
    Unit cur, nxt; int ui = 0;
    if (!S.next(0, cur)) return;
    f32x4 acc[2][2][4][2];
#pragma unroll
    for (int a = 0; a < 2; ++a)
#pragma unroll
        for (int b = 0; b < 2; ++b)
#pragma unroll
            for (int m = 0; m < 4; ++m)
#pragma unroll
                for (int n = 0; n < 2; ++n) acc[a][b][m][n] = (f32x4){0.f, 0.f, 0.f, 0.f};
    bf16x8 At[4][2], B0[2][2], B1[2][2];
    const char* cA = (const char*)g.A + (size_t)cur.pm * tstep; const char* cB = (const char*)g.Bt + (size_t)cur.pn * tstep;
    S.a_ready(cur);
    if constexpr (SP2) {
        PG8_STAGE(PG8_SB(0, 0), cB, voffB); PG8_STAGE(PG8_SB(0, 1), cB + hstep, voffB); PG8_STAGE(PG8_SA(0, 0), cA, voffA); PG8_STAGE(PG8_SA(0, 1), cA + hstep, voffA);
        if (wr == 1) PG8_BAR;
        PG8_WAIT_V(2); PG8_BAR;
        PG8_STAGE(PG8_SB(1, 0), cB + kstep, voffB); PG8_STAGE(PG8_SA(1, 0), cA + kstep, voffA); PG8_STAGE(PG8_SB(1, 1), cB + hstep + kstep, voffB);
        PG8_WAIT_V(6); PG8_BAR;
    } else {
        PG8_STAGE(PG8_SB(0, 0), cB, voffB); PG8_STAGE(PG8_SA(0, 0), cA, voffA); PG8_STAGE(PG8_SB(0, 1), cB + hstep, voffB); PG8_STAGE(PG8_SA(0, 1), cA + hstep, voffA);
        if (wr == 1) PG8_BAR;
        PG8_WAIT_V(4); PG8_BAR;
        PG8_STAGE(PG8_SB(1, 0), cB + kstep, voffB); PG8_STAGE(PG8_SA(1, 0), cA + kstep, voffA); PG8_STAGE(PG8_SB(1, 1), cB + hstep + kstep, voffB);
        PG8_WAIT_V(6); PG8_BAR;
    }
    for (;;) {
        const bool has_next = S.next(ui + 1, nxt);
        const char* nA = has_next ? (const char*)g.A + (size_t)nxt.pm * tstep : cA; const char* nB = has_next ? (const char*)g.Bt + (size_t)nxt.pn * tstep : cB;
        for (int t = 0; t < nt; t += 2) {
            const bool last = (t == nt - 2);
            const char* a1 = cA + (size_t)(t + 1) * kstep;
            const char* a2 = last ? nA : cA + (size_t)(t + 2) * kstep; const char* b2 = last ? nB : cB + (size_t)(t + 2) * kstep;
            const char* a3 = a2 + kstep; const char* b3 = b2 + kstep;
            if (last && has_next) S.a_ready(nxt);
            if constexpr (SP2) {
            PG8_LDB(B0, 0, 0); PG8_LDB(B1, 0, 1); PG8_SCHED; PG8_LDA(At, 0, 0); PG8_STAGE(PG8_SA(1, 1), a1 + hstep, voffA);
            PG8_WAIT_V(8); PG8_WAIT_L(0); PG8_BAR; PG8_MMA(0, 0, At, B0); PG8_MMA(0, 1, At, B1); PG8_BAR; PG8_SCHED;
            PG8_LDA(At, 0, 1); PG8_STAGE(PG8_SB(0, 0), b2, voffB); PG8_STAGE(PG8_SB(0, 1), b2 + hstep, voffB); PG8_STAGE(PG8_SA(0, 0), a2, voffA);
            PG8_WAIT_V(8); PG8_WAIT_L(0); PG8_BAR; PG8_MMA(1, 0, At, B0); PG8_MMA(1, 1, At, B1); PG8_BAR; PG8_SCHED;
            PG8_LDB(B0, 1, 0); PG8_LDB(B1, 1, 1); PG8_SCHED; PG8_LDA(At, 1, 0); PG8_STAGE(PG8_SA(0, 1), a2 + hstep, voffA);
            PG8_WAIT_V(8); PG8_WAIT_L(0); PG8_BAR; PG8_MMA(0, 0, At, B0); PG8_MMA(0, 1, At, B1); PG8_BAR; PG8_SCHED;
            PG8_LDA(At, 1, 1); PG8_STAGE(PG8_SB(1, 0), b3, voffB); PG8_STAGE(PG8_SB(1, 1), b3 + hstep, voffB); PG8_STAGE(PG8_SA(1, 0), a3, voffA);
            PG8_WAIT_V(8); PG8_WAIT_L(0); PG8_BAR; PG8_MMA(1, 0, At, B0); PG8_MMA(1, 1, At, B1); PG8_BAR; PG8_SCHED;
            } else {
            PG8_LDB(B0, 0, 0); PG8_SCHED; PG8_LDA(At, 0, 0); PG8_STAGE(PG8_SA(1, 1), a1 + hstep, voffA);
            PG8_WAIT_L(8); PG8_BAR; PG8_WAIT_L(0); PG8_MMA(0, 0, At, B0); PG8_BAR; PG8_SCHED;
            PG8_LDB(B1, 0, 1); PG8_STAGE(PG8_SB(0, 0), b2, voffB);
            PG8_BAR; PG8_WAIT_L(0); PG8_MMA(0, 1, At, B1); PG8_BAR;
            PG8_LDA(At, 0, 1); PG8_STAGE(PG8_SA(0, 0), a2, voffA);
            PG8_BAR; PG8_WAIT_L(0); PG8_MMA(1, 0, At, B0); PG8_BAR; PG8_SCHED;
            PG8_STAGE(PG8_SB(0, 1), b2 + hstep, voffB);
            PG8_WAIT_V(6); PG8_BAR; PG8_MMA(1, 1, At, B1); PG8_BAR;
            PG8_LDB(B0, 1, 0); PG8_SCHED; PG8_LDA(At, 1, 0); PG8_STAGE(PG8_SA(0, 1), a2 + hstep, voffA);
            PG8_WAIT_L(8); PG8_BAR; PG8_WAIT_L(0); PG8_MMA(0, 0, At, B0); PG8_BAR; PG8_SCHED;
            PG8_LDB(B1, 1, 1); PG8_STAGE(PG8_SB(1, 0), b3, voffB);
            PG8_BAR; PG8_WAIT_L(0); PG8_MMA(0, 1, At, B1); PG8_BAR;
            PG8_LDA(At, 1, 1); PG8_STAGE(PG8_SA(1, 0), a3, voffA);
            PG8_BAR; PG8_WAIT_L(0); PG8_MMA(1, 0, At, B0); PG8_BAR; PG8_SCHED;
            PG8_STAGE(PG8_SB(1, 1), b3 + hstep, voffB);
            PG8_WAIT_V(6); PG8_BAR; PG8_MMA(1, 1, At, B1); PG8_BAR;
            }
        }
        if constexpr (ALIGN_EPI) { if (wr == 0) PG8_BAR; }
        if constexpr (!Epi::AFTER_DRAIN) { E(acc, cur, wr, wc, fr, fq); S.done(cur); }
        if (!has_next) break;
#pragma unroll
        for (int a = 0; a < 2; ++a)
#pragma unroll
            for (int b = 0; b < 2; ++b)
#pragma unroll
                for (int m = 0; m < 4; ++m)
#pragma unroll
                    for (int n = 0; n < 2; ++n) acc[a][b][m][n] = (f32x4){0.f, 0.f, 0.f, 0.f};
        cur = nxt; cA = nA; cB = nB; ++ui;
        if constexpr (ALIGN_EPI) { if (wr == 1) PG8_BAR; }
    }
    PG8_WAIT_V(0);
    if constexpr (!ALIGN_EPI) { if (wr == 0) PG8_BAR; }
    PG8_BAR;
    if constexpr (Epi::AFTER_DRAIN) { E.fused(acc, cur, wr, wc, fr, fq, lds, wid, lane); S.done(cur); }
#undef PG8_SA
#undef PG8_SB
#undef PG8_STAGE
#undef PG8_LDA
#undef PG8_LDB
#undef PG8_MMA
#undef PG8_WAIT_V
#undef PG8_WAIT_L
#undef PG8_BAR
#undef PG8_SCHED
}
}
#include <hip/hip_bf16.h>
#include <cmath>
namespace attn_body {
using bf16=__hip_bfloat16;
using bf16x8=__attribute__((ext_vector_type(8)))short;
using s16x4=__attribute__((ext_vector_type(4)))short;
using f32x16=__attribute__((ext_vector_type(16)))float;
using u32x4=__attribute__((ext_vector_type(4)))unsigned;
constexpr int D=64,QP=512,KP=128;
constexpr int NW=8,QBLK=32,QB=QBLK*NW,KVBLK=64;
constexpr int ATTN_UNIT_ROWS=QB;
__device__ __forceinline__ int crow(int r,int hi){return (r&3)+8*(r>>2)+4*hi;}
#define SBAR() __builtin_amdgcn_sched_barrier(0)
__device__ __forceinline__ void cmask(f32x16&p0,f32x16&p1,int jb,int qrel,int hi){
  const float NEG=-INFINITY; int kb=64*jb+4*hi;
  #pragma unroll
  for(int r=0;r<16;++r){int kv=kb+(r&3)+8*(r>>2); if(kv>qrel)p0[r]=NEG; if(kv+32>qrel)p1[r]=NEG;}
}

constexpr int NSLOT=3, SLOTB=8192;
constexpr int LDS_K=0, LDS_V=NSLOT*SLOTB, LDS_WS=2*NSLOT*SLOTB, LDS_OST=LDS_WS+NW*64*4, LDS_BYTES=LDS_OST+NW*4096;
constexpr float C2=0.125f*1.4426950408889634f;
__device__ __forceinline__ void glds16(const void*gsrc,unsigned lds_dst){unsigned keep;
  asm volatile("s_mov_b32 %0, m0\n\ts_mov_b32 m0, %2\n\ts_nop 0\n\tglobal_load_lds_dwordx4 %1, off\n\ts_mov_b32 m0, %0":"=&s"(keep):"v"(gsrc),"s"(lds_dst):"memory");}
__device__ __forceinline__ float max3f(float a,float b,float c){float r;asm("v_max3_f32 %0, %1, %2, %3":"=v"(r):"v"(a),"v"(b),"v"(c));return r;}
__device__ __forceinline__ float max2f(float a,float b){float r;asm("v_max_f32_e32 %0, %1, %2":"=v"(r):"v"(a),"v"(b));return r;}
__device__ __forceinline__ float fadd_s(float a,float b){float r;asm("v_add_f32_e32 %0, %1, %2":"=v"(r):"v"(a),"v"(b));return r;}
__device__ __forceinline__ float fsub_s(float a,float b){float r;asm("v_sub_f32_e32 %0, %1, %2":"=v"(r):"v"(a),"v"(b));return r;}
typedef float f32x2_t __attribute__((ext_vector_type(2))); typedef __bf16 bf16x2_t __attribute__((ext_vector_type(2)));
__device__ __forceinline__ unsigned cvtpk_s(float lo,float hi){f32x2_t v={lo,hi};bf16x2_t b=__builtin_convertvector(v,bf16x2_t);return __builtin_bit_cast(unsigned,b);}
#define WAIT_BAR(N) asm volatile("s_waitcnt vmcnt(" #N ") lgkmcnt(0)\n\ts_barrier":::"memory")

__device__ __forceinline__ void qkt(f32x16&p0,f32x16&p1,const char*Kslot,const bf16x8*qr,const f32x16&negm,int r32,int hi){
  const char*kb=Kslot+hi*1024+r32*16;
  #pragma unroll
  for(int d0=0;d0<4;++d0){
    const bf16x8 b0=*reinterpret_cast<const bf16x8*>(kb+d0*2048);
    const bf16x8 b1=*reinterpret_cast<const bf16x8*>(kb+d0*2048+512);
    if(d0==0){p0=__builtin_amdgcn_mfma_f32_32x32x16_bf16(b0,qr[0],negm,0,0,0);p1=__builtin_amdgcn_mfma_f32_32x32x16_bf16(b1,qr[0],negm,0,0,0);}
    else{p0=__builtin_amdgcn_mfma_f32_32x32x16_bf16(b0,qr[d0],p0,0,0,0);p1=__builtin_amdgcn_mfma_f32_32x32x16_bf16(b1,qr[d0],p1,0,0,0);}}
}
typedef __attribute__((address_space(3))) const char* lds_cptr;
typedef short v4i16_t __attribute__((ext_vector_type(4)));
__device__ __forceinline__ void kload8(bf16x8*kf,lds_cptr kp){
  kf[0]=*(const __attribute__((address_space(3))) bf16x8*)(kp);      kf[1]=*(const __attribute__((address_space(3))) bf16x8*)(kp+512);
  kf[2]=*(const __attribute__((address_space(3))) bf16x8*)(kp+2048); kf[3]=*(const __attribute__((address_space(3))) bf16x8*)(kp+2560);
  kf[4]=*(const __attribute__((address_space(3))) bf16x8*)(kp+4096); kf[5]=*(const __attribute__((address_space(3))) bf16x8*)(kp+4608);
  kf[6]=*(const __attribute__((address_space(3))) bf16x8*)(kp+6144); kf[7]=*(const __attribute__((address_space(3))) bf16x8*)(kp+6656);
}
__device__ __forceinline__ void kload2(bf16x8*kf,lds_cptr kp,int j){ kf[2*j]=*(const __attribute__((address_space(3))) bf16x8*)(kp+j*2048); kf[2*j+1]=*(const __attribute__((address_space(3))) bf16x8*)(kp+j*2048+512); }
__device__ __forceinline__ s16x4 vtr(lds_cptr p){ return __builtin_bit_cast(s16x4,__builtin_amdgcn_ds_read_tr16_b64_v4i16((__attribute__((address_space(3))) v4i16_t*)p)); }
__device__ __forceinline__ float rowmax(const f32x16&p0,const f32x16&p1){
  float a=max3f(p0[0],p0[1],p1[0]),b=max3f(p0[2],p0[3],p1[1]);a=max3f(a,p1[2],p1[3]);
  #pragma unroll
  for(int r=4;r<16;r+=4){a=max3f(a,p0[r],p0[r+1]);b=max3f(b,p0[r+2],p0[r+3]);a=max3f(a,p1[r],p1[r+1]);b=max3f(b,p1[r+2],p1[r+3]);}
  const float m=max2f(a,b);
  auto rr=__builtin_amdgcn_permlane32_swap(__float_as_uint(m),__float_as_uint(m),false,false);
  return max2f(__uint_as_float(rr[0]),__uint_as_float(rr[1]));
}
__device__ __forceinline__ void pv(f32x16*o,int vb,bf16x8 pa0,bf16x8 pa1,bf16x8 pa2,bf16x8 pa3){
  #pragma unroll
  for(int d0=0;d0<2;++d0){s16x4 lo[4],hi[4];
    #pragma unroll
    for(int ks=0;ks<4;++ks){
      asm volatile("ds_read_b64_tr_b16 %0,%1 offset:%c2":"=&v"(lo[ks]):"v"(vb),"i"(d0*4096+ks*1024):"memory");
      asm volatile("ds_read_b64_tr_b16 %0,%1 offset:%c2":"=&v"(hi[ks]):"v"(vb),"i"(d0*4096+ks*1024+512):"memory");}
    asm volatile("s_waitcnt lgkmcnt(0)":::"memory");SBAR();
    #define PK(k) (bf16x8){lo[k][0],lo[k][1],lo[k][2],lo[k][3],hi[k][0],hi[k][1],hi[k][2],hi[k][3]}
    o[d0]=__builtin_amdgcn_mfma_f32_32x32x16_bf16(pa0,PK(0),o[d0],0,0,0);
    o[d0]=__builtin_amdgcn_mfma_f32_32x32x16_bf16(pa1,PK(1),o[d0],0,0,0);
    o[d0]=__builtin_amdgcn_mfma_f32_32x32x16_bf16(pa2,PK(2),o[d0],0,0,0);
    o[d0]=__builtin_amdgcn_mfma_f32_32x32x16_bf16(pa3,PK(3),o[d0],0,0,0);
    #undef PK
  }
}

#ifndef ATTN_STORE16
#define ATTN_STORE16(p,v) (*(u32x4*)(p)=(v))
#endif
template<int THRL> __device__ __forceinline__ void attn_unit(long rowbase,int h,int qb,int NT,const bf16*Q,const bf16*__restrict__ K,const bf16*__restrict__ V,bf16*O,char*shm){
  int tid=threadIdx.x; asm volatile("":"+v"(tid)); const int lane=tid&63,r32=lane&31,hi=lane>>5; const int wid=__builtin_amdgcn_readfirstlane(tid>>6);
  const int q0=qb*QB;
  const bf16*Qw=Q+(rowbase+q0+wid*QBLK)*QP+h*D;
  const bf16*Kh=K+rowbase*KP+(h>>2)*D,*Vh=V+rowbase*KP+(h>>2)*D;
  const unsigned lds0=(unsigned)(uintptr_t)shm;
  float*wsf=(float*)(shm+LDS_WS)+wid*64;
  const bf16*ksrc=Kh+(long)lane*KP+wid*8;
  const bf16*vsrc=Vh+(long)(16*(wid&3)+(lane>>2))*KP+(wid>>2)*32+(lane&3)*8;
  const unsigned kdst=lds0+LDS_K+wid*1024, vdst=lds0+LDS_V+wid*1024;
  #define DMA_K(t,slot) glds16(ksrc+(long)(t)*KVBLK*KP,(unsigned)__builtin_amdgcn_readfirstlane(kdst+(slot)))
  #define DMA_V(t,slot) glds16(vsrc+(long)(t)*KVBLK*KP,(unsigned)__builtin_amdgcn_readfirstlane(vdst+(slot)))
  const int vb0=(int)(lds0+LDS_V)+((lane>>4)&1)*32+(lane&3)*8+(4*hi+((lane&15)>>2))*64;
  const char*Kbase=shm+LDS_K; bf16x8 kf[8];
  const lds_cptr shm3=(lds_cptr)shm; const lds_cptr kp0=shm3+LDS_K+hi*1024+r32*16; const lds_cptr vp0=shm3+LDS_V+((lane>>4)&1)*32+(lane&3)*8+(4*hi+((lane&15)>>2))*64;
  DMA_K(0,0);DMA_V(0,0);DMA_K(1,SLOTB);
  bf16x8 qr[4];
  #pragma unroll
  for(int d0=0;d0<4;++d0)qr[d0]=*reinterpret_cast<const bf16x8*>(&Qw[(long)r32*QP+d0*16+hi*8]);
  float mhat=0.f,l_reg=0.f;f32x16 o[2];o[0]=f32x16{};o[1]=f32x16{};f32x16 negm=f32x16{};asm volatile("":"+v"(negm));
    #define CMASK(P0,P1,t) do{}while(0)
  bool resc=false;
  #define START(P0,P1) do{ const float rm=rowmax(P0,P1); resc=false; \
    { const float dl=rm; mhat=fadd_s(mhat,dl); \
      _Pragma("unroll") for(int r=0;r<16;++r){P0[r]=fsub_s(P0[r],dl);P1[r]=fsub_s(P1[r],dl);} \
      _Pragma("unroll") for(int r=0;r<16;++r)negm[r]=-mhat; asm volatile("":"+v"(negm)); } \
    _Pragma("unroll") for(int r=0;r<16;++r)P0[r]=__builtin_amdgcn_exp2f(P0[r]); }while(0)
  #define RESC() do{ if(resc){ asm volatile("s_waitcnt lgkmcnt(0)":::"memory"); \
      _Pragma("unroll") for(int d_=0;d_<2;++d_) _Pragma("unroll") for(int r=0;r<16;++r)o[d_][r]*=wsf[crow(r,hi)]; } }while(0)
  f32x16 pA0,pA1,pB0,pB1;
  int sl_prev=0,sl_cur=0,sl_next=SLOTB;
  #define ROT() do{sl_prev=sl_cur;sl_cur=sl_next;sl_next=(sl_next==(NSLOT-1)*SLOTB)?0:sl_next+SLOTB;}while(0)
  DMA_K(2,2*SLOTB);
  WAIT_BAR(3);
  qkt(pA0,pA1,Kbase,qr,negm,r32,hi);asm volatile("s_nop 15\n\ts_nop 7":"+v"(pA0),"+v"(pA1));CMASK(pA0,pA1,0);
  START(pA0,pA1);
  _Pragma("unroll") for(int r=0;r<16;++r)pA1[r]=__builtin_amdgcn_exp2f(pA1[r]);
  WAIT_BAR(0);
  DMA_K(3,0);DMA_V(1,SLOTB);
  ROT();
  kload8(kf,kp0+sl_cur);
  WAIT_BAR(2);
  s16x4 vlo[8],vhi[8]; u32x4 pw0,pw1,pw2,pw3;
  #define PKW(P,B) cvtpk_s(P[B],P[B+1])
  #define PAF(k) __builtin_bit_cast(bf16x8,pw##k)
  #define VFR(i) (bf16x8){vlo[i][0],vlo[i][1],vlo[i][2],vlo[i][3],vhi[i][0],vhi[i][1],vhi[i][2],vhi[i][3]}
  #define PIN(x) asm volatile("":"+v"(x))
  #define MX3(a,b,c) __builtin_fmaxf(__builtin_fmaxf((a),(b)),(c))
  #define GAPA(MF,A0,A1,A2,A3,W0,W1,PW) do{ MF; sacc+=A0; sacc+=A1; sacc+=A2; sacc+=A3; PIN(sacc); W0; W1; PIN(PW); SBAR(); }while(0)
  #define EX(v) __builtin_amdgcn_exp2f(v)
  #define GAPB(MF,X,B) do{ MF; X[B]=EX(X[B]); X[B+1]=EX(X[B+1]); X[B+2]=EX(X[B+2]); X[B+3]=EX(X[B+3]); PIN(X); SBAR(); }while(0)
  #define VRD(i) do{ vlo[i]=vtr(vp_+(((i)>>2)*4096+((i)&3)*1024)); vhi[i]=vtr(vp_+(((i)>>2)*4096+((i)&3)*1024+512)); }while(0)
  #define KRD(G,j) do{ if(G){ kload2(kf,kp0+sl_next,j); SBAR(); } }while(0)
  #define STEP(C0,C1,P0,P1,t,GK,GV,GL) do{ SBAR(); \
    const lds_cptr vp_=vp0+sl_prev; \
    VRD(0); SBAR(); float sacc=(P0[0]+P0[1]); \
    GAPA(C0=__builtin_amdgcn_mfma_f32_32x32x16_bf16(kf[0],qr[0],negm,0,0,0), P0[2],P0[3],P0[4],P0[5],     pw0[0]=PKW(P0,0), pw0[1]=PKW(P0,2), pw0); \
    VRD(4); SBAR(); GAPA(C1=__builtin_amdgcn_mfma_f32_32x32x16_bf16(kf[1],qr[0],negm,0,0,0), P0[6],P0[7],P0[8],P0[9],     pw0[2]=PKW(P0,4), pw0[3]=PKW(P0,6), pw0); \
    VRD(1); SBAR(); GAPA(C0=__builtin_amdgcn_mfma_f32_32x32x16_bf16(kf[2],qr[1],C0,0,0,0),   P0[10],P0[11],P0[12],P0[13], pw1[0]=PKW(P0,8), pw1[1]=PKW(P0,10), pw1); \
    VRD(5); SBAR(); GAPA(C1=__builtin_amdgcn_mfma_f32_32x32x16_bf16(kf[3],qr[1],C1,0,0,0),   P0[14],P0[15],P1[0],P1[1],   pw1[2]=PKW(P0,12),pw1[3]=PKW(P0,14), pw1); \
    VRD(2); SBAR(); GAPA(C0=__builtin_amdgcn_mfma_f32_32x32x16_bf16(kf[4],qr[2],C0,0,0,0),   P1[2],P1[3],P1[4],P1[5],     pw2[0]=PKW(P1,0), pw2[1]=PKW(P1,2), pw2); \
    VRD(6); SBAR(); GAPA(C1=__builtin_amdgcn_mfma_f32_32x32x16_bf16(kf[5],qr[2],C1,0,0,0),   P1[6],P1[7],P1[8],P1[9],     pw2[2]=PKW(P1,4), pw2[3]=PKW(P1,6), pw2); \
    VRD(3); SBAR(); GAPA(C0=__builtin_amdgcn_mfma_f32_32x32x16_bf16(kf[6],qr[3],C0,0,0,0),   P1[10],P1[11],P1[12],P1[13], pw3[0]=PKW(P1,8), pw3[1]=PKW(P1,10), pw3); \
    VRD(7); SBAR(); GAPA(C1=__builtin_amdgcn_mfma_f32_32x32x16_bf16(kf[7],qr[3],C1,0,0,0),   P1[14],P1[15],0.f,0.f,       pw3[2]=PKW(P1,12),pw3[3]=PKW(P1,14), pw3); \
    l_reg+=sacc; \
    if(GK){DMA_K((t)+3,sl_cur);} if(GV){DMA_V((t)+1,sl_next);} \
    CMASK(C0,C1,t); \
    { float a=MX3(C0[0],C0[1],C1[0]),b=MX3(C0[2],C0[3],C1[1]); a=MX3(a,C1[2],C1[3]); \
      _Pragma("unroll") for(int r=4;r<16;r+=4){a=MX3(a,C0[r],C0[r+1]);b=MX3(b,C0[r+2],C0[r+3]);a=MX3(a,C1[r],C1[r+1]);b=MX3(b,C1[r+2],C1[r+3]);} \
      float rm=__builtin_fmaxf(a,b); { auto rr=__builtin_amdgcn_permlane32_swap(__float_as_uint(rm),__float_as_uint(rm),false,false); rm=__builtin_fmaxf(__uint_as_float(rr[0]),__uint_as_float(rr[1])); } \
      resc=false; \
      if(__builtin_expect(__any(rm>(float)THRL),0)){ const float dl=__builtin_fmaxf(rm,0.f); mhat+=dl; \
        _Pragma("unroll") for(int r=0;r<16;++r){C0[r]-=dl;C1[r]-=dl;} \
        _Pragma("unroll") for(int r=0;r<16;++r)negm[r]=-mhat; asm volatile("":"+v"(negm)); \
        const float f=__builtin_amdgcn_exp2f(-dl); l_reg*=f; if(hi==0)wsf[r32]=f; resc=true; } } \
    SBAR(); \
    GAPB(o[0]=__builtin_amdgcn_mfma_f32_32x32x16_bf16(PAF(0),VFR(0),o[0],0,0,0), C0,0); \
    GAPB(o[1]=__builtin_amdgcn_mfma_f32_32x32x16_bf16(PAF(0),VFR(4),o[1],0,0,0), C0,4); \
    KRD(GL,0); GAPB(o[0]=__builtin_amdgcn_mfma_f32_32x32x16_bf16(PAF(1),VFR(1),o[0],0,0,0), C0,8); \
    KRD(GL,1); GAPB(o[1]=__builtin_amdgcn_mfma_f32_32x32x16_bf16(PAF(1),VFR(5),o[1],0,0,0), C0,12); \
    KRD(GL,2); GAPB(o[0]=__builtin_amdgcn_mfma_f32_32x32x16_bf16(PAF(2),VFR(2),o[0],0,0,0), C1,0); \
    KRD(GL,3); GAPB(o[1]=__builtin_amdgcn_mfma_f32_32x32x16_bf16(PAF(2),VFR(6),o[1],0,0,0), C1,4); \
    GAPB(o[0]=__builtin_amdgcn_mfma_f32_32x32x16_bf16(PAF(3),VFR(3),o[0],0,0,0), C1,8); \
    GAPB(o[1]=__builtin_amdgcn_mfma_f32_32x32x16_bf16(PAF(3),VFR(7),o[1],0,0,0), C1,12); \
    }while(0)
  int t=1;
  #undef CMASK
  #define CMASK(P0,P1,t) do{}while(0)
  for(;t+5<NT;t+=2){
    STEP(pB0,pB1,pA0,pA1,t,true,true,true);     WAIT_BAR(2); RESC(); ROT();
    STEP(pA0,pA1,pB0,pB1,t+1,true,true,true);   WAIT_BAR(2); RESC(); ROT();
  }
  #undef CMASK
  #define CMASK(P0,P1,t) do{}while(0)
  #define ENDW(tt) do{ if((tt)+3<NT){WAIT_BAR(2);} else if((tt)+2<NT){WAIT_BAR(1);} else {WAIT_BAR(0);} }while(0)
  for(;t+1<NT;t+=2){
    STEP(pB0,pB1,pA0,pA1,t,(t+3<NT),(t+1<NT),(t+1<NT));       ENDW(t);   RESC(); ROT();
    STEP(pA0,pA1,pB0,pB1,t+1,(t+4<NT),(t+2<NT),(t+2<NT));     ENDW(t+1); RESC(); ROT();
  }
  STEP(pB0,pB1,pA0,pA1,NT-1,false,false,false); RESC();
  { float sacc=pB0[0]+pB0[1]; _Pragma("unroll") for(int r=2;r<16;++r)sacc+=pB0[r]; _Pragma("unroll") for(int r=0;r<16;++r)sacc+=pB1[r]; l_reg+=sacc;
    pw0=(u32x4){PKW(pB0,0),PKW(pB0,2),PKW(pB0,4),PKW(pB0,6)};pw1=(u32x4){PKW(pB0,8),PKW(pB0,10),PKW(pB0,12),PKW(pB0,14)};pw2=(u32x4){PKW(pB1,0),PKW(pB1,2),PKW(pB1,4),PKW(pB1,6)};pw3=(u32x4){PKW(pB1,8),PKW(pB1,10),PKW(pB1,12),PKW(pB1,14)};
    SBAR(); pv(o,vb0+sl_cur,PAF(0),PAF(1),PAF(2),PAF(3)); }
  #undef PKW
  #undef PAF
  #undef VFR
  #undef PIN
  #undef MX3
  #undef GAPA
  #undef GAPB
  #undef EX
  #undef VRD
  #undef KRD
  #undef STEP
  #undef ENDW
  {auto rr=__builtin_amdgcn_permlane32_swap(__float_as_uint(l_reg),__float_as_uint(l_reg),false,false);l_reg=__uint_as_float(rr[0])+__uint_as_float(rr[1]);}
  if(hi==0)wsf[32+r32]=l_reg;asm volatile("s_waitcnt lgkmcnt(0)":::"memory");
  float rli[16];
  #pragma unroll
  for(int r=0;r<16;++r)rli[r]=__builtin_amdgcn_rcpf(wsf[32+crow(r,hi)]);
  bf16*Ow=O+(rowbase+q0+wid*QBLK)*QP+h*D;
  { bf16*stg=(bf16*)(shm+LDS_OST)+wid*2048;
    #pragma unroll
    for(int r=0;r<16;++r){const int orow=crow(r,hi);
      #pragma unroll
      for(int d0=0;d0<2;++d0)stg[orow*64+d0*32+r32]=__float2bfloat16(o[d0][r]*rli[r]);}
    asm volatile("s_waitcnt lgkmcnt(0)":::"memory");
    #pragma unroll
    for(int i=0;i<4;++i){const int row=i*8+(lane>>3),ch=lane&7; const u32x4 v=*(const u32x4*)(stg+row*64+ch*8); ATTN_STORE16(Ow+(long)row*QP+ch*8,v);} }
  asm volatile("s_waitcnt lgkmcnt(0)\n\ts_barrier":::"memory");
  #undef DMA_K
  #undef DMA_V
  #undef CMASK
  #undef START
  #undef RESC
  #undef ROT
}
constexpr int ATTN_LDS_BYTES=LDS_BYTES;
struct AttnTensors { const bf16* Q; const bf16* K; const bf16* V; bf16* O; };
template<int THRL=8> __device__ __forceinline__ void attn_phase(char*lds,const AttnTensors&T,int vcu,int G){
  for(int i=0;;++i){
    int u;
    if(G==256){ if(i>=6)break; u=(i<4)?(4*vcu+i):(1024+2*vcu+(i-4)); }
    else{ u=vcu+i*G; if(u>=1536)break; }
    long rowbase; int h,qb,NT;
    if(u<1024){ const int bh=u>>5; qb=u&31; rowbase=(long)(bh>>3)*8192; h=bh&7; NT=128; }
    else { const int v=u-1024; const int bh=v>>4; qb=v&15; rowbase=32768+(long)(bh>>3)*4096; h=bh&7; NT=64; }
    attn_unit<THRL>(rowbase,h,qb,NT,T.Q,T.K,T.V,T.O,lds);
  }
}
#undef SBAR
#undef WAIT_BAR
}
#ifndef PH_MASK
#define PH_MASK 0x3ff
#endif
#define PH(k) if constexpr ((PH_MASK >> (k)) & 1)
constexpr int NWAVES = 8;
constexpr int RING_BYTES = 131072, LDS_BYTES = 147456;

#define LAS __attribute__((address_space(3)))
typedef unsigned short bf16;
typedef unsigned v4u __attribute__((ext_vector_type(4)));
typedef float f32x4 __attribute__((ext_vector_type(4)));
#define LDS_WAIT() asm volatile("s_waitcnt lgkmcnt(0)" ::: "memory")
__device__ __forceinline__ unsigned f2bf(float f) { unsigned u = __builtin_bit_cast(unsigned, f); return (u + 0x7fffu + ((u >> 16) & 1u)) >> 16; }
__device__ __forceinline__ unsigned pk2(float lo, float hi) { return f2bf(lo) | (f2bf(hi) << 16); }
__device__ __forceinline__ float wave_sum(float v) {
#pragma unroll
    for (int o = 1; o < 64; o <<= 1) v += __shfl_xor(v, o);
    return v;
}
__device__ __forceinline__ void transpose_item(const float* W, int ldw, int src_col0, int k0, bf16* WT, int K, int dst_row0, LAS float* scr, int lane) {
#pragma unroll 8
    for (int i = 0; i < 32; ++i) { const int kk = 2 * i + (lane >> 5); scr[kk * 33 + (lane & 31)] = W[(size_t)(k0 + kk) * ldw + src_col0 + (lane & 31)]; }
    LDS_WAIT(); asm volatile("" ::: "memory");
    const int c = lane & 7;
#pragma unroll
    for (int j = 0; j < 4; ++j) { const int n = (lane >> 3) + 8 * j; const LAS float* s = scr + (8 * c) * 33 + n;
        v4u o; o.x = pk2(s[0 * 33], s[1 * 33]); o.y = pk2(s[2 * 33], s[3 * 33]); o.z = pk2(s[4 * 33], s[5 * 33]); o.w = pk2(s[6 * 33], s[7 * 33]);
        *(v4u*)(WT + (size_t)(dst_row0 + n) * K + k0 + 8 * c) = o; }
    LDS_WAIT(); asm volatile("" ::: "memory");
}

struct Args { const float* in[25]; float* out; unsigned char* ws; };
static_assert(sizeof(Args) == 27 * 8, "Args has no padding");

__device__ __forceinline__ void gateup_items(int r, const float* Wg, const float* Wu, bf16* WT, LAS float* scr, int lane) {
    const int kb = r / 176, G = r % 176, tile = G >> 3, w = G & 7;
    transpose_item((w < 4) ? Wg : Wu, DFF, tile * 128 + (w & 3) * 32, kb * 64, WT, 1024, G * 32, scr, lane);
}

__global__ void __launch_bounds__(NWAVES * 64, 2) fwd_mega(Args args) {
    extern __shared__ __attribute__((aligned(16))) unsigned char lds[];
    cg::grid_group grid = cg::this_grid();
    const int tid = threadIdx.x, lane = tid & 63, wave = __builtin_amdgcn_readfirstlane(tid >> 6);
    const int G = gridDim.x, bx = blockIdx.x, vcu = (G % 8 == 0) ? (bx % 8) * (G / 8) + bx / 8 : bx;
    unsigned char* ws = args.ws;
    LAS unsigned char* ldsp = (LAS unsigned char*)lds;
    const float* x_p = args.in[0]; const float* x_s = args.in[1]; const float* p_p = args.in[2]; const float* p_s = args.in[3];
    float* out = args.out;
    float* SS = (float*)(ws + WS_SS); float* SSE = (float*)(ws + WS_SSE);
    bf16* W1 = (bf16*)(ws + WS_W1); bf16* WD1 = (bf16*)(ws + WS_WD1); bf16* WIN = (bf16*)(ws + WS_WIN); bf16* WUA = (bf16*)(ws + WS_WUA); bf16* WPC = (bf16*)(ws + WS_WPC);
    bf16* WOUT = (bf16*)(ws + WS_WOUT); bf16* W2 = (bf16*)(ws + WS_W2); bf16* WD2 = (bf16*)(ws + WS_WD2); bf16* WPG = (bf16*)(ws + WS_WPG); bf16* WPP = (bf16*)(ws + WS_WPP);
    bf16* HB = (bf16*)(ws + WS_HB); bf16* ACT = (bf16*)(ws + WS_ACT); bf16* QO = (bf16*)(ws + WS_QO); bf16* Zb = (bf16*)(ws + WS_Z); bf16* PL = (bf16*)(ws + WS_PL);
    bf16* MX = (bf16*)(ws + WS_MX); bf16* KB = (bf16*)(ws + WS_K); bf16* VB = (bf16*)(ws + WS_V); bf16* PB = (bf16*)(ws + WS_PB); bf16* SGB = (bf16*)(ws + WS_SGB); bf16* EB = (bf16*)(ws + WS_E);
    const int gw = vcu * NWAVES + wave, NGW = G * NWAVES;
    const int gt = bx * (NWAVES * 64) + tid, NGT = G * NWAVES * 64;

    PH(0) {
        LAS float* scr = (LAS float*)(ldsp + wave * 16384);
        constexpr int I1 = 16 * 176, I2 = 44 * 32, I3 = 16 * 104, I4 = 8 * 32, I6 = 16 * 32, I10 = 4 * 32;
        constexpr int NITEMS = 2 * I1 + 2 * I2 + I3 + I4 + 2 * I6 + I10;
        for (int it = gw; it < NITEMS; it += NGW) {
            int r = it;
            if (r < I1) { gateup_items(r, args.in[5], args.in[6], W1, scr, lane); continue; } r -= I1;
            if (r < I1) { gateup_items(r, args.in[18], args.in[19], W2, scr, lane); continue; } r -= I1;
            if (r < I2) { transpose_item(args.in[7], 1024, (r % 32) * 32, (r / 32) * 64, WD1, DFF, (r % 32) * 32, scr, lane); continue; } r -= I2;
            if (r < I2) { transpose_item(args.in[20], 1024, (r % 32) * 32, (r / 32) * 64, WD2, DFF, (r % 32) * 32, scr, lane); continue; } r -= I2;
            if (r < I3) { const int kb = r / 104, Gp = r % 104; const int c0 = Gp < 24 ? ((Gp >> 3) * 256 + (Gp & 3) * 64 + ((Gp >> 2) & 1) * 32) : Gp * 32;
                transpose_item(args.in[9], INW, c0, kb * 64, WIN, 1024, Gp * 32, scr, lane); continue; } r -= I3;
            if (r < I4) { transpose_item(args.in[12], 1024, (r % 32) * 32, (r / 32) * 64, WUA, 512, (r % 32) * 32, scr, lane); continue; } r -= I4;
            if (r < I6) { transpose_item(args.in[16], 1024, (r % 32) * 32, (r / 32) * 64, WOUT, 1024, (r % 32) * 32, scr, lane); continue; } r -= I6;
            if (r < I6) { transpose_item(args.in[22], 1024, (r % 32) * 32, (r / 32) * 64, WPG, 1024, (r % 32) * 32, scr, lane); continue; } r -= I6;
            transpose_item(args.in[23], 1024, (r % 32) * 32, (r / 32) * 64, WPP, PLE, (r % 32) * 32, scr, lane);
        }
        if (gt < 128) ((float*)(ws + WS_GQK))[gt] = gt < 64 ? args.in[10][gt] : args.in[11][gt - 64];
        { const float* pw = args.in[13]; const float* psc = args.in[14]; const float* wup = args.in[15];
          for (int idx = gt; idx < 512 * 1024; idx += NGT) { const int d = idx & 1023, c = idx >> 10, g0 = c & ~127; float a = 0.f;
              const float* pr = pw + (size_t)c * 128;
#pragma unroll 8
              for (int j = 0; j < 128; ++j) a += pr[j] * psc[g0 + j] * wup[(size_t)(g0 + j) * 1024 + d];
              WPC[(size_t)d * 512 + c] = (bf16)f2bf(a); } }
        { const float* g1 = args.in[4]; f32x4 gv[4];
#pragma unroll
          for (int j = 0; j < 4; ++j) gv[j] = ((const f32x4*)g1)[lane + 64 * j];
          for (int m = gw; m < MTOT; m += NGW) { const float* xr = m < MP ? x_p + (size_t)m * 1024 : x_s + (size_t)(m - MP) * 1024;
              f32x4 v[4]; float s = 0.f;
#pragma unroll
              for (int j = 0; j < 4; ++j) { v[j] = ((const f32x4*)xr)[lane + 64 * j]; s += (v[j].x * v[j].x + v[j].y * v[j].y) + (v[j].z * v[j].z + v[j].w * v[j].w); }
              const float rstd = rsqrtf(wave_sum(s) * (1.f / 1024.f) + EPSN);
              unsigned long long* o8 = (unsigned long long*)(HB + (size_t)m * 1024) + lane;
#pragma unroll
              for (int j = 0; j < 4; ++j) { const f32x4 y = v[j] * rstd * gv[j]; o8[64 * j] = (unsigned long long)pk2(y.x, y.y) | ((unsigned long long)pk2(y.z, y.w) << 32); } } }
    }
    grid.sync();

    PH(1) { pg8::Gemm g{HB, W1, MTOT, 2 * DFF, 1024}; pg8::StaticOrder S; S.init(MTOT, 2 * DFF, G, bx);
      pg8::EpiGateUp<false> E{ACT, DFF, nullptr};
      pg8::gemm_phase<pg8::EpiGateUp<false>, pg8::StaticOrder, true, true>(ldsp, g, S, E); }
    grid.sync();
    PH(2) { pg8::Gemm g{ACT, WD1, MTOT, 1024, DFF}; pg8::StaticOrder S; S.init(MTOT, 1024, G, bx);
      pg8::EpiResid E{x_p, x_s, out, HB, args.in[8], SS, 0.5f};
      pg8::gemm_phase<pg8::EpiResid, pg8::StaticOrder, true, true>(ldsp, g, S, E); }
    grid.sync();
    PH(3) { pg8::Gemm g{HB, WIN, MTOT, INW, 1024}; pg8::StaticOrder S; S.init(MTOT, INW, G, bx);
      pg8::EpiWin E{SS, (const float*)(ws + WS_GQK), ws, attn_body::C2};
      pg8::gemm_phase<pg8::EpiWin, pg8::StaticOrder, true, true>(ldsp, g, S, E); }
    grid.sync();
    PH(4) {
      for (int idx = gt; idx < MTOT * 64; idx += NGT) { const int row = idx >> 6, ch = idx & 63, grp = ch >> 4, w = 2 << grp, left = w >> 1, right = w - 1 - left;
          const int T = row < MP ? 8192 : 4096, t = row < MP ? (row & 8191) : ((row - MP) & 4095);
          const int lo = (t - left) > 0 ? (t - left) : 0, hi = (t + right) < (T - 1) ? (t + right) : (T - 1);
          const bf16* zp = Zb + (size_t)(row - t) * 512 + ch * 8; float a[8];
#pragma unroll
          for (int e = 0; e < 8; ++e) a[e] = 0.f;
          for (int tt = lo; tt <= hi; ++tt) { const v4u q = *(const v4u*)(zp + (size_t)tt * 512);
              a[0] += pg8::bf_lo(q.x); a[1] += pg8::bf_hi(q.x); a[2] += pg8::bf_lo(q.y); a[3] += pg8::bf_hi(q.y); a[4] += pg8::bf_lo(q.z); a[5] += pg8::bf_hi(q.z); a[6] += pg8::bf_lo(q.w); a[7] += pg8::bf_hi(q.w); }
          const v4u q = *(const v4u*)(zp + (size_t)t * 512); const float ic = 1.0f / (float)(hi - lo + 1);
          v4u o; o.x = pk2(a[0] * ic - pg8::bf_lo(q.x), a[1] * ic - pg8::bf_hi(q.x)); o.y = pk2(a[2] * ic - pg8::bf_lo(q.y), a[3] * ic - pg8::bf_hi(q.y));
          o.z = pk2(a[4] * ic - pg8::bf_lo(q.z), a[5] * ic - pg8::bf_hi(q.z)); o.w = pk2(a[6] * ic - pg8::bf_lo(q.w), a[7] * ic - pg8::bf_hi(q.w));
          *(v4u*)(PL + (size_t)row * 512 + ch * 8) = o; }
      asm volatile("s_waitcnt vmcnt(0)" ::: "memory"); __syncthreads();
      const attn_body::AttnTensors AT{(const attn_body::bf16*)QO, (const attn_body::bf16*)KB, (const attn_body::bf16*)VB, (attn_body::bf16*)QO};
      attn_body::attn_phase<8>((char*)lds, AT, vcu, G); }
    grid.sync();
    PH(5) { for (int idx = gt; idx < MTOT * 32; idx += NGT) { const int row = idx >> 5, ch = idx & 31; const float* pr = (row < MP ? p_p + (size_t)row * PLE : p_s + (size_t)(row - MP) * PLE) + ch * 8;
          const f32x4 a = *(const f32x4*)pr, b = *(const f32x4*)(pr + 4); v4u o; o.x = pk2(a.x, a.y); o.y = pk2(a.z, a.w); o.z = pk2(b.x, b.y); o.w = pk2(b.z, b.w);
          *(v4u*)(PB + (size_t)row * PLE + ch * 8) = o; }
      asm volatile("s_waitcnt vmcnt(0)" ::: "memory"); __syncthreads();
      pg8::StaticOrder S; S.init(MTOT, 1024, G, bx);
      { pg8::Gemm g{QO, WUA, MTOT, 1024, 512}; pg8::EpiGateMix<0> E{MX, SGB}; pg8::gemm_phase<pg8::EpiGateMix<0>, pg8::StaticOrder, true, true>(ldsp, g, S, E); }
      asm volatile("s_waitcnt vmcnt(0)" ::: "memory"); __syncthreads();
      { pg8::Gemm g{PL, WPC, MTOT, 1024, 512}; pg8::EpiGateMix<1> E{MX, SGB}; pg8::gemm_phase<pg8::EpiGateMix<1>, pg8::StaticOrder, true, true>(ldsp, g, S, E); } }
    grid.sync();
    PH(6) { pg8::StaticOrder S; S.init(MTOT, 1024, G, bx);
      { pg8::Gemm g{MX, WOUT, MTOT, 1024, 1024}; pg8::EpiResid E{out, out + (size_t)MP * 1024, out, HB, args.in[17], SS, 1.0f}; pg8::gemm_phase<pg8::EpiResid, pg8::StaticOrder, true, true>(ldsp, g, S, E); }
      asm volatile("s_waitcnt vmcnt(0)" ::: "memory"); __syncthreads();
      { pg8::Gemm g{PB, WPP, MTOT, 1024, PLE}; pg8::EpiE E{EB, SSE}; pg8::gemm_phase<pg8::EpiE, pg8::StaticOrder, true, true>(ldsp, g, S, E); } }
    grid.sync();
    PH(7) { pg8::Gemm g{HB, W2, MTOT, 2 * DFF, 1024}; pg8::StaticOrder S; S.init(MTOT, 2 * DFF, G, bx);
      pg8::EpiGateUp<true> E{ACT, DFF, SS};
      pg8::gemm_phase<pg8::EpiGateUp<true>, pg8::StaticOrder, true, true>(ldsp, g, S, E); }
    grid.sync();
    PH(8) { pg8::Gemm g{ACT, WD2, MTOT, 1024, DFF}; pg8::StaticOrder S; S.init(MTOT, 1024, G, bx);
      pg8::EpiResid E{out, out + (size_t)MP * 1024, out, HB, args.in[21], SS, 0.5f};
      pg8::gemm_phase<pg8::EpiResid, pg8::StaticOrder, true, true>(ldsp, g, S, E); }
    grid.sync();
    PH(9) { pg8::Gemm g{HB, WPG, MTOT, 1024, 1024}; pg8::StaticOrder S; S.init(MTOT, 1024, G, bx);
      pg8::EpiFinal E{out, EB, SS, SSE, args.in[24]};
      pg8::gemm_phase<pg8::EpiFinal, pg8::StaticOrder, true, true>(ldsp, g, S, E); }
}

extern "C" void kernel_launch(void* const* d_in, const int* in_sizes, int n_in, void* d_out, int out_size, void* d_ws, size_t ws_size, hipStream_t stream) {
    static int grid = 0;
    if (grid == 0) {
        if (n_in != 25 || out_size != MTOT * 1024 || ws_size < WS_END) { fprintf(stderr, "kernel_launch: unexpected problem (n_in %d, out %d, ws %zu); nothing launched\n", n_in, out_size, ws_size); grid = -1; return; }
        int dev = 0, cus = 0, per_cu = 0;
        if (hipGetDevice(&dev) != hipSuccess || hipDeviceGetAttribute(&cus, hipDeviceAttributeMultiprocessorCount, dev) != hipSuccess) { grid = -1; return; }
        if (hipFuncSetAttribute((const void*)fwd_mega, hipFuncAttributeMaxDynamicSharedMemorySize, LDS_BYTES) != hipSuccess) { fprintf(stderr, "kernel_launch: hipFuncSetAttribute failed\n"); grid = -1; return; }
        if (hipOccupancyMaxActiveBlocksPerMultiprocessor(&per_cu, (const void*)fwd_mega, NWAVES * 64, LDS_BYTES) != hipSuccess || per_cu < 1) { fprintf(stderr, "kernel_launch: occupancy query says %d blocks per CU\n", per_cu); (void)hipGetLastError(); }
        grid = cus;
    }
    if (grid < 0) return;
    Args a{};
    for (int i = 0; i < 25; ++i) a.in[i] = (const float*)d_in[i];
    a.out = (float*)d_out; a.ws = (unsigned char*)d_ws;
    void* kargs[] = {&a};
    const hipError_t e = hipLaunchCooperativeKernel((const void*)fwd_mega, dim3(grid), dim3(NWAVES * 64), kargs, LDS_BYTES, stream);
    if (e != hipSuccess) fprintf(stderr, "kernel_launch: cooperative launch failed: %s (grid %d)\n", hipGetErrorString(e), grid);
}
```

```cpp
#include <hip/hip_runtime.h>
#include <hip/hip_cooperative_groups.h>
#include <hip/hip_bf16.h>
#include <cstdio>
#include <cstdint>
#include <cmath>
namespace cg = cooperative_groups;

constexpr int DMODEL = 1024, MP = 4 * 8192, MS = 4 * 4096, MTOT = MP + MS;
constexpr int DFF = 2816, INW = 3328, PLE = 256;
constexpr float EPSN = 1e-6f;
constexpr size_t HK = 512u * 1024u;
constexpr size_t WS_GQK = 1 * HK;
constexpr size_t WS_SS = 2 * HK, WS_SSE = 8 * HK;
constexpr size_t WS_W1 = 16 * HK, WS_WD1 = 38 * HK, WS_WIN = 49 * HK, WS_WUA = 62 * HK, WS_WPC = 64 * HK, WS_WOUT = 66 * HK, WS_W2 = 70 * HK, WS_WD2 = 92 * HK, WS_WPG = 103 * HK, WS_WPP = 107 * HK;
constexpr size_t WS_HB = 112 * HK;
constexpr size_t WS_ACT = 304 * HK;
constexpr size_t WS_QO = WS_ACT, WS_Z = WS_ACT + 96 * HK, WS_PL = WS_ACT + 192 * HK, WS_MX = WS_ACT + 288 * HK, WS_K = WS_ACT + 480 * HK, WS_V = WS_ACT + 504 * HK, WS_PB = WS_K;
constexpr size_t WS_SGB = 832 * HK, WS_E = WS_SGB, WS_END = 1024 * HK;
static_assert(WS_WPP + 1024 * 256 * 2 <= WS_HB && WS_HB + (size_t)MTOT * 1024 * 2 <= WS_ACT && WS_ACT + (size_t)MTOT * DFF * 2 <= WS_SGB && WS_V + (size_t)MTOT * 128 * 2 <= WS_SGB && WS_SGB + (size_t)MTOT * 1024 * 2 <= WS_END, "d_ws map");
static_assert(WS_W1 + 5632 * 1024 * 2 <= WS_WD1 && WS_WD1 + 1024 * 2816 * 2 <= WS_WIN && WS_WIN + 3328 * 1024 * 2 <= WS_WUA && WS_W2 + 5632 * 1024 * 2 <= WS_WD2 && WS_WD2 + 1024 * 2816 * 2 <= WS_WPG && WS_WPG + 1024 * 1024 * 2 <= WS_WPP, "weights map");


namespace pg8 {
#define PG8_LAS __attribute__((address_space(3)))
typedef unsigned short bf16_t;
typedef short bf16x8 __attribute__((ext_vector_type(8)));
typedef float f32x4 __attribute__((ext_vector_type(4)));
typedef unsigned u32x4 __attribute__((ext_vector_type(4)));
constexpr int BM = 256, BK = 64, HALF = 128, HTB = HALF * BK * 2  , STAGE_BYTES = 8 * HTB, NXCD = 8, WGM = 8;

__host__ __device__ __forceinline__ int lds_byte(int r, int c) { const int st = (r >> 4) * 2 + (c >> 5), rr = r & 15, cc = c & 31, ob = rr * 64 + cc * 2; return st * 1024 + (ob ^ (((ob >> 9) & 1) << 5)); }
__host__ __device__ __forceinline__ void stage_rc(int b, int& R, int& C) { const int st = b / 1024, sb = b % 1024, swz = sb ^ (((sb >> 9) & 1) << 5); R = (st >> 1) * 16 + swz / 64; C = (st & 1) * 32 + (swz % 64) / 2; }
__host__ __device__ __forceinline__ int perm32(int rho) { const int n = rho >> 4, i = rho & 15; return 8 * (i >> 2) + 4 * n + (i & 3); }

struct Unit { int pm, pn; };
struct Gemm { const bf16_t* A; const bf16_t* Bt; int M, N, K; };

struct StaticOrder {
    int nM, nN, nwg, G, c;
    __host__ __device__ void init(int M, int N, int G_, int c_) { nM = M / BM; nN = N / BM; nwg = nM * nN; G = G_; c = c_; }
    __host__ __device__ bool next(int i, Unit& u) const {
        const long L = (long)i * G + c; if (L >= nwg) return false;
        int wgid = (int)L; { const int q = nwg / NXCD, r = nwg % NXCD, xcd = wgid % NXCD, off = wgid / NXCD; wgid = (xcd < r ? xcd * (q + 1) : r * (q + 1) + (xcd - r) * q) + off; }
        const int nig = WGM * nN, gid = wgid / nig, fm = gid * WGM, gsz = (nM - fm) < WGM ? (nM - fm) : WGM;
        u.pm = fm + ((wgid % nig) % gsz); u.pn = (wgid % nig) / gsz; return true;
    }
    __device__ __forceinline__ void a_ready(const Unit&) const {}
    __device__ __forceinline__ void done(const Unit&) const {}
};
__device__ __forceinline__ unsigned cvt_pk_bf16(float lo, float hi) { unsigned r; asm volatile("v_cvt_pk_bf16_f32 %0, %1, %2" : "=v"(r) : "v"(lo), "v"(hi)); return r; }
typedef unsigned u32x2 __attribute__((ext_vector_type(2)));
__device__ __forceinline__ float bf_lo(unsigned w) { return __uint_as_float(w << 16); }
__device__ __forceinline__ float bf_hi(unsigned w) { return __uint_as_float(w & 0xffff0000u); }
__device__ __forceinline__ float sigm(float x) { return __builtin_amdgcn_rcpf(1.0f + __builtin_amdgcn_exp2f(-1.4426950408889634f * x)); }
__device__ __forceinline__ float row_rstd(const float* ss, int row) {
    const f32x4* p = (const f32x4*)(ss + (size_t)row * 16);
    const f32x4 a = p[0], b = p[1], c = p[2], d = p[3];
    const float s = (((a.x + a.y) + (a.z + a.w)) + ((b.x + b.y) + (b.z + b.w))) + (((c.x + c.y) + (c.z + c.w)) + ((d.x + d.y) + (d.z + d.w)));
    return rsqrtf(s * (1.0f / 1024.0f) + EPSN);
}

template <bool ROWSCALE> struct EpiGateUp {
    static constexpr bool PERM = true, AFTER_DRAIN = false;
    bf16_t* O; int ldc; const float* ss;
    __device__ __forceinline__ void operator()(const f32x4 (&acc)[2][2][4][2], const Unit& u, int wr, int wc, int fr, int fq) const {
        const int row0 = u.pm * BM + wr * 64 + fr, col0 = u.pn * HALF + wc * 32 + 8 * fq;
#pragma unroll
        for (int ai = 0; ai < 2; ++ai)
#pragma unroll
            for (int m = 0; m < 4; ++m) { const int row = row0 + ai * HALF + m * 16; const float rs = ROWSCALE ? row_rstd(ss, row) : 1.0f;
                float o[8];
#pragma unroll
                for (int n = 0; n < 2; ++n)
#pragma unroll
                    for (int e = 0; e < 4; ++e) { const float g = acc[ai][0][m][n][e] * rs, up = acc[ai][1][m][n][e] * rs; o[n * 4 + e] = g * sigm(g) * up; }
                u32x4 w; w.x = cvt_pk_bf16(o[0], o[1]); w.y = cvt_pk_bf16(o[2], o[3]); w.z = cvt_pk_bf16(o[4], o[5]); w.w = cvt_pk_bf16(o[6], o[7]);
                *(u32x4*)(O + (size_t)row * ldc + col0) = w; asm volatile("" ::: "memory"); __builtin_amdgcn_sched_barrier(0); }
    }
};

struct EpiResid {
    static constexpr bool PERM = false, AFTER_DRAIN = false;
    const float* base0; const float* base1; float* out; bf16_t* hb; const float* gn; float* ss; float alpha;
    __device__ __forceinline__ void operator()(const f32x4 (&acc)[2][2][4][2], const Unit& u, int wr, int wc, int fr, int fq) const {
        const int row0 = u.pm * BM + wr * 64 + fr, col0 = u.pn * BM + wc * 32 + 4 * fq;
        f32x4 gv[2][2];
#pragma unroll
        for (int bj = 0; bj < 2; ++bj)
#pragma unroll
            for (int n = 0; n < 2; ++n) gv[bj][n] = *(const f32x4*)(gn + col0 + bj * HALF + n * 16);
#pragma unroll
        for (int ai = 0; ai < 2; ++ai)
#pragma unroll
            for (int m = 0; m < 4; ++m) { const int row = row0 + ai * HALF + m * 16;
                const float* bp = (row < MP ? base0 + (size_t)row * DMODEL : base1 + (size_t)(row - MP) * DMODEL) + col0;
                const size_t off = (size_t)row * DMODEL + col0; float s = 0.f;
#pragma unroll
                for (int bj = 0; bj < 2; ++bj)
#pragma unroll
                    for (int n = 0; n < 2; ++n) { const f32x4 b = *(const f32x4*)(bp + bj * HALF + n * 16); const f32x4 v = b + acc[ai][bj][m][n] * alpha;
                        *(f32x4*)(out + off + bj * HALF + n * 16) = v; s += (v.x * v.x + v.y * v.y) + (v.z * v.z + v.w * v.w);
                        const f32x4 h = v * gv[bj][n]; u32x2 w; w.x = cvt_pk_bf16(h.x, h.y); w.y = cvt_pk_bf16(h.z, h.w); *(u32x2*)(hb + off + bj * HALF + n * 16) = w; }
                s += __shfl_xor(s, 16); s += __shfl_xor(s, 32);
                if (fq == 0) ss[(size_t)row * 16 + u.pn * 4 + wc] = s;
                asm volatile("" ::: "memory"); __builtin_amdgcn_sched_barrier(0); }
    }
};

struct EpiWin {
    static constexpr bool PERM = false, AFTER_DRAIN = false;
    const float* ss; const float* gqk; unsigned char* ws; float qscale;
    __device__ __forceinline__ void operator()(const f32x4 (&acc)[2][2][4][2], const Unit& u, int wr, int wc, int fr, int fq) const {
        const int row0 = u.pm * BM + wr * 64 + fr;
        const int pn = u.pn;
        const bool is_rope = (pn < 2) || (pn == 2 && wc < 2);
        if (is_rope) {
            const float* g = gqk + ((pn < 2) ? 0 : 64); const float osc = (pn < 2) ? qscale : 1.0f;
            bf16_t* dst = (bf16_t*)(ws + ((pn < 2) ? (WS_QO + (size_t)(pn * 4 + wc) * 128) : (WS_K + (size_t)wc * 128))); const int ld = (pn < 2) ? 512 : 128;
            float inv[4];
#pragma unroll
            for (int e = 0; e < 4; ++e) inv[e] = __builtin_amdgcn_exp2f(-(float)(4 * fq + e) * 0.8304820237218406f);
#pragma unroll
            for (int m = 0; m < 4; ++m)
#pragma unroll
                for (int ai = 0; ai < 2; ++ai) { const int row = row0 + ai * HALF + m * 16; const float rs = row_rstd(ss, row);
                    int t = row < MP ? (row & 8191) : ((row - MP) & 4095); asm volatile("" : "+v"(t));
                    float s = 0.f;
#pragma unroll
                    for (int bj = 0; bj < 2; ++bj)
#pragma unroll
                        for (int n = 0; n < 2; ++n) { const f32x4 a = acc[ai][bj][m][n]; s += (a.x * a.x + a.y * a.y) + (a.z * a.z + a.w * a.w); }
                    s += __shfl_xor(s, 16); s += __shfl_xor(s, 32);
                    s *= rs * rs;
                    const float r = rsqrtf(s * (1.0f / 64.0f) + EPSN) * rs * osc;
#pragma unroll
                    for (int bj = 0; bj < 2; ++bj) { const float pos = (float)(bj == 0 ? (t >> 6) : (t & 63));
                        const f32x4 x1 = acc[ai][bj][m][0] * r * *(const f32x4*)(g + bj * 32 + 4 * fq), x2 = acc[ai][bj][m][1] * r * *(const f32x4*)(g + bj * 32 + 16 + 4 * fq); f32x4 o1, o2;
#pragma unroll
                        for (int e = 0; e < 4; ++e) { const float ang = pos * inv[e]; const float c = __cosf(ang), sn = __sinf(ang); o1[e] = x1[e] * c - x2[e] * sn; o2[e] = x2[e] * c + x1[e] * sn; }
                        u32x2 w1, w2; w1.x = cvt_pk_bf16(o1.x, o1.y); w1.y = cvt_pk_bf16(o1.z, o1.w); w2.x = cvt_pk_bf16(o2.x, o2.y); w2.y = cvt_pk_bf16(o2.z, o2.w);
                        bf16_t* p = dst + (size_t)row * ld + bj * 32 + 4 * fq; *(u32x2*)p = w1; *(u32x2*)(p + 16) = w2; }
                    asm volatile("" ::: "memory"); __builtin_amdgcn_sched_barrier(0); }
        } else if (pn == 2) {
            bf16_t* dst = (bf16_t*)(ws + WS_V) + (wc - 2) * 64 + 4 * fq;
#pragma unroll
            for (int ai = 0; ai < 2; ++ai)
#pragma unroll
                for (int m = 0; m < 4; ++m) { const int row = row0 + ai * HALF + m * 16; const float rs = row_rstd(ss, row);
#pragma unroll
                    for (int bj = 0; bj < 2; ++bj)
#pragma unroll
                        for (int n = 0; n < 2; ++n) { const f32x4 v = acc[ai][bj][m][n] * rs; u32x2 w; w.x = cvt_pk_bf16(v.x, v.y); w.y = cvt_pk_bf16(v.z, v.w); *(u32x2*)(dst + (size_t)row * 128 + bj * 32 + n * 16) = w; }
                    asm volatile("" ::: "memory"); __builtin_amdgcn_sched_barrier(0); }
        } else {
            const bool sg = pn >= 5; const int ld = sg ? 1024 : 512; const int ct = pn < 5 ? pn - 3 : (pn < 9 ? pn - 5 : pn - 9);
            bf16_t* dst = (bf16_t*)(ws + (pn < 5 ? WS_Z : (pn < 9 ? WS_MX : WS_SGB))) + ct * 256 + wc * 32 + 4 * fq;
#pragma unroll
            for (int ai = 0; ai < 2; ++ai)
#pragma unroll
                for (int m = 0; m < 4; ++m) { const int row = row0 + ai * HALF + m * 16; const float rs = row_rstd(ss, row);
#pragma unroll
                    for (int bj = 0; bj < 2; ++bj)
#pragma unroll
                        for (int n = 0; n < 2; ++n) { f32x4 v = acc[ai][bj][m][n] * rs; if (sg) { v.x = sigm(v.x); v.y = sigm(v.y); v.z = sigm(v.z); v.w = sigm(v.w); }
                            u32x2 w; w.x = cvt_pk_bf16(v.x, v.y); w.y = cvt_pk_bf16(v.z, v.w); *(u32x2*)(dst + (size_t)row * ld + bj * HALF + n * 16) = w; }
                    asm volatile("" ::: "memory"); __builtin_amdgcn_sched_barrier(0); }
        }
    }
};

template <int PASS> struct EpiGateMix {
    static constexpr bool PERM = true, AFTER_DRAIN = false;
    bf16_t* Mx; const bf16_t* SGB;
    __device__ __forceinline__ void operator()(const f32x4 (&acc)[2][2][4][2], const Unit& u, int wr, int wc, int fr, int fq) const {
        const int row0 = u.pm * BM + wr * 64 + fr, col0 = u.pn * BM + wc * 32 + 8 * fq;
#pragma unroll
        for (int ai = 0; ai < 2; ++ai)
#pragma unroll
            for (int m = 0; m < 4; ++m) { const size_t off = (size_t)(row0 + ai * HALF + m * 16) * DMODEL + col0;
#pragma unroll
                for (int bj = 0; bj < 2; ++bj) { const u32x4 a = *(const u32x4*)(Mx + off + bj * HALF); const f32x4 c0 = acc[ai][bj][m][0], c1 = acc[ai][bj][m][1]; float o[8];
                    if (PASS == 0) { o[0] = bf_lo(a.x) * c0.x; o[1] = bf_hi(a.x) * c0.y; o[2] = bf_lo(a.y) * c0.z; o[3] = bf_hi(a.y) * c0.w; o[4] = bf_lo(a.z) * c1.x; o[5] = bf_hi(a.z) * c1.y; o[6] = bf_lo(a.w) * c1.z; o[7] = bf_hi(a.w) * c1.w; }
                    else { const u32x4 g = *(const u32x4*)(SGB + off + bj * HALF);
                        o[0] = bf_lo(a.x) + bf_lo(g.x) * c0.x; o[1] = bf_hi(a.x) + bf_hi(g.x) * c0.y; o[2] = bf_lo(a.y) + bf_lo(g.y) * c0.z; o[3] = bf_hi(a.y) + bf_hi(g.y) * c0.w;
                        o[4] = bf_lo(a.z) + bf_lo(g.z) * c1.x; o[5] = bf_hi(a.z) + bf_hi(g.z) * c1.y; o[6] = bf_lo(a.w) + bf_lo(g.w) * c1.z; o[7] = bf_hi(a.w) + bf_hi(g.w) * c1.w; }
                    u32x4 w; w.x = cvt_pk_bf16(o[0], o[1]); w.y = cvt_pk_bf16(o[2], o[3]); w.z = cvt_pk_bf16(o[4], o[5]); w.w = cvt_pk_bf16(o[6], o[7]);
                    *(u32x4*)(Mx + off + bj * HALF) = w; } }
    }
};

struct EpiE {
    static constexpr bool PERM = true, AFTER_DRAIN = false;
    bf16_t* E; float* ss;
    __device__ __forceinline__ void operator()(const f32x4 (&acc)[2][2][4][2], const Unit& u, int wr, int wc, int fr, int fq) const {
        const int row0 = u.pm * BM + wr * 64 + fr, col0 = u.pn * BM + wc * 32 + 8 * fq;
#pragma unroll
        for (int ai = 0; ai < 2; ++ai)
#pragma unroll
            for (int m = 0; m < 4; ++m) { const int row = row0 + ai * HALF + m * 16; float s = 0.f;
#pragma unroll
                for (int bj = 0; bj < 2; ++bj) { const f32x4 c0 = acc[ai][bj][m][0], c1 = acc[ai][bj][m][1];
                    s += ((c0.x * c0.x + c0.y * c0.y) + (c0.z * c0.z + c0.w * c0.w)) + ((c1.x * c1.x + c1.y * c1.y) + (c1.z * c1.z + c1.w * c1.w));
                    u32x4 w; w.x = cvt_pk_bf16(c0.x, c0.y); w.y = cvt_pk_bf16(c0.z, c0.w); w.z = cvt_pk_bf16(c1.x, c1.y); w.w = cvt_pk_bf16(c1.z, c1.w);
                    *(u32x4*)(E + (size_t)row * DMODEL + col0 + bj * HALF) = w; }
                s += __shfl_xor(s, 16); s += __shfl_xor(s, 32);
                if (fq == 0) ss[(size_t)row * 16 + u.pn * 4 + wc] = s; }
    }
};

struct EpiFinal {
    static constexpr bool PERM = false, AFTER_DRAIN = false;
    float* out; const bf16_t* E; const float* ss; const float* sse; const float* gpost;
    __device__ __forceinline__ void operator()(const f32x4 (&acc)[2][2][4][2], const Unit& u, int wr, int wc, int fr, int fq) const {
        const int row0 = u.pm * BM + wr * 64 + fr, col0 = u.pn * BM + wc * 32 + 4 * fq;
        f32x4 gv[2][2];
#pragma unroll
        for (int bj = 0; bj < 2; ++bj)
#pragma unroll
            for (int n = 0; n < 2; ++n) gv[bj][n] = *(const f32x4*)(gpost + col0 + bj * HALF + n * 16);
#pragma unroll
        for (int ai = 0; ai < 2; ++ai)
#pragma unroll
            for (int m = 0; m < 4; ++m) { const int row = row0 + ai * HALF + m * 16; const float rs = row_rstd(ss, row), re = row_rstd(sse, row);
                const size_t off = (size_t)row * DMODEL + col0;
#pragma unroll
                for (int bj = 0; bj < 2; ++bj)
#pragma unroll
                    for (int n = 0; n < 2; ++n) { const f32x4 h = *(const f32x4*)(out + off + bj * HALF + n * 16); const u32x2 ew = *(const u32x2*)(E + off + bj * HALF + n * 16);
                        const f32x4 a = acc[ai][bj][m][n] * rs; f32x4 ev; ev.x = bf_lo(ew.x); ev.y = bf_hi(ew.x); ev.z = bf_lo(ew.y); ev.w = bf_hi(ew.y); ev = ev * re * gv[bj][n];
                        f32x4 y; y.x = h.x + sigm(a.x) * ev.x; y.y = h.y + sigm(a.y) * ev.y; y.z = h.z + sigm(a.z) * ev.z; y.w = h.w + sigm(a.w) * ev.w;
                        *(f32x4*)(out + off + bj * HALF + n * 16) = y; }
                asm volatile("" ::: "memory"); __builtin_amdgcn_sched_barrier(0); }
    }
};

template <class Epi, class Sched, bool ALIGN_EPI = false, bool SP2 = false>
__device__ __forceinline__ void gemm_phase(PG8_LAS unsigned char* lds, const Gemm g, const Sched& S, const Epi& E) {
    int tid = threadIdx.x; asm volatile("" : "+v"(tid));
    const int wid = __builtin_amdgcn_readfirstlane(tid >> 6), lane = tid & 63, wr = wid >> 2, wc = wid & 3, fr = lane & 15, fq = lane >> 4;
    const int K = g.K, nt = K / BK;
    unsigned voffA[2], voffB[2];
#pragma unroll
    for (int i = 0; i < 2; ++i) { int R, C; stage_rc(tid * 16 + i * 8192, R, C); const int Rb = Epi::PERM ? ((R & ~31) + perm32(R & 31)) : R;
        voffA[i] = (unsigned)(R * K + C) * 2u; voffB[i] = (unsigned)(Rb * K + C) * 2u; }
    const size_t kstep = (size_t)(BK * 2);
    const size_t hstep = (size_t)HALF * K * 2;
    const size_t tstep = 2 * hstep;
    const unsigned ldsw = (unsigned)wid * 1024u;
    const int aoff = lds_byte(wr * 64 + fr, fq * 8), boff = lds_byte(wc * 32 + fr, fq * 8);
#define PG8_SA(b, h) (((b) * 2 + (h)) * HTB)
#define PG8_SB(b, h) ((4 + (b) * 2 + (h)) * HTB)
#define PG8_STAGE(bufoff, gbase, voff) do { _Pragma("unroll") for (int _i = 0; _i < 2; ++_i) \
        __builtin_amdgcn_global_load_lds((const unsigned*)((const char*)(gbase) + (voff)[_i]), (PG8_LAS unsigned*)(lds + (bufoff) + ldsw + _i * 8192), 16, 0, 0); } while (0)
#define PG8_LDA(dst, b, h) do { _Pragma("unroll") for (int m = 0; m < 4; ++m) _Pragma("unroll") for (int k = 0; k < 2; ++k) dst[m][k] = *(const PG8_LAS bf16x8*)(lds + PG8_SA(b, h) + aoff + m * 2048 + k * 1024); } while (0)
#define PG8_LDB(dst, b, h) do { _Pragma("unroll") for (int n = 0; n < 2; ++n) _Pragma("unroll") for (int k = 0; k < 2; ++k) dst[n][k] = *(const PG8_LAS bf16x8*)(lds + PG8_SB(b, h) + boff + n * 2048 + k * 1024); } while (0)
#define PG8_MMA(ai, bj, At, Bt) do { __builtin_amdgcn_s_setprio(1); _Pragma("unroll") for (int m = 0; m < 4; ++m) _Pragma("unroll") for (int n = 0; n < 2; ++n) _Pragma("unroll") for (int k = 0; k < 2; ++k) \
        acc[ai][bj][m][n] = __builtin_amdgcn_mfma_f32_16x16x32_bf16(Bt[n][k], At[m][k], acc[ai][bj][m][n], 0, 0, 0); __builtin_amdgcn_s_setprio(0); } while (0)
#define PG8_WAIT_V(n) asm volatile("s_waitcnt vmcnt(" #n ")" ::: "memory")
#define PG8_WAIT_L(n) asm volatile("s_waitcnt lgkmcnt(" #n ")" ::: "memory")
#define PG8_BAR __builtin_amdgcn_s_barrier()
#define PG8_SCHED __builtin_amdgcn_sched_barrier(0)
    Unit cur, nxt; int ui = 0;
    if (!S.next(0, cur)) return;
    f32x4 acc[2][2][4][2];
#pragma unroll
    for (int a = 0; a < 2; ++a)
#pragma unroll
        for (int b = 0; b < 2; ++b)
#pragma unroll
            for (int m = 0; m < 4; ++m)
#pragma unroll
                for (int n = 0; n < 2; ++n) acc[a][b][m][n] = (f32x4){0.f, 0.f, 0.f, 0.f};
    bf16x8 At[4][2], B0[2][2], B1[2][2];
    const char* cA = (const char*)g.A + (size_t)cur.pm * tstep; const char* cB = (const char*)g.Bt + (size_t)cur.pn * tstep;
    S.a_ready(cur);
    if constexpr (SP2) {
        PG8_STAGE(PG8_SB(0, 0), cB, voffB); PG8_STAGE(PG8_SB(0, 1), cB + hstep, voffB); PG8_STAGE(PG8_SA(0, 0), cA, voffA); PG8_STAGE(PG8_SA(0, 1), cA + hstep, voffA);
        if (wr == 1) PG8_BAR;
        PG8_WAIT_V(2); PG8_BAR;
        PG8_STAGE(PG8_SB(1, 0), cB + kstep, voffB); PG8_STAGE(PG8_SA(1, 0), cA + kstep, voffA); PG8_STAGE(PG8_SB(1, 1), cB + hstep + kstep, voffB);
        PG8_WAIT_V(6); PG8_BAR;
    } else {
        PG8_STAGE(PG8_SB(0, 0), cB, voffB); PG8_STAGE(PG8_SA(0, 0), cA, voffA); PG8_STAGE(PG8_SB(0, 1), cB + hstep, voffB); PG8_STAGE(PG8_SA(0, 1), cA + hstep, voffA);
        if (wr == 1) PG8_BAR;
        PG8_WAIT_V(4); PG8_BAR;
        PG8_STAGE(PG8_SB(1, 0), cB + kstep, voffB); PG8_STAGE(PG8_SA(1, 0), cA + kstep, voffA); PG8_STAGE(PG8_SB(1, 1), cB + hstep + kstep, voffB);
        PG8_WAIT_V(6); PG8_BAR;
    }
    for (;;) {
        const bool has_next = S.next(ui + 1, nxt);
        const char* nA = has_next ? (const char*)g.A + (size_t)nxt.pm * tstep : cA; const char* nB = has_next ? (const char*)g.Bt + (size_t)nxt.pn * tstep : cB;
        for (int t = 0; t < nt; t += 2) {
            const bool last = (t == nt - 2);
            const char* a1 = cA + (size_t)(t + 1) * kstep;
            const char* a2 = last ? nA : cA + (size_t)(t + 2) * kstep; const char* b2 = last ? nB : cB + (size_t)(t + 2) * kstep;
            const char* a3 = a2 + kstep; const char* b3 = b2 + kstep;
            if (last && has_next) S.a_ready(nxt);
            if constexpr (SP2) {
            PG8_LDB(B0, 0, 0); PG8_LDB(B1, 0, 1); PG8_SCHED; PG8_LDA(At, 0, 0); PG8_STAGE(PG8_SA(1, 1), a1 + hstep, voffA);
            PG8_WAIT_V(8); PG8_WAIT_L(0); PG8_BAR; PG8_MMA(0, 0, At, B0); PG8_MMA(0, 1, At, B1); PG8_BAR; PG8_SCHED;
            PG8_LDA(At, 0, 1); PG8_STAGE(PG8_SB(0, 0), b2, voffB); PG8_STAGE(PG8_SB(0, 1), b2 + hstep, voffB); PG8_STAGE(PG8_SA(0, 0), a2, voffA);
            PG8_WAIT_V(8); PG8_WAIT_L(0); PG8_BAR; PG8_MMA(1, 0, At, B0); PG8_MMA(1, 1, At, B1); PG8_BAR; PG8_SCHED;
            PG8_LDB(B0, 1, 0); PG8_LDB(B1, 1, 1); PG8_SCHED; PG8_LDA(At, 1, 0); PG8_STAGE(PG8_SA(0, 1), a2 + hstep, voffA);
            PG8_WAIT_V(8); PG8_WAIT_L(0); PG8_BAR; PG8_MMA(0, 0, At, B0); PG8_MMA(0, 1, At, B1); PG8_BAR; PG8_SCHED;
            PG8_LDA(At, 1, 1); PG8_STAGE(PG8_SB(1, 0), b3, voffB); PG8_STAGE(PG8_SB(1, 1), b3 + hstep, voffB); PG8_STAGE(PG8_SA(1, 0), a3, voffA);
            PG8_WAIT_V(8); PG8_WAIT_L(0); PG8_BAR; PG8_MMA(1, 0, At, B0); PG8_MMA(1, 1, At, B1); PG8_BAR; PG8_SCHED;
            } else {
            PG8_LDB(B0, 0, 0); PG8_SCHED; PG8_LDA(At, 0, 0); PG8_STAGE(PG8_SA(1, 1), a1 + hstep, voffA);
            PG8_WAIT_L(8); PG8_BAR; PG8_WAIT_L(0); PG8_MMA(0, 0, At, B0); PG8_BAR; PG8_SCHED;
            PG8_LDB(B1, 0, 1); PG8_STAGE(PG8_SB(0, 0), b2, voffB);
            PG8_BAR; PG8_WAIT_L(0); PG8_MMA(0, 1, At, B1); PG8_BAR;
            PG8_LDA(At, 0, 1); PG8_STAGE(PG8_SA(0, 0), a2, voffA);
            PG8_BAR; PG8_WAIT_L(0); PG8_MMA(1, 0, At, B0); PG8_BAR; PG8_SCHED;
            PG8_STAGE(PG8_SB(0, 1), b2 + hstep, voffB);
            PG8_WAIT_V(6); PG8_BAR; PG8_MMA(1, 1, At, B1); PG8_BAR;
            PG8_LDB(B0, 1, 0); PG8_SCHED; PG8_LDA(At, 1, 0); PG8_STAGE(PG8_SA(0, 1), a2 + hstep, voffA);
            PG8_WAIT_L(8); PG8_BAR; PG8_WAIT_L(0); PG8_MMA(0, 0, At, B0); PG8_BAR; PG8_SCHED;
            PG8_LDB(B1, 1, 1); PG8_STAGE(PG8_SB(1, 0), b3, voffB);
            PG8_BAR; PG8_WAIT_L(0); PG8_MMA(0, 1, At, B1); PG8_BAR;
            PG8_LDA(At, 1, 1); PG8_STAGE(PG8_SA(1, 0), a3, voffA);
            PG8_BAR; PG8_WAIT_L(0); PG8_MMA(1, 0, At, B0); PG8_BAR; PG8_SCHED;
            PG8_STAGE(PG8_SB(1, 1), b3 + hstep, voffB);
            PG8_WAIT_V(6); PG8_BAR; PG8_MMA(1, 1, At, B1); PG8_BAR;
            }
        }
        if constexpr (ALIGN_EPI) { if (wr == 0) PG8_BAR; }
        if constexpr (!Epi::AFTER_DRAIN) { E(acc, cur, wr, wc, fr, fq); S.done(cur); }
        if (!has_next) break;
#pragma unroll
        for (int a = 0; a < 2; ++a)
#pragma unroll
            for (int b = 0; b < 2; ++b)
#pragma unroll
                for (int m = 0; m < 4; ++m)
#pragma unroll
                    for (int n = 0; n < 2; ++n) acc[a][b][m][n] = (f32x4){0.f, 0.f, 0.f, 0.f};
        cur = nxt; cA = nA; cB = nB; ++ui;
        if constexpr (ALIGN_EPI) { if (wr == 1) PG8_BAR; }
    }
    PG8_WAIT_V(0);
    if constexpr (!ALIGN_EPI) { if (wr == 0) PG8_BAR; }
    PG8_BAR;
    if constexpr (Epi::AFTER_DRAIN) { E.fused(acc, cur, wr, wc, fr, fq, lds, wid, lane); S.done(cur); }
#undef PG8_SA
#undef PG8_SB
#undef PG8_STAGE
#undef PG8_LDA
#undef PG8_LDB
#undef PG8_MMA
#undef PG8_WAIT_V
#undef PG8_WAIT_L
#undef PG8_BAR
#undef PG8_SCHED
}
}
#include <hip/hip_bf16.h>
#include <cmath>
namespace attn_body {
using bf16=__hip_bfloat16;
using bf16x8=__attribute__((ext_vector_type(8)))short;
using s16x4=__attribute__((ext_vector_type(4)))short;
using f32x16=__attribute__((ext_vector_type(16)))float;
using u32x4=__attribute__((ext_vector_type(4)))unsigned;
constexpr int D=64,QP=512,KP=128;
constexpr int NW=8,QBLK=32,QB=QBLK*NW,KVBLK=64;
constexpr int ATTN_UNIT_ROWS=QB;
__device__ __forceinline__ int crow(int r,int hi){return (r&3)+8*(r>>2)+4*hi;}
#define SBAR() __builtin_amdgcn_sched_barrier(0)
__device__ __forceinline__ void cmask(f32x16&p0,f32x16&p1,int jb,int qrel,int hi){
  const float NEG=-INFINITY; int kb=64*jb+4*hi;
  #pragma unroll
  for(int r=0;r<16;++r){int kv=kb+(r&3)+8*(r>>2); if(kv>qrel)p0[r]=NEG; if(kv+32>qrel)p1[r]=NEG;}
}

constexpr int NSLOT=3, SLOTB=8192;
constexpr int LDS_K=0, LDS_V=NSLOT*SLOTB, LDS_WS=2*NSLOT*SLOTB, LDS_OST=LDS_WS+NW*64*4, LDS_BYTES=LDS_OST+NW*4096;
constexpr float C2=0.125f*1.4426950408889634f;
__device__ __forceinline__ void glds16(const void*gsrc,unsigned lds_dst){unsigned keep;
  asm volatile("s_mov_b32 %0, m0\n\ts_mov_b32 m0, %2\n\ts_nop 0\n\tglobal_load_lds_dwordx4 %1, off\n\ts_mov_b32 m0, %0":"=&s"(keep):"v"(gsrc),"s"(lds_dst):"memory");}
__device__ __forceinline__ float max3f(float a,float b,float c){float r;asm("v_max3_f32 %0, %1, %2, %3":"=v"(r):"v"(a),"v"(b),"v"(c));return r;}
__device__ __forceinline__ float max2f(float a,float b){float r;asm("v_max_f32_e32 %0, %1, %2":"=v"(r):"v"(a),"v"(b));return r;}
__device__ __forceinline__ float fadd_s(float a,float b){float r;asm("v_add_f32_e32 %0, %1, %2":"=v"(r):"v"(a),"v"(b));return r;}
__device__ __forceinline__ float fsub_s(float a,float b){float r;asm("v_sub_f32_e32 %0, %1, %2":"=v"(r):"v"(a),"v"(b));return r;}
typedef float f32x2_t __attribute__((ext_vector_type(2))); typedef __bf16 bf16x2_t __attribute__((ext_vector_type(2)));
__device__ __forceinline__ unsigned cvtpk_s(float lo,float hi){f32x2_t v={lo,hi};bf16x2_t b=__builtin_convertvector(v,bf16x2_t);return __builtin_bit_cast(unsigned,b);}
#define WAIT_BAR(N) asm volatile("s_waitcnt vmcnt(" #N ") lgkmcnt(0)\n\ts_barrier":::"memory")

__device__ __forceinline__ void qkt(f32x16&p0,f32x16&p1,const char*Kslot,const bf16x8*qr,const f32x16&negm,int r32,int hi){
  const char*kb=Kslot+hi*1024+r32*16;
  #pragma unroll
  for(int d0=0;d0<4;++d0){
    const bf16x8 b0=*reinterpret_cast<const bf16x8*>(kb+d0*2048);
    const bf16x8 b1=*reinterpret_cast<const bf16x8*>(kb+d0*2048+512);
    if(d0==0){p0=__builtin_amdgcn_mfma_f32_32x32x16_bf16(b0,qr[0],negm,0,0,0);p1=__builtin_amdgcn_mfma_f32_32x32x16_bf16(b1,qr[0],negm,0,0,0);}
    else{p0=__builtin_amdgcn_mfma_f32_32x32x16_bf16(b0,qr[d0],p0,0,0,0);p1=__builtin_amdgcn_mfma_f32_32x32x16_bf16(b1,qr[d0],p1,0,0,0);}}
}
typedef __attribute__((address_space(3))) const char* lds_cptr;
typedef short v4i16_t __attribute__((ext_vector_type(4)));
__device__ __forceinline__ void kload8(bf16x8*kf,lds_cptr kp){
  kf[0]=*(const __attribute__((address_space(3))) bf16x8*)(kp);      kf[1]=*(const __attribute__((address_space(3))) bf16x8*)(kp+512);
  kf[2]=*(const __attribute__((address_space(3))) bf16x8*)(kp+2048); kf[3]=*(const __attribute__((address_space(3))) bf16x8*)(kp+2560);
  kf[4]=*(const __attribute__((address_space(3))) bf16x8*)(kp+4096); kf[5]=*(const __attribute__((address_space(3))) bf16x8*)(kp+4608);
  kf[6]=*(const __attribute__((address_space(3))) bf16x8*)(kp+6144); kf[7]=*(const __attribute__((address_space(3))) bf16x8*)(kp+6656);
}
__device__ __forceinline__ void kload2(bf16x8*kf,lds_cptr kp,int j){ kf[2*j]=*(const __attribute__((address_space(3))) bf16x8*)(kp+j*2048); kf[2*j+1]=*(const __attribute__((address_space(3))) bf16x8*)(kp+j*2048+512); }
__device__ __forceinline__ s16x4 vtr(lds_cptr p){ return __builtin_bit_cast(s16x4,__builtin_amdgcn_ds_read_tr16_b64_v4i16((__attribute__((address_space(3))) v4i16_t*)p)); }
__device__ __forceinline__ float rowmax(const f32x16&p0,const f32x16&p1){
  float a=max3f(p0[0],p0[1],p1[0]),b=max3f(p0[2],p0[3],p1[1]);a=max3f(a,p1[2],p1[3]);
  #pragma unroll
  for(int r=4;r<16;r+=4){a=max3f(a,p0[r],p0[r+1]);b=max3f(b,p0[r+2],p0[r+3]);a=max3f(a,p1[r],p1[r+1]);b=max3f(b,p1[r+2],p1[r+3]);}
  const float m=max2f(a,b);
  auto rr=__builtin_amdgcn_permlane32_swap(__float_as_uint(m),__float_as_uint(m),false,false);
  return max2f(__uint_as_float(rr[0]),__uint_as_float(rr[1]));
}
__device__ __forceinline__ void pv(f32x16*o,int vb,bf16x8 pa0,bf16x8 pa1,bf16x8 pa2,bf16x8 pa3){
  #pragma unroll
  for(int d0=0;d0<2;++d0){s16x4 lo[4],hi[4];
    #pragma unroll
    for(int ks=0;ks<4;++ks){
      asm volatile("ds_read_b64_tr_b16 %0,%1 offset:%c2":"=&v"(lo[ks]):"v"(vb),"i"(d0*4096+ks*1024):"memory");
      asm volatile("ds_read_b64_tr_b16 %0,%1 offset:%c2":"=&v"(hi[ks]):"v"(vb),"i"(d0*4096+ks*1024+512):"memory");}
    asm volatile("s_waitcnt lgkmcnt(0)":::"memory");SBAR();
    #define PK(k) (bf16x8){lo[k][0],lo[k][1],lo[k][2],lo[k][3],hi[k][0],hi[k][1],hi[k][2],hi[k][3]}
    o[d0]=__builtin_amdgcn_mfma_f32_32x32x16_bf16(pa0,PK(0),o[d0],0,0,0);
    o[d0]=__builtin_amdgcn_mfma_f32_32x32x16_bf16(pa1,PK(1),o[d0],0,0,0);
    o[d0]=__builtin_amdgcn_mfma_f32_32x32x16_bf16(pa2,PK(2),o[d0],0,0,0);
    o[d0]=__builtin_amdgcn_mfma_f32_32x32x16_bf16(pa3,PK(3),o[d0],0,0,0);
    #undef PK
  }
}

#ifndef ATTN_STORE16
#define ATTN_STORE16(p,v) (*(u32x4*)(p)=(v))
#endif
template<int THRL> __device__ __forceinline__ void attn_unit(long rowbase,int h,int qb,int NT,const bf16*Q,const bf16*__restrict__ K,const bf16*__restrict__ V,bf16*O,char*shm){
  int tid=threadIdx.x; asm volatile("":"+v"(tid)); const int lane=tid&63,r32=lane&31,hi=lane>>5; const int wid=__builtin_amdgcn_readfirstlane(tid>>6);
  const int q0=qb*QB;
  const bf16*Qw=Q+(rowbase+q0+wid*QBLK)*QP+h*D;
  const bf16*Kh=K+rowbase*KP+(h>>2)*D,*Vh=V+rowbase*KP+(h>>2)*D;
  const unsigned lds0=(unsigned)(uintptr_t)shm;
  float*wsf=(float*)(shm+LDS_WS)+wid*64;
  const bf16*ksrc=Kh+(long)lane*KP+wid*8;
  const bf16*vsrc=Vh+(long)(16*(wid&3)+(lane>>2))*KP+(wid>>2)*32+(lane&3)*8;
  const unsigned kdst=lds0+LDS_K+wid*1024, vdst=lds0+LDS_V+wid*1024;
  #define DMA_K(t,slot) glds16(ksrc+(long)(t)*KVBLK*KP,(unsigned)__builtin_amdgcn_readfirstlane(kdst+(slot)))
  #define DMA_V(t,slot) glds16(vsrc+(long)(t)*KVBLK*KP,(unsigned)__builtin_amdgcn_readfirstlane(vdst+(slot)))
  const int vb0=(int)(lds0+LDS_V)+((lane>>4)&1)*32+(lane&3)*8+(4*hi+((lane&15)>>2))*64;
  const char*Kbase=shm+LDS_K; bf16x8 kf[8];
  const lds_cptr shm3=(lds_cptr)shm; const lds_cptr kp0=shm3+LDS_K+hi*1024+r32*16; const lds_cptr vp0=shm3+LDS_V+((lane>>4)&1)*32+(lane&3)*8+(4*hi+((lane&15)>>2))*64;
  DMA_K(0,0);DMA_V(0,0);DMA_K(1,SLOTB);
  bf16x8 qr[4];
  #pragma unroll
  for(int d0=0;d0<4;++d0)qr[d0]=*reinterpret_cast<const bf16x8*>(&Qw[(long)r32*QP+d0*16+hi*8]);
  float mhat=0.f,l_reg=0.f;f32x16 o[2];o[0]=f32x16{};o[1]=f32x16{};f32x16 negm=f32x16{};asm volatile("":"+v"(negm));
    #define CMASK(P0,P1,t) do{}while(0)
  bool resc=false;
  #define START(P0,P1) do{ const float rm=rowmax(P0,P1); resc=false; \
    { const float dl=rm; mhat=fadd_s(mhat,dl); \
      _Pragma("unroll") for(int r=0;r<16;++r){P0[r]=fsub_s(P0[r],dl);P1[r]=fsub_s(P1[r],dl);} \
      _Pragma("unroll") for(int r=0;r<16;++r)negm[r]=-mhat; asm volatile("":"+v"(negm)); } \
    _Pragma("unroll") for(int r=0;r<16;++r)P0[r]=__builtin_amdgcn_exp2f(P0[r]); }while(0)
  #define RESC() do{ if(resc){ asm volatile("s_waitcnt lgkmcnt(0)":::"memory"); \
      _Pragma("unroll") for(int d_=0;d_<2;++d_) _Pragma("unroll") for(int r=0;r<16;++r)o[d_][r]*=wsf[crow(r,hi)]; } }while(0)
  f32x16 pA0,pA1,pB0,pB1;
  int sl_prev=0,sl_cur=0,sl_next=SLOTB;
  #define ROT() do{sl_prev=sl_cur;sl_cur=sl_next;sl_next=(sl_next==(NSLOT-1)*SLOTB)?0:sl_next+SLOTB;}while(0)
  DMA_K(2,2*SLOTB);
  WAIT_BAR(3);
  qkt(pA0,pA1,Kbase,qr,negm,r32,hi);asm volatile("s_nop 15\n\ts_nop 7":"+v"(pA0),"+v"(pA1));CMASK(pA0,pA1,0);
  START(pA0,pA1);
  _Pragma("unroll") for(int r=0;r<16;++r)pA1[r]=__builtin_amdgcn_exp2f(pA1[r]);
  WAIT_BAR(0);
  DMA_K(3,0);DMA_V(1,SLOTB);
  ROT();
  kload8(kf,kp0+sl_cur);
  WAIT_BAR(2);
  s16x4 vlo[8],vhi[8]; u32x4 pw0,pw1,pw2,pw3;
  #define PKW(P,B) cvtpk_s(P[B],P[B+1])
  #define PAF(k) __builtin_bit_cast(bf16x8,pw##k)
  #define VFR(i) (bf16x8){vlo[i][0],vlo[i][1],vlo[i][2],vlo[i][3],vhi[i][0],vhi[i][1],vhi[i][2],vhi[i][3]}
  #define PIN(x) asm volatile("":"+v"(x))
  #define MX3(a,b,c) __builtin_fmaxf(__builtin_fmaxf((a),(b)),(c))
  #define GAPA(MF,A0,A1,A2,A3,W0,W1,PW) do{ MF; sacc+=A0; sacc+=A1; sacc+=A2; sacc+=A3; PIN(sacc); W0; W1; PIN(PW); SBAR(); }while(0)
  #define EX(v) __builtin_amdgcn_exp2f(v)
  #define GAPB(MF,X,B) do{ MF; X[B]=EX(X[B]); X[B+1]=EX(X[B+1]); X[B+2]=EX(X[B+2]); X[B+3]=EX(X[B+3]); PIN(X); SBAR(); }while(0)
  #define VRD(i) do{ vlo[i]=vtr(vp_+(((i)>>2)*4096+((i)&3)*1024)); vhi[i]=vtr(vp_+(((i)>>2)*4096+((i)&3)*1024+512)); }while(0)
  #define KRD(G,j) do{ if(G){ kload2(kf,kp0+sl_next,j); SBAR(); } }while(0)
  #define STEP(C0,C1,P0,P1,t,GK,GV,GL) do{ SBAR(); \
    const lds_cptr vp_=vp0+sl_prev; \
    VRD(0); SBAR(); float sacc=(P0[0]+P0[1]); \
    GAPA(C0=__builtin_amdgcn_mfma_f32_32x32x16_bf16(kf[0],qr[0],negm,0,0,0), P0[2],P0[3],P0[4],P0[5],     pw0[0]=PKW(P0,0), pw0[1]=PKW(P0,2), pw0); \
    VRD(4); SBAR(); GAPA(C1=__builtin_amdgcn_mfma_f32_32x32x16_bf16(kf[1],qr[0],negm,0,0,0), P0[6],P0[7],P0[8],P0[9],     pw0[2]=PKW(P0,4), pw0[3]=PKW(P0,6), pw0); \
    VRD(1); SBAR(); GAPA(C0=__builtin_amdgcn_mfma_f32_32x32x16_bf16(kf[2],qr[1],C0,0,0,0),   P0[10],P0[11],P0[12],P0[13], pw1[0]=PKW(P0,8), pw1[1]=PKW(P0,10), pw1); \
    VRD(5); SBAR(); GAPA(C1=__builtin_amdgcn_mfma_f32_32x32x16_bf16(kf[3],qr[1],C1,0,0,0),   P0[14],P0[15],P1[0],P1[1],   pw1[2]=PKW(P0,12),pw1[3]=PKW(P0,14), pw1); \
    VRD(2); SBAR(); GAPA(C0=__builtin_amdgcn_mfma_f32_32x32x16_bf16(kf[4],qr[2],C0,0,0,0),   P1[2],P1[3],P1[4],P1[5],     pw2[0]=PKW(P1,0), pw2[1]=PKW(P1,2), pw2); \
    VRD(6); SBAR(); GAPA(C1=__builtin_amdgcn_mfma_f32_32x32x16_bf16(kf[5],qr[2],C1,0,0,0),   P1[6],P1[7],P1[8],P1[9],     pw2[2]=PKW(P1,4), pw2[3]=PKW(P1,6), pw2); \
    VRD(3); SBAR(); GAPA(C0=__builtin_amdgcn_mfma_f32_32x32x16_bf16(kf[6],qr[3],C0,0,0,0),   P1[10],P1[11],P1[12],P1[13], pw3[0]=PKW(P1,8), pw3[1]=PKW(P1,10), pw3); \
    VRD(7); SBAR(); GAPA(C1=__builtin_amdgcn_mfma_f32_32x32x16_bf16(kf[7],qr[3],C1,0,0,0),   P1[14],P1[15],0.f,0.f,       pw3[2]=PKW(P1,12),pw3[3]=PKW(P1,14), pw3); \
    l_reg+=sacc; \
    if(GK){DMA_K((t)+3,sl_cur);} if(GV){DMA_V((t)+1,sl_next);} \
    CMASK(C0,C1,t); \
    { float a=MX3(C0[0],C0[1],C1[0]),b=MX3(C0[2],C0[3],C1[1]); a=MX3(a,C1[2],C1[3]); \
      _Pragma("unroll") for(int r=4;r<16;r+=4){a=MX3(a,C0[r],C0[r+1]);b=MX3(b,C0[r+2],C0[r+3]);a=MX3(a,C1[r],C1[r+1]);b=MX3(b,C1[r+2],C1[r+3]);} \
      float rm=__builtin_fmaxf(a,b); { auto rr=__builtin_amdgcn_permlane32_swap(__float_as_uint(rm),__float_as_uint(rm),false,false); rm=__builtin_fmaxf(__uint_as_float(rr[0]),__uint_as_float(rr[1])); } \
      resc=false; \
      if(__builtin_expect(__any(rm>(float)THRL),0)){ const float dl=__builtin_fmaxf(rm,0.f); mhat+=dl; \
        _Pragma("unroll") for(int r=0;r<16;++r){C0[r]-=dl;C1[r]-=dl;} \
        _Pragma("unroll") for(int r=0;r<16;++r)negm[r]=-mhat; asm volatile("":"+v"(negm)); \
        const float f=__builtin_amdgcn_exp2f(-dl); l_reg*=f; if(hi==0)wsf[r32]=f; resc=true; } } \
    SBAR(); \
    GAPB(o[0]=__builtin_amdgcn_mfma_f32_32x32x16_bf16(PAF(0),VFR(0),o[0],0,0,0), C0,0); \
    GAPB(o[1]=__builtin_amdgcn_mfma_f32_32x32x16_bf16(PAF(0),VFR(4),o[1],0,0,0), C0,4); \
    KRD(GL,0); GAPB(o[0]=__builtin_amdgcn_mfma_f32_32x32x16_bf16(PAF(1),VFR(1),o[0],0,0,0), C0,8); \
    KRD(GL,1); GAPB(o[1]=__builtin_amdgcn_mfma_f32_32x32x16_bf16(PAF(1),VFR(5),o[1],0,0,0), C0,12); \
    KRD(GL,2); GAPB(o[0]=__builtin_amdgcn_mfma_f32_32x32x16_bf16(PAF(2),VFR(2),o[0],0,0,0), C1,0); \
    KRD(GL,3); GAPB(o[1]=__builtin_amdgcn_mfma_f32_32x32x16_bf16(PAF(2),VFR(6),o[1],0,0,0), C1,4); \
    GAPB(o[0]=__builtin_amdgcn_mfma_f32_32x32x16_bf16(PAF(3),VFR(3),o[0],0,0,0), C1,8); \
    GAPB(o[1]=__builtin_amdgcn_mfma_f32_32x32x16_bf16(PAF(3),VFR(7),o[1],0,0,0), C1,12); \
    }while(0)
  int t=1;
  #undef CMASK
  #define CMASK(P0,P1,t) do{}while(0)
  for(;t+5<NT;t+=2){
    STEP(pB0,pB1,pA0,pA1,t,true,true,true);     WAIT_BAR(2); RESC(); ROT();
    STEP(pA0,pA1,pB0,pB1,t+1,true,true,true);   WAIT_BAR(2); RESC(); ROT();
  }
  #undef CMASK
  #define CMASK(P0,P1,t) do{}while(0)
  #define ENDW(tt) do{ if((tt)+3<NT){WAIT_BAR(2);} else if((tt)+2<NT){WAIT_BAR(1);} else {WAIT_BAR(0);} }while(0)
  for(;t+1<NT;t+=2){
    STEP(pB0,pB1,pA0,pA1,t,(t+3<NT),(t+1<NT),(t+1<NT));       ENDW(t);   RESC(); ROT();
    STEP(pA0,pA1,pB0,pB1,t+1,(t+4<NT),(t+2<NT),(t+2<NT));     ENDW(t+1); RESC(); ROT();
  }
  STEP(pB0,pB1,pA0,pA1,NT-1,false,false,false); RESC();
  { float sacc=pB0[0]+pB0[1]; _Pragma("unroll") for(int r=2;r<16;++r)sacc+=pB0[r]; _Pragma("unroll") for(int r=0;r<16;++r)sacc+=pB1[r]; l_reg+=sacc;
    pw0=(u32x4){PKW(pB0,0),PKW(pB0,2),PKW(pB0,4),PKW(pB0,6)};pw1=(u32x4){PKW(pB0,8),PKW(pB0,10),PKW(pB0,12),PKW(pB0,14)};pw2=(u32x4){PKW(pB1,0),PKW(pB1,2),PKW(pB1,4),PKW(pB1,6)};pw3=(u32x4){PKW(pB1,8),PKW(pB1,10),PKW(pB1,12),PKW(pB1,14)};
    SBAR(); pv(o,vb0+sl_cur,PAF(0),PAF(1),PAF(2),PAF(3)); }
  #undef PKW
  #undef PAF
  #undef VFR
  #undef PIN
  #undef MX3
  #undef GAPA
  #undef GAPB
  #undef EX
  #undef VRD
  #undef KRD
  #undef STEP
  #undef ENDW
  {auto rr=__builtin_amdgcn_permlane32_swap(__float_as_uint(l_reg),__float_as_uint(l_reg),false,false);l_reg=__uint_as_float(rr[0])+__uint_as_float(rr[1]);}
  if(hi==0)wsf[32+r32]=l_reg;asm volatile("s_waitcnt lgkmcnt(0)":::"memory");
  float rli[16];
  #pragma unroll
  for(int r=0;r<16;++r)rli[r]=__builtin_amdgcn_rcpf(wsf[32+crow(r,hi)]);
  bf16*Ow=O+(rowbase+q0+wid*QBLK)*QP+h*D;
  { bf16*stg=(bf16*)(shm+LDS_OST)+wid*2048;
    #pragma unroll
    for(int r=0;r<16;++r){const int orow=crow(r,hi);
      #pragma unroll
      for(int d0=0;d0<2;++d0)stg[orow*64+d0*32+r32]=__float2bfloat16(o[d0][r]*rli[r]);}
    asm volatile("s_waitcnt lgkmcnt(0)":::"memory");
    #pragma unroll
    for(int i=0;i<4;++i){const int row=i*8+(lane>>3),ch=lane&7; const u32x4 v=*(const u32x4*)(stg+row*64+ch*8); ATTN_STORE16(Ow+(long)row*QP+ch*8,v);} }
  asm volatile("s_waitcnt lgkmcnt(0)\n\ts_barrier":::"memory");
  #undef DMA_K
  #undef DMA_V
  #undef CMASK
  #undef START
  #undef RESC
  #undef ROT
}
constexpr int ATTN_LDS_BYTES=LDS_BYTES;
struct AttnTensors { const bf16* Q; const bf16* K; const bf16* V; bf16* O; };
template<int THRL=8> __device__ __forceinline__ void attn_phase(char*lds,const AttnTensors&T,int vcu,int G){
  for(int i=0;;++i){
    int u;
    if(G==256){ if(i>=6)break; u=(i<4)?(4*vcu+i):(1024+2*vcu+(i-4)); }
    else{ u=vcu+i*G; if(u>=1536)break; }
    long rowbase; int h,qb,NT;
    if(u<1024){ const int bh=u>>5; qb=u&31; rowbase=(long)(bh>>3)*8192; h=bh&7; NT=128; }
    else { const int v=u-1024; const int bh=v>>4; qb=v&15; rowbase=32768+(long)(bh>>3)*4096; h=bh&7; NT=64; }
    attn_unit<THRL>(rowbase,h,qb,NT,T.Q,T.K,T.V,T.O,lds);
  }
}
#undef SBAR
#undef WAIT_BAR
}
#ifndef PH_MASK
#define PH_MASK 0x3ff
#endif
#define PH(k) if constexpr ((PH_MASK >> (k)) & 1)
constexpr int NWAVES = 8;
constexpr int RING_BYTES = 131072, LDS_BYTES = 147456;

#define LAS __attribute__((address_space(3)))
typedef unsigned short bf16;
typedef unsigned v4u __attribute__((ext_vector_type(4)));
typedef float f32x4 __attribute__((ext_vector_type(4)));
#define LDS_WAIT() asm volatile("s_waitcnt lgkmcnt(0)" ::: "memory")
__device__ __forceinline__ unsigned f2bf(float f) { unsigned u = __builtin_bit_cast(unsigned, f); return (u + 0x7fffu + ((u >> 16) & 1u)) >> 16; }
__device__ __forceinline__ unsigned pk2(float lo, float hi) { return f2bf(lo) | (f2bf(hi) << 16); }
__device__ __forceinline__ float wave_sum(float v) {
#pragma unroll
    for (int o = 1; o < 64; o <<= 1) v += __shfl_xor(v, o);
    return v;
}
__device__ __forceinline__ void transpose_item(const float* W, int ldw, int src_col0, int k0, bf16* WT, int K, int dst_row0, LAS float* scr, int lane) {
    float tv[32];
    const float* wp = W + (size_t)(k0 + (lane >> 5)) * ldw + src_col0 + (lane & 31);
#pragma unroll
    for (int i = 0; i < 32; ++i) tv[i] = wp[(size_t)(2 * i) * ldw];
#pragma unroll
    for (int i = 0; i < 32; ++i) { const int kk = 2 * i + (lane >> 5); scr[kk * 33 + (lane & 31)] = tv[i]; }
    LDS_WAIT(); asm volatile("" ::: "memory");
    const int c = lane & 7;
#pragma unroll
    for (int j = 0; j < 4; ++j) { const int n = (lane >> 3) + 8 * j; const LAS float* s = scr + (8 * c) * 33 + n;
        v4u o; o.x = pk2(s[0 * 33], s[1 * 33]); o.y = pk2(s[2 * 33], s[3 * 33]); o.z = pk2(s[4 * 33], s[5 * 33]); o.w = pk2(s[6 * 33], s[7 * 33]);
        *(v4u*)(WT + (size_t)(dst_row0 + n) * K + k0 + 8 * c) = o; }
    LDS_WAIT(); asm volatile("" ::: "memory");
}

template <int W> __device__ __forceinline__ void pool_item(const bf16* Zb, bf16* PL, int row, int ch) {
    constexpr int left = W / 2;
    const int T = row < MP ? 8192 : 4096, t = row < MP ? (row & 8191) : ((row - MP) & 4095);
    const bf16* zp = Zb + (size_t)(row - t) * 512 + ch * 8;
    v4u q[W];
#pragma unroll
    for (int k = 0; k < W; ++k) { int tt = t - left + k; tt = tt < 0 ? 0 : (tt > T - 1 ? T - 1 : tt); q[k] = *(const v4u*)(zp + (size_t)tt * 512); }
    float a[8];
#pragma unroll
    for (int e = 0; e < 8; ++e) a[e] = 0.f;
#pragma unroll
    for (int k = 0; k < W; ++k) { const int tt = t - left + k; const float wv = (tt >= 0 && tt < T) ? 1.f : 0.f;
        a[0] += wv * pg8::bf_lo(q[k].x); a[1] += wv * pg8::bf_hi(q[k].x); a[2] += wv * pg8::bf_lo(q[k].y); a[3] += wv * pg8::bf_hi(q[k].y);
        a[4] += wv * pg8::bf_lo(q[k].z); a[5] += wv * pg8::bf_hi(q[k].z); a[6] += wv * pg8::bf_lo(q[k].w); a[7] += wv * pg8::bf_hi(q[k].w); }
    const int lo = (t - left) > 0 ? (t - left) : 0, hi = (t + W - 1 - left) < (T - 1) ? (t + W - 1 - left) : (T - 1);
    const float ic = 1.0f / (float)(hi - lo + 1); const v4u s = q[left];
    v4u o; o.x = pk2(a[0] * ic - pg8::bf_lo(s.x), a[1] * ic - pg8::bf_hi(s.x)); o.y = pk2(a[2] * ic - pg8::bf_lo(s.y), a[3] * ic - pg8::bf_hi(s.y));
    o.z = pk2(a[4] * ic - pg8::bf_lo(s.z), a[5] * ic - pg8::bf_hi(s.z)); o.w = pk2(a[6] * ic - pg8::bf_lo(s.w), a[7] * ic - pg8::bf_hi(s.w));
    *(v4u*)(PL + (size_t)row * 512 + ch * 8) = o;
}
struct Args { const float* in[25]; float* out; unsigned char* ws; };
static_assert(sizeof(Args) == 27 * 8, "Args has no padding");

__device__ __forceinline__ void gateup_items(int r, const float* Wg, const float* Wu, bf16* WT, LAS float* scr, int lane) {
    const int kb = r / 176, G = r % 176, tile = G >> 3, w = G & 7;
    transpose_item((w < 4) ? Wg : Wu, DFF, tile * 128 + (w & 3) * 32, kb * 64, WT, 1024, G * 32, scr, lane);
}

__global__ void __launch_bounds__(NWAVES * 64, 2) fwd_mega(Args args) {
    extern __shared__ __attribute__((aligned(16))) unsigned char lds[];
    cg::grid_group grid = cg::this_grid();
    const int tid = threadIdx.x, lane = tid & 63, wave = __builtin_amdgcn_readfirstlane(tid >> 6);
    const int G = gridDim.x, bx = blockIdx.x, vcu = (G % 8 == 0) ? (bx % 8) * (G / 8) + bx / 8 : bx;
    unsigned char* ws = args.ws;
    LAS unsigned char* ldsp = (LAS unsigned char*)lds;
    const float* x_p = args.in[0]; const float* x_s = args.in[1]; const float* p_p = args.in[2]; const float* p_s = args.in[3];
    float* out = args.out;
    float* SS = (float*)(ws + WS_SS); float* SSE = (float*)(ws + WS_SSE);
    bf16* W1 = (bf16*)(ws + WS_W1); bf16* WD1 = (bf16*)(ws + WS_WD1); bf16* WIN = (bf16*)(ws + WS_WIN); bf16* WUA = (bf16*)(ws + WS_WUA); bf16* WPC = (bf16*)(ws + WS_WPC);
    bf16* WOUT = (bf16*)(ws + WS_WOUT); bf16* W2 = (bf16*)(ws + WS_W2); bf16* WD2 = (bf16*)(ws + WS_WD2); bf16* WPG = (bf16*)(ws + WS_WPG); bf16* WPP = (bf16*)(ws + WS_WPP);
    bf16* HB = (bf16*)(ws + WS_HB); bf16* ACT = (bf16*)(ws + WS_ACT); bf16* QO = (bf16*)(ws + WS_QO); bf16* Zb = (bf16*)(ws + WS_Z); bf16* PL = (bf16*)(ws + WS_PL);
    bf16* MX = (bf16*)(ws + WS_MX); bf16* KB = (bf16*)(ws + WS_K); bf16* VB = (bf16*)(ws + WS_V); bf16* PB = (bf16*)(ws + WS_PB); bf16* SGB = (bf16*)(ws + WS_SGB); bf16* EB = (bf16*)(ws + WS_E);
    const int gw = vcu * NWAVES + wave, NGW = G * NWAVES;
    const int gt = bx * (NWAVES * 64) + tid, NGT = G * NWAVES * 64;

    PH(0) {
        LAS float* scr = (LAS float*)(ldsp + wave * 16384);
        constexpr int I1 = 16 * 176, I2 = 44 * 32, I3 = 16 * 104, I4 = 8 * 32, I6 = 16 * 32, I10 = 4 * 32;
        constexpr int NITEMS = 2 * I1 + 2 * I2 + I3 + I4 + 2 * I6 + I10;
        for (int it = gw; it < NITEMS; it += NGW) {
            int r = it;
            if (r < I1) { gateup_items(r, args.in[5], args.in[6], W1, scr, lane); continue; } r -= I1;
            if (r < I1) { gateup_items(r, args.in[18], args.in[19], W2, scr, lane); continue; } r -= I1;
            if (r < I2) { transpose_item(args.in[7], 1024, (r % 32) * 32, (r / 32) * 64, WD1, DFF, (r % 32) * 32, scr, lane); continue; } r -= I2;
            if (r < I2) { transpose_item(args.in[20], 1024, (r % 32) * 32, (r / 32) * 64, WD2, DFF, (r % 32) * 32, scr, lane); continue; } r -= I2;
            if (r < I3) { const int kb = r / 104, Gp = r % 104; const int c0 = Gp < 24 ? ((Gp >> 3) * 256 + (Gp & 3) * 64 + ((Gp >> 2) & 1) * 32) : Gp * 32;
                transpose_item(args.in[9], INW, c0, kb * 64, WIN, 1024, Gp * 32, scr, lane); continue; } r -= I3;
            if (r < I4) { transpose_item(args.in[12], 1024, (r % 32) * 32, (r / 32) * 64, WUA, 512, (r % 32) * 32, scr, lane); continue; } r -= I4;
            if (r < I6) { transpose_item(args.in[16], 1024, (r % 32) * 32, (r / 32) * 64, WOUT, 1024, (r % 32) * 32, scr, lane); continue; } r -= I6;
            if (r < I6) { transpose_item(args.in[22], 1024, (r % 32) * 32, (r / 32) * 64, WPG, 1024, (r % 32) * 32, scr, lane); continue; } r -= I6;
            transpose_item(args.in[23], 1024, (r % 32) * 32, (r / 32) * 64, WPP, PLE, (r % 32) * 32, scr, lane);
        }
        if (gt < 128) ((float*)(ws + WS_GQK))[gt] = gt < 64 ? args.in[10][gt] : args.in[11][gt - 64];
        { const float* pw = args.in[13]; const float* psc = args.in[14]; const float* wup = args.in[15];
          for (int idx = gt; idx < 128 * 1024; idx += NGT) { const int d = idx & 1023, c0 = (idx >> 10) * 4, g0 = c0 & ~127; float a0 = 0.f, a1 = 0.f, a2 = 0.f, a3 = 0.f;
              const float* pr = pw + (size_t)c0 * 128; const float* bp = wup + (size_t)g0 * 1024 + d;
#pragma unroll 16
              for (int j = 0; j < 128; ++j) { const float b = bp[(size_t)j * 1024] * psc[g0 + j]; a0 += pr[j] * b; a1 += pr[128 + j] * b; a2 += pr[256 + j] * b; a3 += pr[384 + j] * b; }
              *(unsigned long long*)(WPC + (size_t)d * 512 + c0) = (unsigned long long)pk2(a0, a1) | ((unsigned long long)pk2(a2, a3) << 32); } }
        { const float* g1 = args.in[4]; f32x4 gv[4];
#pragma unroll
          for (int j = 0; j < 4; ++j) gv[j] = ((const f32x4*)g1)[lane + 64 * j];
          for (int m0 = gw * 4; m0 < MTOT; m0 += NGW * 4) { const float* xr = m0 < MP ? x_p + (size_t)m0 * 1024 : x_s + (size_t)(m0 - MP) * 1024;
              f32x4 v[4][4]; float s[4];
#pragma unroll
              for (int r = 0; r < 4; ++r)
#pragma unroll
                  for (int j = 0; j < 4; ++j) v[r][j] = ((const f32x4*)(xr + r * 1024))[lane + 64 * j];
#pragma unroll
              for (int r = 0; r < 4; ++r) { s[r] = 0.f;
#pragma unroll
                  for (int j = 0; j < 4; ++j) s[r] += (v[r][j].x * v[r][j].x + v[r][j].y * v[r][j].y) + (v[r][j].z * v[r][j].z + v[r][j].w * v[r][j].w); }
#pragma unroll
              for (int r = 0; r < 4; ++r) { const float rstd = rsqrtf(wave_sum(s[r]) * (1.f / 1024.f) + EPSN);
                  unsigned long long* o8 = (unsigned long long*)(HB + (size_t)(m0 + r) * 1024) + lane;
#pragma unroll
                  for (int j = 0; j < 4; ++j) { const f32x4 y = v[r][j] * rstd * gv[j]; o8[64 * j] = (unsigned long long)pk2(y.x, y.y) | ((unsigned long long)pk2(y.z, y.w) << 32); } } } }
    }
    grid.sync();

    PH(1) { pg8::Gemm g{HB, W1, MTOT, 2 * DFF, 1024}; pg8::StaticOrder S; S.init(MTOT, 2 * DFF, G, bx);
      pg8::EpiGateUp<false> E{ACT, DFF, nullptr};
      pg8::gemm_phase<pg8::EpiGateUp<false>, pg8::StaticOrder, true, true>(ldsp, g, S, E); }
    grid.sync();
    PH(2) { pg8::Gemm g{ACT, WD1, MTOT, 1024, DFF}; pg8::StaticOrder S; S.init(MTOT, 1024, G, bx);
      pg8::EpiResid E{x_p, x_s, out, HB, args.in[8], SS, 0.5f};
      pg8::gemm_phase<pg8::EpiResid, pg8::StaticOrder, true, true>(ldsp, g, S, E); }
    grid.sync();
    PH(3) { pg8::Gemm g{HB, WIN, MTOT, INW, 1024}; pg8::StaticOrder S; S.init(MTOT, INW, G, bx);
      pg8::EpiWin E{SS, (const float*)(ws + WS_GQK), ws, attn_body::C2};
      pg8::gemm_phase<pg8::EpiWin, pg8::StaticOrder, true, true>(ldsp, g, S, E); }
    grid.sync();
    PH(4) {
      for (int wi = gw; wi < MTOT; wi += NGW) { const int grp = wi & 3, row = (wi >> 2) * 4 + (lane >> 4), ch = grp * 16 + (lane & 15);
          if (grp == 0) pool_item<2>(Zb, PL, row, ch); else if (grp == 1) pool_item<4>(Zb, PL, row, ch); else if (grp == 2) pool_item<8>(Zb, PL, row, ch); else pool_item<16>(Zb, PL, row, ch); }
      asm volatile("s_waitcnt vmcnt(0)" ::: "memory"); __syncthreads();
      const attn_body::AttnTensors AT{(const attn_body::bf16*)QO, (const attn_body::bf16*)KB, (const attn_body::bf16*)VB, (attn_body::bf16*)QO};
      attn_body::attn_phase<8>((char*)lds, AT, vcu, G); }
    grid.sync();
    PH(5) { for (int idx = gt; idx < MTOT * 32; idx += NGT) { const int row = idx >> 5, ch = idx & 31; const float* pr = (row < MP ? p_p + (size_t)row * PLE : p_s + (size_t)(row - MP) * PLE) + ch * 8;
          const f32x4 a = *(const f32x4*)pr, b = *(const f32x4*)(pr + 4); v4u o; o.x = pk2(a.x, a.y); o.y = pk2(a.z, a.w); o.z = pk2(b.x, b.y); o.w = pk2(b.z, b.w);
          *(v4u*)(PB + (size_t)row * PLE + ch * 8) = o; }
      asm volatile("s_waitcnt vmcnt(0)" ::: "memory"); __syncthreads();
      pg8::StaticOrder S; S.init(MTOT, 1024, G, bx);
      { pg8::Gemm g{QO, WUA, MTOT, 1024, 512}; pg8::EpiGateMix<0> E{MX, SGB}; pg8::gemm_phase<pg8::EpiGateMix<0>, pg8::StaticOrder, true, true>(ldsp, g, S, E); }
      asm volatile("s_waitcnt vmcnt(0)" ::: "memory"); __syncthreads();
      { pg8::Gemm g{PL, WPC, MTOT, 1024, 512}; pg8::EpiGateMix<1> E{MX, SGB}; pg8::gemm_phase<pg8::EpiGateMix<1>, pg8::StaticOrder, true, true>(ldsp, g, S, E); } }
    grid.sync();
    PH(6) { pg8::StaticOrder S; S.init(MTOT, 1024, G, bx);
      { pg8::Gemm g{MX, WOUT, MTOT, 1024, 1024}; pg8::EpiResid E{out, out + (size_t)MP * 1024, out, HB, args.in[17], SS, 1.0f}; pg8::gemm_phase<pg8::EpiResid, pg8::StaticOrder, true, true>(ldsp, g, S, E); }
      asm volatile("s_waitcnt vmcnt(0)" ::: "memory"); __syncthreads();
      { pg8::Gemm g{PB, WPP, MTOT, 1024, PLE}; pg8::EpiE E{EB, SSE}; pg8::gemm_phase<pg8::EpiE, pg8::StaticOrder, true, true>(ldsp, g, S, E); } }
    grid.sync();
    PH(7) { pg8::Gemm g{HB, W2, MTOT, 2 * DFF, 1024}; pg8::StaticOrder S; S.init(MTOT, 2 * DFF, G, bx);
      pg8::EpiGateUp<true> E{ACT, DFF, SS};
      pg8::gemm_phase<pg8::EpiGateUp<true>, pg8::StaticOrder, true, true>(ldsp, g, S, E); }
    grid.sync();
    PH(8) { pg8::Gemm g{ACT, WD2, MTOT, 1024, DFF}; pg8::StaticOrder S; S.init(MTOT, 1024, G, bx);
      pg8::EpiResid E{out, out + (size_t)MP * 1024, out, HB, args.in[21], SS, 0.5f};
      pg8::gemm_phase<pg8::EpiResid, pg8::StaticOrder, true, true>(ldsp, g, S, E); }
    grid.sync();
    PH(9) { pg8::Gemm g{HB, WPG, MTOT, 1024, 1024}; pg8::StaticOrder S; S.init(MTOT, 1024, G, bx);
      pg8::EpiFinal E{out, EB, SS, SSE, args.in[24]};
      pg8::gemm_phase<pg8::EpiFinal, pg8::StaticOrder, true, true>(ldsp, g, S, E); }
}

extern "C" void kernel_launch(void* const* d_in, const int* in_sizes, int n_in, void* d_out, int out_size, void* d_ws, size_t ws_size, hipStream_t stream) {
    static int grid = 0;
    if (grid == 0) {
        if (n_in != 25 || out_size != MTOT * 1024 || ws_size < WS_END) { fprintf(stderr, "kernel_launch: unexpected problem (n_in %d, out %d, ws %zu); nothing launched\n", n_in, out_size, ws_size); grid = -1; return; }
        int dev = 0, cus = 0, per_cu = 0;
        if (hipGetDevice(&dev) != hipSuccess || hipDeviceGetAttribute(&cus, hipDeviceAttributeMultiprocessorCount, dev) != hipSuccess) { grid = -1; return; }
        if (hipFuncSetAttribute((const void*)fwd_mega, hipFuncAttributeMaxDynamicSharedMemorySize, LDS_BYTES) != hipSuccess) { fprintf(stderr, "kernel_launch: hipFuncSetAttribute failed\n"); grid = -1; return; }
        if (hipOccupancyMaxActiveBlocksPerMultiprocessor(&per_cu, (const void*)fwd_mega, NWAVES * 64, LDS_BYTES) != hipSuccess || per_cu < 1) { fprintf(stderr, "kernel_launch: occupancy query says %d blocks per CU\n", per_cu); (void)hipGetLastError(); }
        grid = cus;
    }
    if (grid < 0) return;
    Args a{};
    for (int i = 0; i < 25; ++i) a.in[i] = (const float*)d_in[i];
    a.out = (float*)d_out; a.ws = (unsigned char*)d_ws;
    void* kargs[] = {&a};
    const hipError_t e = hipLaunchCooperativeKernel((const void*)fwd_mega, dim3(grid), dim3(NWAVES * 64), kargs, LDS_BYTES, stream);
    if (e != hipSuccess) fprintf(stderr, "kernel_launch: cooperative launch failed: %s (grid %d)\n", hipGetErrorString(e), grid);
}
```

```cpp
#include <hip/hip_runtime.h>
#include <hip/hip_cooperative_groups.h>
#include <hip/hip_bf16.h>
#include <cstdio>
#include <cstdint>
#include <cmath>
namespace cg = cooperative_groups;

constexpr int DMODEL = 1024, MP = 4 * 8192, MS = 4 * 4096, MTOT = MP + MS;
constexpr int DFF = 2816, INW = 3328, PLE = 256;
constexpr float EPSN = 1e-6f;
constexpr size_t HK = 512u * 1024u;
constexpr size_t WS_GQK = 1 * HK;
constexpr size_t WS_SS = 2 * HK, WS_SSE = 8 * HK;
constexpr size_t WS_W1 = 16 * HK, WS_WD1 = 38 * HK, WS_WIN = 49 * HK, WS_WUA = 62 * HK, WS_WPC = 64 * HK, WS_WOUT = 66 * HK, WS_W2 = 70 * HK, WS_WD2 = 92 * HK, WS_WPG = 103 * HK, WS_WPP = 107 * HK;
constexpr size_t WS_HB = 112 * HK;
constexpr size_t WS_ACT = 304 * HK;
constexpr size_t WS_QO = WS_ACT, WS_Z = WS_ACT + 96 * HK, WS_PL = WS_ACT + 192 * HK, WS_MX = WS_ACT + 288 * HK, WS_K = WS_ACT + 480 * HK, WS_V = WS_ACT + 504 * HK, WS_PB = WS_K;
constexpr size_t WS_SGB = 832 * HK, WS_E = WS_SGB, WS_END = 1024 * HK;
static_assert(WS_WPP + 1024 * 256 * 2 <= WS_HB && WS_HB + (size_t)MTOT * 1024 * 2 <= WS_ACT && WS_ACT + (size_t)MTOT * DFF * 2 <= WS_SGB && WS_V + (size_t)MTOT * 128 * 2 <= WS_SGB && WS_SGB + (size_t)MTOT * 1024 * 2 <= WS_END, "d_ws map");
static_assert(WS_W1 + 5632 * 1024 * 2 <= WS_WD1 && WS_WD1 + 1024 * 2816 * 2 <= WS_WIN && WS_WIN + 3328 * 1024 * 2 <= WS_WUA && WS_W2 + 5632 * 1024 * 2 <= WS_WD2 && WS_WD2 + 1024 * 2816 * 2 <= WS_WPG && WS_WPG + 1024 * 1024 * 2 <= WS_WPP, "weights map");


namespace pg8 {
#define PG8_LAS __attribute__((address_space(3)))
typedef unsigned short bf16_t;
typedef short bf16x8 __attribute__((ext_vector_type(8)));
typedef float f32x4 __attribute__((ext_vector_type(4)));
typedef unsigned u32x4 __attribute__((ext_vector_type(4)));
constexpr int BM = 256, BK = 64, HALF = 128, HTB = HALF * BK * 2  , STAGE_BYTES = 8 * HTB, NXCD = 8, WGM = 8;

__host__ __device__ __forceinline__ int lds_byte(int r, int c) { const int st = (r >> 4) * 2 + (c >> 5), rr = r & 15, cc = c & 31, ob = rr * 64 + cc * 2; return st * 1024 + (ob ^ (((ob >> 9) & 1) << 5)); }
__host__ __device__ __forceinline__ void stage_rc(int b, int& R, int& C) { const int st = b / 1024, sb = b % 1024, swz = sb ^ (((sb >> 9) & 1) << 5); R = (st >> 1) * 16 + swz / 64; C = (st & 1) * 32 + (swz % 64) / 2; }
__host__ __device__ __forceinline__ int perm32(int rho) { const int n = rho >> 4, i = rho & 15; return 8 * (i >> 2) + 4 * n + (i & 3); }

struct Unit { int pm, pn, seg; };
struct Gemm { const bf16_t* A; const bf16_t* Bt; int M, N, K; long dA, dB; };

struct StaticOrder {
    int nM, nN, nwg, G, c;
    __host__ __device__ void init(int M, int N, int G_, int c_) { nM = M / BM; nN = N / BM; nwg = nM * nN; G = G_; c = c_; }
    __host__ __device__ bool next(int i, Unit& u) const {
        const long L = (long)i * G + c; if (L >= nwg) return false;
        int wgid = (int)L; { const int q = nwg / NXCD, r = nwg % NXCD, xcd = wgid % NXCD, off = wgid / NXCD; wgid = (xcd < r ? xcd * (q + 1) : r * (q + 1) + (xcd - r) * q) + off; }
        const int nig = WGM * nN, gid = wgid / nig, fm = gid * WGM, gsz = (nM - fm) < WGM ? (nM - fm) : WGM;
        u.pm = fm + ((wgid % nig) % gsz); u.pn = (wgid % nig) / gsz; u.seg = 0; return true;
    }
    __device__ __forceinline__ void a_ready(const Unit&) const {}
    __device__ __forceinline__ void done(const Unit&) const {}
};
struct SegOrder : StaticOrder {
    __host__ __device__ bool next(int i, Unit& u) const { const bool ok = StaticOrder::next(i >> 1, u); u.seg = i & 1; return ok; }
};
__device__ __forceinline__ unsigned cvt_pk_bf16(float lo, float hi) { unsigned r; asm volatile("v_cvt_pk_bf16_f32 %0, %1, %2" : "=v"(r) : "v"(lo), "v"(hi)); return r; }
typedef unsigned u32x2 __attribute__((ext_vector_type(2)));
__device__ __forceinline__ float bf_lo(unsigned w) { return __uint_as_float(w << 16); }
__device__ __forceinline__ float bf_hi(unsigned w) { return __uint_as_float(w & 0xffff0000u); }
__device__ __forceinline__ float sigm(float x) { return __builtin_amdgcn_rcpf(1.0f + __builtin_amdgcn_exp2f(-1.4426950408889634f * x)); }
__device__ __forceinline__ float row_rstd(const float* ss, int row) {
    const f32x4* p = (const f32x4*)(ss + (size_t)row * 16);
    const f32x4 a = p[0], b = p[1], c = p[2], d = p[3];
    const float s = (((a.x + a.y) + (a.z + a.w)) + ((b.x + b.y) + (b.z + b.w))) + (((c.x + c.y) + (c.z + c.w)) + ((d.x + d.y) + (d.z + d.w)));
    return rsqrtf(s * (1.0f / 1024.0f) + EPSN);
}

template <bool ROWSCALE> struct EpiGateUp {
    static constexpr bool PERM = true, AFTER_DRAIN = false, SEG = false;
    bf16_t* O; int ldc; const float* ss;
    __device__ __forceinline__ void operator()(const f32x4 (&acc)[2][2][4][2], const Unit& u, int wr, int wc, int fr, int fq) const {
        const int row0 = u.pm * BM + wr * 64 + fr, col0 = u.pn * HALF + wc * 32 + 8 * fq;
#pragma unroll
        for (int ai = 0; ai < 2; ++ai)
#pragma unroll
            for (int m = 0; m < 4; ++m) { const int row = row0 + ai * HALF + m * 16; const float rs = ROWSCALE ? row_rstd(ss, row) : 1.0f;
                float o[8];
#pragma unroll
                for (int n = 0; n < 2; ++n)
#pragma unroll
                    for (int e = 0; e < 4; ++e) { const float g = acc[ai][0][m][n][e] * rs, up = acc[ai][1][m][n][e] * rs; o[n * 4 + e] = g * sigm(g) * up; }
                u32x4 w; w.x = cvt_pk_bf16(o[0], o[1]); w.y = cvt_pk_bf16(o[2], o[3]); w.z = cvt_pk_bf16(o[4], o[5]); w.w = cvt_pk_bf16(o[6], o[7]);
                *(u32x4*)(O + (size_t)row * ldc + col0) = w; asm volatile("" ::: "memory"); __builtin_amdgcn_sched_barrier(0); }
    }
};

template <bool F32BASE> struct EpiResid {
    static constexpr bool PERM = true, AFTER_DRAIN = false, SEG = false;
    const float* base0; const float* base1; bf16_t* hb; float* ss; float alpha;
    __device__ __forceinline__ void operator()(const f32x4 (&acc)[2][2][4][2], const Unit& u, int wr, int wc, int fr, int fq) const {
        const int row0 = u.pm * BM + wr * 64 + fr, col0 = u.pn * BM + wc * 32 + 8 * fq;
#pragma unroll
        for (int ai = 0; ai < 2; ++ai)
#pragma unroll
            for (int m = 0; m < 4; ++m) { const int row = row0 + ai * HALF + m * 16; const size_t off = (size_t)row * DMODEL + col0; float s = 0.f;
#pragma unroll
                for (int bj = 0; bj < 2; ++bj) { const f32x4 c0 = acc[ai][bj][m][0], c1 = acc[ai][bj][m][1]; f32x4 b0, b1;
                    if (F32BASE) { const float* bp = (row < MP ? base0 + (size_t)row * DMODEL : base1 + (size_t)(row - MP) * DMODEL) + col0 + bj * HALF; b0 = *(const f32x4*)bp; b1 = *(const f32x4*)(bp + 4); }
                    else { const u32x4 w = *(const u32x4*)(hb + off + bj * HALF); b0 = (f32x4){bf_lo(w.x), bf_hi(w.x), bf_lo(w.y), bf_hi(w.y)}; b1 = (f32x4){bf_lo(w.z), bf_hi(w.z), bf_lo(w.w), bf_hi(w.w)}; }
                    const f32x4 v0 = b0 + c0 * alpha, v1 = b1 + c1 * alpha;
                    s += ((v0.x * v0.x + v0.y * v0.y) + (v0.z * v0.z + v0.w * v0.w)) + ((v1.x * v1.x + v1.y * v1.y) + (v1.z * v1.z + v1.w * v1.w));
                    u32x4 o; o.x = cvt_pk_bf16(v0.x, v0.y); o.y = cvt_pk_bf16(v0.z, v0.w); o.z = cvt_pk_bf16(v1.x, v1.y); o.w = cvt_pk_bf16(v1.z, v1.w);
                    *(u32x4*)(hb + off + bj * HALF) = o; }
                s += __shfl_xor(s, 16); s += __shfl_xor(s, 32);
                if (fq == 0) ss[(size_t)row * 16 + u.pn * 4 + wc] = s;
                asm volatile("" ::: "memory"); __builtin_amdgcn_sched_barrier(0); }
    }
};

struct EpiWin {
    static constexpr bool PERM = false, AFTER_DRAIN = false, SEG = false;
    const float* ss; const float* gqk; unsigned char* ws; float qscale;
    __device__ __forceinline__ void operator()(const f32x4 (&acc)[2][2][4][2], const Unit& u, int wr, int wc, int fr, int fq) const {
        const int row0 = u.pm * BM + wr * 64 + fr;
        const int pn = u.pn;
        const bool is_rope = (pn < 2) || (pn == 2 && wc < 2);
        if (is_rope) {
            const float* g = gqk + ((pn < 2) ? 0 : 64); const float osc = (pn < 2) ? qscale : 1.0f;
            bf16_t* dst = (bf16_t*)(ws + ((pn < 2) ? (WS_QO + (size_t)(pn * 4 + wc) * 128) : (WS_K + (size_t)wc * 128))); const int ld = (pn < 2) ? 512 : 128;
            float inv[4];
#pragma unroll
            for (int e = 0; e < 4; ++e) inv[e] = __builtin_amdgcn_exp2f(-(float)(4 * fq + e) * 0.8304820237218406f);
#pragma unroll
            for (int m = 0; m < 4; ++m)
#pragma unroll
                for (int ai = 0; ai < 2; ++ai) { const int row = row0 + ai * HALF + m * 16; const float rs = row_rstd(ss, row);
                    int t = row < MP ? (row & 8191) : ((row - MP) & 4095); asm volatile("" : "+v"(t));
                    float s = 0.f;
#pragma unroll
                    for (int bj = 0; bj < 2; ++bj)
#pragma unroll
                        for (int n = 0; n < 2; ++n) { const f32x4 a = acc[ai][bj][m][n]; s += (a.x * a.x + a.y * a.y) + (a.z * a.z + a.w * a.w); }
                    s += __shfl_xor(s, 16); s += __shfl_xor(s, 32);
                    s *= rs * rs;
                    const float r = rsqrtf(s * (1.0f / 64.0f) + EPSN) * rs * osc;
#pragma unroll
                    for (int bj = 0; bj < 2; ++bj) { const float pos = (float)(bj == 0 ? (t >> 6) : (t & 63));
                        const f32x4 x1 = acc[ai][bj][m][0] * r * *(const f32x4*)(g + bj * 32 + 4 * fq), x2 = acc[ai][bj][m][1] * r * *(const f32x4*)(g + bj * 32 + 16 + 4 * fq); f32x4 o1, o2;
#pragma unroll
                        for (int e = 0; e < 4; ++e) { const float ang = pos * inv[e]; const float c = __cosf(ang), sn = __sinf(ang); o1[e] = x1[e] * c - x2[e] * sn; o2[e] = x2[e] * c + x1[e] * sn; }
                        u32x2 w1, w2; w1.x = cvt_pk_bf16(o1.x, o1.y); w1.y = cvt_pk_bf16(o1.z, o1.w); w2.x = cvt_pk_bf16(o2.x, o2.y); w2.y = cvt_pk_bf16(o2.z, o2.w);
                        bf16_t* p = dst + (size_t)row * ld + bj * 32 + 4 * fq; *(u32x2*)p = w1; *(u32x2*)(p + 16) = w2; }
                    asm volatile("" ::: "memory"); __builtin_amdgcn_sched_barrier(0); }
        } else if (pn == 2) {
            bf16_t* dst = (bf16_t*)(ws + WS_V) + (wc - 2) * 64 + 4 * fq;
#pragma unroll
            for (int ai = 0; ai < 2; ++ai)
#pragma unroll
                for (int m = 0; m < 4; ++m) { const int row = row0 + ai * HALF + m * 16; const float rs = row_rstd(ss, row);
#pragma unroll
                    for (int bj = 0; bj < 2; ++bj)
#pragma unroll
                        for (int n = 0; n < 2; ++n) { const f32x4 v = acc[ai][bj][m][n] * rs; u32x2 w; w.x = cvt_pk_bf16(v.x, v.y); w.y = cvt_pk_bf16(v.z, v.w); *(u32x2*)(dst + (size_t)row * 128 + bj * 32 + n * 16) = w; }
                    asm volatile("" ::: "memory"); __builtin_amdgcn_sched_barrier(0); }
        } else {
            const bool sg = pn >= 5; const int ld = sg ? 1024 : 512; const int ct = pn < 5 ? pn - 3 : (pn < 9 ? pn - 5 : pn - 9);
            bf16_t* dst = (bf16_t*)(ws + (pn < 5 ? WS_Z : (pn < 9 ? WS_MX : WS_SGB))) + ct * 256 + wc * 32 + 4 * fq;
#pragma unroll
            for (int ai = 0; ai < 2; ++ai)
#pragma unroll
                for (int m = 0; m < 4; ++m) { const int row = row0 + ai * HALF + m * 16; const float rs = row_rstd(ss, row);
#pragma unroll
                    for (int bj = 0; bj < 2; ++bj)
#pragma unroll
                        for (int n = 0; n < 2; ++n) { f32x4 v = acc[ai][bj][m][n] * rs; if (sg) { v.x = sigm(v.x); v.y = sigm(v.y); v.z = sigm(v.z); v.w = sigm(v.w); }
                            u32x2 w; w.x = cvt_pk_bf16(v.x, v.y); w.y = cvt_pk_bf16(v.z, v.w); *(u32x2*)(dst + (size_t)row * ld + bj * HALF + n * 16) = w; }
                    asm volatile("" ::: "memory"); __builtin_amdgcn_sched_barrier(0); }
        }
    }
};

struct EpiGateMix {
    static constexpr bool PERM = true, AFTER_DRAIN = false, SEG = true;
    bf16_t* Mx; const bf16_t* SGB;
    __device__ __forceinline__ void operator()(f32x4 (&acc)[2][2][4][2], const Unit& u, int wr, int wc, int fr, int fq) const {
        const int row0 = u.pm * BM + wr * 64 + fr, col0 = u.pn * BM + wc * 32 + 8 * fq;
#pragma unroll
        for (int ai = 0; ai < 2; ++ai)
#pragma unroll
            for (int m = 0; m < 4; ++m) { const size_t off = (size_t)(row0 + ai * HALF + m * 16) * DMODEL + col0;
#pragma unroll
                for (int bj = 0; bj < 2; ++bj) { const u32x4 g = *(const u32x4*)(SGB + off + bj * HALF);
                    f32x4 g0 = (f32x4){bf_lo(g.x), bf_hi(g.x), bf_lo(g.y), bf_hi(g.y)}, g1 = (f32x4){bf_lo(g.z), bf_hi(g.z), bf_lo(g.w), bf_hi(g.w)};
                    if (u.seg == 0) { const u32x4 a = *(const u32x4*)(Mx + off + bj * HALF);
                        const f32x4 a0 = (f32x4){bf_lo(a.x), bf_hi(a.x), bf_lo(a.y), bf_hi(a.y)}, a1 = (f32x4){bf_lo(a.z), bf_hi(a.z), bf_lo(a.w), bf_hi(a.w)};
#pragma unroll
                        for (int e = 0; e < 4; ++e) { acc[ai][bj][m][0][e] *= a0[e] * __builtin_amdgcn_rcpf(g0[e]); acc[ai][bj][m][1][e] *= a1[e] * __builtin_amdgcn_rcpf(g1[e]); } }
                    else { const f32x4 v0 = acc[ai][bj][m][0] * g0, v1 = acc[ai][bj][m][1] * g1;
                        u32x4 w; w.x = cvt_pk_bf16(v0.x, v0.y); w.y = cvt_pk_bf16(v0.z, v0.w); w.z = cvt_pk_bf16(v1.x, v1.y); w.w = cvt_pk_bf16(v1.z, v1.w);
                        *(u32x4*)(Mx + off + bj * HALF) = w; } }
                asm volatile("" ::: "memory"); }
    }
};

struct EpiE {
    static constexpr bool PERM = true, AFTER_DRAIN = false, SEG = false;
    bf16_t* E; float* ss;
    __device__ __forceinline__ void operator()(const f32x4 (&acc)[2][2][4][2], const Unit& u, int wr, int wc, int fr, int fq) const {
        const int row0 = u.pm * BM + wr * 64 + fr, col0 = u.pn * BM + wc * 32 + 8 * fq;
#pragma unroll
        for (int ai = 0; ai < 2; ++ai)
#pragma unroll
            for (int m = 0; m < 4; ++m) { const int row = row0 + ai * HALF + m * 16; float s = 0.f;
#pragma unroll
                for (int bj = 0; bj < 2; ++bj) { const f32x4 c0 = acc[ai][bj][m][0], c1 = acc[ai][bj][m][1];
                    s += ((c0.x * c0.x + c0.y * c0.y) + (c0.z * c0.z + c0.w * c0.w)) + ((c1.x * c1.x + c1.y * c1.y) + (c1.z * c1.z + c1.w * c1.w));
                    u32x4 w; w.x = cvt_pk_bf16(c0.x, c0.y); w.y = cvt_pk_bf16(c0.z, c0.w); w.z = cvt_pk_bf16(c1.x, c1.y); w.w = cvt_pk_bf16(c1.z, c1.w);
                    *(u32x4*)(E + (size_t)row * DMODEL + col0 + bj * HALF) = w; }
                s += __shfl_xor(s, 16); s += __shfl_xor(s, 32);
                if (fq == 0) ss[(size_t)row * 16 + u.pn * 4 + wc] = s; }
    }
};

struct EpiFinal {
    static constexpr bool PERM = true, AFTER_DRAIN = false, SEG = false;
    float* out; const bf16_t* hb; const bf16_t* E; const float* ss; const float* sse; const float* gpost;
    __device__ __forceinline__ void operator()(const f32x4 (&acc)[2][2][4][2], const Unit& u, int wr, int wc, int fr, int fq) const {
        const int row0 = u.pm * BM + wr * 64 + fr, col0 = u.pn * BM + wc * 32 + 8 * fq;
        f32x4 gv[2][2];
#pragma unroll
        for (int bj = 0; bj < 2; ++bj)
#pragma unroll
            for (int n = 0; n < 2; ++n) gv[bj][n] = *(const f32x4*)(gpost + col0 + bj * HALF + n * 4);
#pragma unroll
        for (int ai = 0; ai < 2; ++ai)
#pragma unroll
            for (int m = 0; m < 4; ++m) { const int row = row0 + ai * HALF + m * 16; const float rs = row_rstd(ss, row), re = row_rstd(sse, row);
                const size_t off = (size_t)row * DMODEL + col0;
#pragma unroll
                for (int bj = 0; bj < 2; ++bj) { const u32x4 hw = *(const u32x4*)(hb + off + bj * HALF), ew = *(const u32x4*)(E + off + bj * HALF);
                    const f32x4 h0 = (f32x4){bf_lo(hw.x), bf_hi(hw.x), bf_lo(hw.y), bf_hi(hw.y)}, h1 = (f32x4){bf_lo(hw.z), bf_hi(hw.z), bf_lo(hw.w), bf_hi(hw.w)};
                    const f32x4 e0 = (f32x4){bf_lo(ew.x), bf_hi(ew.x), bf_lo(ew.y), bf_hi(ew.y)} * re * gv[bj][0], e1 = (f32x4){bf_lo(ew.z), bf_hi(ew.z), bf_lo(ew.w), bf_hi(ew.w)} * re * gv[bj][1];
                    const f32x4 a0 = acc[ai][bj][m][0] * rs, a1 = acc[ai][bj][m][1] * rs; f32x4 y0, y1;
#pragma unroll
                    for (int e = 0; e < 4; ++e) { y0[e] = h0[e] + sigm(a0[e]) * e0[e]; y1[e] = h1[e] + sigm(a1[e]) * e1[e]; }
                    *(f32x4*)(out + off + bj * HALF) = y0; *(f32x4*)(out + off + bj * HALF + 4) = y1; }
                asm volatile("" ::: "memory"); __builtin_amdgcn_sched_barrier(0); }
    }
};

template <class Epi, class Sched, bool ALIGN_EPI = false, bool SP2 = false>
__device__ __forceinline__ void gemm_phase(PG8_LAS unsigned char* lds, const Gemm g, const Sched& S, const Epi& E) {
    int tid = threadIdx.x; asm volatile("" : "+v"(tid));
    const int wid = __builtin_amdgcn_readfirstlane(tid >> 6), lane = tid & 63, wr = wid >> 2, wc = wid & 3, fr = lane & 15, fq = lane >> 4;
    const int K = g.K, nt = K / BK;
    unsigned voffA[2], voffB[2];
#pragma unroll
    for (int i = 0; i < 2; ++i) { int R, C; stage_rc(tid * 16 + i * 8192, R, C); const int Rb = Epi::PERM ? ((R & ~31) + perm32(R & 31)) : R;
        voffA[i] = (unsigned)(R * K + C) * 2u; voffB[i] = (unsigned)(Rb * K + C) * 2u; }
    const size_t kstep = (size_t)(BK * 2);
    const size_t hstep = (size_t)HALF * K * 2;
    const size_t tstep = 2 * hstep;
    const unsigned ldsw = (unsigned)wid * 1024u;
    const int aoff = lds_byte(wr * 64 + fr, fq * 8), boff = lds_byte(wc * 32 + fr, fq * 8);
#define PG8_SA(b, h) (((b) * 2 + (h)) * HTB)
#define PG8_SB(b, h) ((4 + (b) * 2 + (h)) * HTB)
#define PG8_STAGE(bufoff, gbase, voff) do { _Pragma("unroll") for (int _i = 0; _i < 2; ++_i) \
        __builtin_amdgcn_global_load_lds((const unsigned*)((const char*)(gbase) + (voff)[_i]), (PG8_LAS unsigned*)(lds + (bufoff) + ldsw + _i * 8192), 16, 0, 0); } while (0)
#define PG8_LDA(dst, b, h) do { _Pragma("unroll") for (int m = 0; m < 4; ++m) _Pragma("unroll") for (int k = 0; k < 2; ++k) dst[m][k] = *(const PG8_LAS bf16x8*)(lds + PG8_SA(b, h) + aoff + m * 2048 + k * 1024); } while (0)
#define PG8_LDB(dst, b, h) do { _Pragma("unroll") for (int n = 0; n < 2; ++n) _Pragma("unroll") for (int k = 0; k < 2; ++k) dst[n][k] = *(const PG8_LAS bf16x8*)(lds + PG8_SB(b, h) + boff + n * 2048 + k * 1024); } while (0)
#define PG8_MMA(ai, bj, At, Bt) do { __builtin_amdgcn_s_setprio(1); _Pragma("unroll") for (int m = 0; m < 4; ++m) _Pragma("unroll") for (int n = 0; n < 2; ++n) _Pragma("unroll") for (int k = 0; k < 2; ++k) \
        acc[ai][bj][m][n] = __builtin_amdgcn_mfma_f32_16x16x32_bf16(Bt[n][k], At[m][k], acc[ai][bj][m][n], 0, 0, 0); __builtin_amdgcn_s_setprio(0); } while (0)
#define PG8_WAIT_V(n) asm volatile("s_waitcnt vmcnt(" #n ")" ::: "memory")
#define PG8_WAIT_L(n) asm volatile("s_waitcnt lgkmcnt(" #n ")" ::: "memory")
#define PG8_BAR __builtin_amdgcn_s_barrier()
#define PG8_SCHED __builtin_amdgcn_sched_barrier(0)
    Unit cur, nxt; int ui = 0;
    if (!S.next(0, cur)) return;
    f32x4 acc[2][2][4][2];
#pragma unroll
    for (int a = 0; a < 2; ++a)
#pragma unroll
        for (int b = 0; b < 2; ++b)
#pragma unroll
            for (int m = 0; m < 4; ++m)
#pragma unroll
                for (int n = 0; n < 2; ++n) acc[a][b][m][n] = (f32x4){0.f, 0.f, 0.f, 0.f};
    bf16x8 At[4][2], B0[2][2], B1[2][2];
    const char* cA = (const char*)g.A + (size_t)cur.pm * tstep + (size_t)cur.seg * g.dA; const char* cB = (const char*)g.Bt + (size_t)cur.pn * tstep + (size_t)cur.seg * g.dB;
    S.a_ready(cur);
    if constexpr (SP2) {
        PG8_STAGE(PG8_SB(0, 0), cB, voffB); PG8_STAGE(PG8_SB(0, 1), cB + hstep, voffB); PG8_STAGE(PG8_SA(0, 0), cA, voffA); PG8_STAGE(PG8_SA(0, 1), cA + hstep, voffA);
        if (wr == 1) PG8_BAR;
        PG8_WAIT_V(2); PG8_BAR;
        PG8_STAGE(PG8_SB(1, 0), cB + kstep, voffB); PG8_STAGE(PG8_SA(1, 0), cA + kstep, voffA); PG8_STAGE(PG8_SB(1, 1), cB + hstep + kstep, voffB);
        PG8_WAIT_V(6); PG8_BAR;
    } else {
        PG8_STAGE(PG8_SB(0, 0), cB, voffB); PG8_STAGE(PG8_SA(0, 0), cA, voffA); PG8_STAGE(PG8_SB(0, 1), cB + hstep, voffB); PG8_STAGE(PG8_SA(0, 1), cA + hstep, voffA);
        if (wr == 1) PG8_BAR;
        PG8_WAIT_V(4); PG8_BAR;
        PG8_STAGE(PG8_SB(1, 0), cB + kstep, voffB); PG8_STAGE(PG8_SA(1, 0), cA + kstep, voffA); PG8_STAGE(PG8_SB(1, 1), cB + hstep + kstep, voffB);
        PG8_WAIT_V(6); PG8_BAR;
    }
    for (;;) {
        const bool has_next = S.next(ui + 1, nxt);
        const char* nA = has_next ? (const char*)g.A + (size_t)nxt.pm * tstep + (size_t)nxt.seg * g.dA : cA; const char* nB = has_next ? (const char*)g.Bt + (size_t)nxt.pn * tstep + (size_t)nxt.seg * g.dB : cB;
        for (int t = 0; t < nt; t += 2) {
            const bool last = (t == nt - 2);
            const char* a1 = cA + (size_t)(t + 1) * kstep;
            const char* a2 = last ? nA : cA + (size_t)(t + 2) * kstep; const char* b2 = last ? nB : cB + (size_t)(t + 2) * kstep;
            const char* a3 = a2 + kstep; const char* b3 = b2 + kstep;
            if (last && has_next) S.a_ready(nxt);
            if constexpr (SP2) {
            PG8_LDB(B0, 0, 0); PG8_LDB(B1, 0, 1); PG8_SCHED; PG8_LDA(At, 0, 0); PG8_STAGE(PG8_SA(1, 1), a1 + hstep, voffA);
            PG8_WAIT_V(8); PG8_WAIT_L(0); PG8_BAR; PG8_MMA(0, 0, At, B0); PG8_MMA(0, 1, At, B1); PG8_BAR; PG8_SCHED;
            PG8_LDA(At, 0, 1); PG8_STAGE(PG8_SB(0, 0), b2, voffB); PG8_STAGE(PG8_SB(0, 1), b2 + hstep, voffB); PG8_STAGE(PG8_SA(0, 0), a2, voffA);
            PG8_WAIT_V(8); PG8_WAIT_L(0); PG8_BAR; PG8_MMA(1, 0, At, B0); PG8_MMA(1, 1, At, B1); PG8_BAR; PG8_SCHED;
            PG8_LDB(B0, 1, 0); PG8_LDB(B1, 1, 1); PG8_SCHED; PG8_LDA(At, 1, 0); PG8_STAGE(PG8_SA(0, 1), a2 + hstep, voffA);
            PG8_WAIT_V(8); PG8_WAIT_L(0); PG8_BAR; PG8_MMA(0, 0, At, B0); PG8_MMA(0, 1, At, B1); PG8_BAR; PG8_SCHED;
            PG8_LDA(At, 1, 1); PG8_STAGE(PG8_SB(1, 0), b3, voffB); PG8_STAGE(PG8_SB(1, 1), b3 + hstep, voffB); PG8_STAGE(PG8_SA(1, 0), a3, voffA);
            PG8_WAIT_V(8); PG8_WAIT_L(0); PG8_BAR; PG8_MMA(1, 0, At, B0); PG8_MMA(1, 1, At, B1); PG8_BAR; PG8_SCHED;
            } else {
            PG8_LDB(B0, 0, 0); PG8_SCHED; PG8_LDA(At, 0, 0); PG8_STAGE(PG8_SA(1, 1), a1 + hstep, voffA);
            PG8_WAIT_L(8); PG8_BAR; PG8_WAIT_L(0); PG8_MMA(0, 0, At, B0); PG8_BAR; PG8_SCHED;
            PG8_LDB(B1, 0, 1); PG8_STAGE(PG8_SB(0, 0), b2, voffB);
            PG8_BAR; PG8_WAIT_L(0); PG8_MMA(0, 1, At, B1); PG8_BAR;
            PG8_LDA(At, 0, 1); PG8_STAGE(PG8_SA(0, 0), a2, voffA);
            PG8_BAR; PG8_WAIT_L(0); PG8_MMA(1, 0, At, B0); PG8_BAR; PG8_SCHED;
            PG8_STAGE(PG8_SB(0, 1), b2 + hstep, voffB);
            PG8_WAIT_V(6); PG8_BAR; PG8_MMA(1, 1, At, B1); PG8_BAR;
            PG8_LDB(B0, 1, 0); PG8_SCHED; PG8_LDA(At, 1, 0); PG8_STAGE(PG8_SA(0, 1), a2 + hstep, voffA);
            PG8_WAIT_L(8); PG8_BAR; PG8_WAIT_L(0); PG8_MMA(0, 0, At, B0); PG8_BAR; PG8_SCHED;
            PG8_LDB(B1, 1, 1); PG8_STAGE(PG8_SB(1, 0), b3, voffB);
            PG8_BAR; PG8_WAIT_L(0); PG8_MMA(0, 1, At, B1); PG8_BAR;
            PG8_LDA(At, 1, 1); PG8_STAGE(PG8_SA(1, 0), a3, voffA);
            PG8_BAR; PG8_WAIT_L(0); PG8_MMA(1, 0, At, B0); PG8_BAR; PG8_SCHED;
            PG8_STAGE(PG8_SB(1, 1), b3 + hstep, voffB);
            PG8_WAIT_V(6); PG8_BAR; PG8_MMA(1, 1, At, B1); PG8_BAR;
            }
        }
        if constexpr (ALIGN_EPI) { if (wr == 0) PG8_BAR; }
        if constexpr (!Epi::AFTER_DRAIN) { E(acc, cur, wr, wc, fr, fq); S.done(cur); }
        if (!has_next) break;
        if (!(Epi::SEG && cur.seg == 0))
#pragma unroll
        for (int a = 0; a < 2; ++a)
#pragma unroll
            for (int b = 0; b < 2; ++b)
#pragma unroll
                for (int m = 0; m < 4; ++m)
#pragma unroll
                    for (int n = 0; n < 2; ++n) acc[a][b][m][n] = (f32x4){0.f, 0.f, 0.f, 0.f};
        cur = nxt; cA = nA; cB = nB; ++ui;
        if constexpr (ALIGN_EPI) { if (wr == 1) PG8_BAR; }
    }
    PG8_WAIT_V(0);
    if constexpr (!ALIGN_EPI) { if (wr == 0) PG8_BAR; }
    PG8_BAR;
    if constexpr (Epi::AFTER_DRAIN) { E.fused(acc, cur, wr, wc, fr, fq, lds, wid, lane); S.done(cur); }
#undef PG8_SA
#undef PG8_SB
#undef PG8_STAGE
#undef PG8_LDA
#undef PG8_LDB
#undef PG8_MMA
#undef PG8_WAIT_V
#undef PG8_WAIT_L
#undef PG8_BAR
#undef PG8_SCHED
}
}
#include <hip/hip_bf16.h>
#include <cmath>
namespace attn_body {
using bf16=__hip_bfloat16;
using bf16x8=__attribute__((ext_vector_type(8)))short;
using s16x4=__attribute__((ext_vector_type(4)))short;
using f32x16=__attribute__((ext_vector_type(16)))float;
using u32x4=__attribute__((ext_vector_type(4)))unsigned;
constexpr int D=64,QP=512,KP=128;
constexpr int NW=8,QBLK=32,QB=QBLK*NW,KVBLK=64;
constexpr int ATTN_UNIT_ROWS=QB;
__device__ __forceinline__ int crow(int r,int hi){return (r&3)+8*(r>>2)+4*hi;}
#define SBAR() __builtin_amdgcn_sched_barrier(0)
__device__ __forceinline__ void cmask(f32x16&p0,f32x16&p1,int jb,int qrel,int hi){
  const float NEG=-INFINITY; int kb=64*jb+4*hi;
  #pragma unroll
  for(int r=0;r<16;++r){int kv=kb+(r&3)+8*(r>>2); if(kv>qrel)p0[r]=NEG; if(kv+32>qrel)p1[r]=NEG;}
}

constexpr int NSLOT=3, SLOTB=8192;
constexpr int LDS_K=0, LDS_V=NSLOT*SLOTB, LDS_WS=2*NSLOT*SLOTB, LDS_OST=LDS_WS+NW*64*4, LDS_BYTES=LDS_OST+NW*4096;
constexpr float C2=0.125f*1.4426950408889634f;
__device__ __forceinline__ void glds16(const void*gsrc,unsigned lds_dst){unsigned keep;
  asm volatile("s_mov_b32 %0, m0\n\ts_mov_b32 m0, %2\n\ts_nop 0\n\tglobal_load_lds_dwordx4 %1, off\n\ts_mov_b32 m0, %0":"=&s"(keep):"v"(gsrc),"s"(lds_dst):"memory");}
__device__ __forceinline__ float max3f(float a,float b,float c){float r;asm("v_max3_f32 %0, %1, %2, %3":"=v"(r):"v"(a),"v"(b),"v"(c));return r;}
__device__ __forceinline__ float max2f(float a,float b){float r;asm("v_max_f32_e32 %0, %1, %2":"=v"(r):"v"(a),"v"(b));return r;}
__device__ __forceinline__ float fadd_s(float a,float b){float r;asm("v_add_f32_e32 %0, %1, %2":"=v"(r):"v"(a),"v"(b));return r;}
__device__ __forceinline__ float fsub_s(float a,float b){float r;asm("v_sub_f32_e32 %0, %1, %2":"=v"(r):"v"(a),"v"(b));return r;}
typedef float f32x2_t __attribute__((ext_vector_type(2))); typedef __bf16 bf16x2_t __attribute__((ext_vector_type(2)));
__device__ __forceinline__ unsigned cvtpk_s(float lo,float hi){f32x2_t v={lo,hi};bf16x2_t b=__builtin_convertvector(v,bf16x2_t);return __builtin_bit_cast(unsigned,b);}
#define WAIT_BAR(N) asm volatile("s_waitcnt vmcnt(" #N ") lgkmcnt(0)\n\ts_barrier":::"memory")

__device__ __forceinline__ void qkt(f32x16&p0,f32x16&p1,const char*Kslot,const bf16x8*qr,const f32x16&negm,int r32,int hi){
  const char*kb=Kslot+hi*1024+r32*16;
  #pragma unroll
  for(int d0=0;d0<4;++d0){
    const bf16x8 b0=*reinterpret_cast<const bf16x8*>(kb+d0*2048);
    const bf16x8 b1=*reinterpret_cast<const bf16x8*>(kb+d0*2048+512);
    if(d0==0){p0=__builtin_amdgcn_mfma_f32_32x32x16_bf16(b0,qr[0],negm,0,0,0);p1=__builtin_amdgcn_mfma_f32_32x32x16_bf16(b1,qr[0],negm,0,0,0);}
    else{p0=__builtin_amdgcn_mfma_f32_32x32x16_bf16(b0,qr[d0],p0,0,0,0);p1=__builtin_amdgcn_mfma_f32_32x32x16_bf16(b1,qr[d0],p1,0,0,0);}}
}
typedef __attribute__((address_space(3))) const char* lds_cptr;
typedef short v4i16_t __attribute__((ext_vector_type(4)));
__device__ __forceinline__ void kload8(bf16x8*kf,lds_cptr kp){
  kf[0]=*(const __attribute__((address_space(3))) bf16x8*)(kp);      kf[1]=*(const __attribute__((address_space(3))) bf16x8*)(kp+512);
  kf[2]=*(const __attribute__((address_space(3))) bf16x8*)(kp+2048); kf[3]=*(const __attribute__((address_space(3))) bf16x8*)(kp+2560);
  kf[4]=*(const __attribute__((address_space(3))) bf16x8*)(kp+4096); kf[5]=*(const __attribute__((address_space(3))) bf16x8*)(kp+4608);
  kf[6]=*(const __attribute__((address_space(3))) bf16x8*)(kp+6144); kf[7]=*(const __attribute__((address_space(3))) bf16x8*)(kp+6656);
}
__device__ __forceinline__ void kload2(bf16x8*kf,lds_cptr kp,int j){ kf[2*j]=*(const __attribute__((address_space(3))) bf16x8*)(kp+j*2048); kf[2*j+1]=*(const __attribute__((address_space(3))) bf16x8*)(kp+j*2048+512); }
__device__ __forceinline__ s16x4 vtr(lds_cptr p){ return __builtin_bit_cast(s16x4,__builtin_amdgcn_ds_read_tr16_b64_v4i16((__attribute__((address_space(3))) v4i16_t*)p)); }
__device__ __forceinline__ float rowmax(const f32x16&p0,const f32x16&p1){
  float a=max3f(p0[0],p0[1],p1[0]),b=max3f(p0[2],p0[3],p1[1]);a=max3f(a,p1[2],p1[3]);
  #pragma unroll
  for(int r=4;r<16;r+=4){a=max3f(a,p0[r],p0[r+1]);b=max3f(b,p0[r+2],p0[r+3]);a=max3f(a,p1[r],p1[r+1]);b=max3f(b,p1[r+2],p1[r+3]);}
  const float m=max2f(a,b);
  auto rr=__builtin_amdgcn_permlane32_swap(__float_as_uint(m),__float_as_uint(m),false,false);
  return max2f(__uint_as_float(rr[0]),__uint_as_float(rr[1]));
}
__device__ __forceinline__ void pv(f32x16*o,int vb,bf16x8 pa0,bf16x8 pa1,bf16x8 pa2,bf16x8 pa3){
  #pragma unroll
  for(int d0=0;d0<2;++d0){s16x4 lo[4],hi[4];
    #pragma unroll
    for(int ks=0;ks<4;++ks){
      asm volatile("ds_read_b64_tr_b16 %0,%1 offset:%c2":"=&v"(lo[ks]):"v"(vb),"i"(d0*4096+ks*1024):"memory");
      asm volatile("ds_read_b64_tr_b16 %0,%1 offset:%c2":"=&v"(hi[ks]):"v"(vb),"i"(d0*4096+ks*1024+512):"memory");}
    asm volatile("s_waitcnt lgkmcnt(0)":::"memory");SBAR();
    #define PK(k) (bf16x8){lo[k][0],lo[k][1],lo[k][2],lo[k][3],hi[k][0],hi[k][1],hi[k][2],hi[k][3]}
    o[d0]=__builtin_amdgcn_mfma_f32_32x32x16_bf16(pa0,PK(0),o[d0],0,0,0);
    o[d0]=__builtin_amdgcn_mfma_f32_32x32x16_bf16(pa1,PK(1),o[d0],0,0,0);
    o[d0]=__builtin_amdgcn_mfma_f32_32x32x16_bf16(pa2,PK(2),o[d0],0,0,0);
    o[d0]=__builtin_amdgcn_mfma_f32_32x32x16_bf16(pa3,PK(3),o[d0],0,0,0);
    #undef PK
  }
}

#ifndef ATTN_STORE16
#define ATTN_STORE16(p,v) (*(u32x4*)(p)=(v))
#endif
template<int THRL> __device__ __forceinline__ void attn_unit(long rowbase,int h,int qb,int NT,const bf16*Q,const bf16*__restrict__ K,const bf16*__restrict__ V,bf16*O,char*shm){
  int tid=threadIdx.x; asm volatile("":"+v"(tid)); const int lane=tid&63,r32=lane&31,hi=lane>>5; const int wid=__builtin_amdgcn_readfirstlane(tid>>6);
  const int q0=qb*QB;
  const bf16*Qw=Q+(rowbase+q0+wid*QBLK)*QP+h*D;
  const bf16*Kh=K+rowbase*KP+(h>>2)*D,*Vh=V+rowbase*KP+(h>>2)*D;
  const unsigned lds0=(unsigned)(uintptr_t)shm;
  float*wsf=(float*)(shm+LDS_WS)+wid*64;
  const bf16*ksrc=Kh+(long)lane*KP+wid*8;
  const bf16*vsrc=Vh+(long)(16*(wid&3)+(lane>>2))*KP+(wid>>2)*32+(lane&3)*8;
  const unsigned kdst=lds0+LDS_K+wid*1024, vdst=lds0+LDS_V+wid*1024;
  #define DMA_K(t,slot) glds16(ksrc+(long)(t)*KVBLK*KP,(unsigned)__builtin_amdgcn_readfirstlane(kdst+(slot)))
  #define DMA_V(t,slot) glds16(vsrc+(long)(t)*KVBLK*KP,(unsigned)__builtin_amdgcn_readfirstlane(vdst+(slot)))
  const int vb0=(int)(lds0+LDS_V)+((lane>>4)&1)*32+(lane&3)*8+(4*hi+((lane&15)>>2))*64;
  const char*Kbase=shm+LDS_K; bf16x8 kf[8];
  const lds_cptr shm3=(lds_cptr)shm; const lds_cptr kp0=shm3+LDS_K+hi*1024+r32*16; const lds_cptr vp0=shm3+LDS_V+((lane>>4)&1)*32+(lane&3)*8+(4*hi+((lane&15)>>2))*64;
  DMA_K(0,0);DMA_V(0,0);DMA_K(1,SLOTB);
  bf16x8 qr[4];
  #pragma unroll
  for(int d0=0;d0<4;++d0)qr[d0]=*reinterpret_cast<const bf16x8*>(&Qw[(long)r32*QP+d0*16+hi*8]);
  float mhat=0.f,l_reg=0.f;f32x16 o[2];o[0]=f32x16{};o[1]=f32x16{};f32x16 negm=f32x16{};asm volatile("":"+v"(negm));
    #define CMASK(P0,P1,t) do{}while(0)
  bool resc=false;
  #define START(P0,P1) do{ const float rm=rowmax(P0,P1); resc=false; \
    { const float dl=rm; mhat=fadd_s(mhat,dl); \
      _Pragma("unroll") for(int r=0;r<16;++r){P0[r]=fsub_s(P0[r],dl);P1[r]=fsub_s(P1[r],dl);} \
      _Pragma("unroll") for(int r=0;r<16;++r)negm[r]=-mhat; asm volatile("":"+v"(negm)); } \
    _Pragma("unroll") for(int r=0;r<16;++r)P0[r]=__builtin_amdgcn_exp2f(P0[r]); }while(0)
  #define RESC() do{ if(resc){ asm volatile("s_waitcnt lgkmcnt(0)":::"memory"); \
      _Pragma("unroll") for(int d_=0;d_<2;++d_) _Pragma("unroll") for(int r=0;r<16;++r)o[d_][r]*=wsf[crow(r,hi)]; } }while(0)
  f32x16 pA0,pA1,pB0,pB1;
  int sl_prev=0,sl_cur=0,sl_next=SLOTB;
  #define ROT() do{sl_prev=sl_cur;sl_cur=sl_next;sl_next=(sl_next==(NSLOT-1)*SLOTB)?0:sl_next+SLOTB;}while(0)
  DMA_K(2,2*SLOTB);
  WAIT_BAR(3);
  qkt(pA0,pA1,Kbase,qr,negm,r32,hi);asm volatile("s_nop 15\n\ts_nop 7":"+v"(pA0),"+v"(pA1));CMASK(pA0,pA1,0);
  START(pA0,pA1);
  _Pragma("unroll") for(int r=0;r<16;++r)pA1[r]=__builtin_amdgcn_exp2f(pA1[r]);
  WAIT_BAR(0);
  DMA_K(3,0);DMA_V(1,SLOTB);
  ROT();
  kload8(kf,kp0+sl_cur);
  WAIT_BAR(2);
  s16x4 vlo[8],vhi[8]; u32x4 pw0,pw1,pw2,pw3;
  #define PKW(P,B) cvtpk_s(P[B],P[B+1])
  #define PAF(k) __builtin_bit_cast(bf16x8,pw##k)
  #define VFR(i) (bf16x8){vlo[i][0],vlo[i][1],vlo[i][2],vlo[i][3],vhi[i][0],vhi[i][1],vhi[i][2],vhi[i][3]}
  #define PIN(x) asm volatile("":"+v"(x))
  #define MX3(a,b,c) __builtin_fmaxf(__builtin_fmaxf((a),(b)),(c))
  #define GAPA(MF,A0,A1,A2,A3,W0,W1,PW) do{ MF; sacc+=A0; sacc+=A1; sacc+=A2; sacc+=A3; PIN(sacc); W0; W1; PIN(PW); SBAR(); }while(0)
  #define EX(v) __builtin_amdgcn_exp2f(v)
  #define GAPB(MF,X,B) do{ MF; X[B]=EX(X[B]); X[B+1]=EX(X[B+1]); X[B+2]=EX(X[B+2]); X[B+3]=EX(X[B+3]); PIN(X); SBAR(); }while(0)
  #define VRD(i) do{ vlo[i]=vtr(vp_+(((i)>>2)*4096+((i)&3)*1024)); vhi[i]=vtr(vp_+(((i)>>2)*4096+((i)&3)*1024+512)); }while(0)
  #define KRD(G,j) do{ if(G){ kload2(kf,kp0+sl_next,j); SBAR(); } }while(0)
  #define STEP(C0,C1,P0,P1,t,GK,GV,GL) do{ SBAR(); \
    const lds_cptr vp_=vp0+sl_prev; \
    VRD(0); SBAR(); float sacc=(P0[0]+P0[1]); \
    GAPA(C0=__builtin_amdgcn_mfma_f32_32x32x16_bf16(kf[0],qr[0],negm,0,0,0), P0[2],P0[3],P0[4],P0[5],     pw0[0]=PKW(P0,0), pw0[1]=PKW(P0,2), pw0); \
    VRD(4); SBAR(); GAPA(C1=__builtin_amdgcn_mfma_f32_32x32x16_bf16(kf[1],qr[0],negm,0,0,0), P0[6],P0[7],P0[8],P0[9],     pw0[2]=PKW(P0,4), pw0[3]=PKW(P0,6), pw0); \
    VRD(1); SBAR(); GAPA(C0=__builtin_amdgcn_mfma_f32_32x32x16_bf16(kf[2],qr[1],C0,0,0,0),   P0[10],P0[11],P0[12],P0[13], pw1[0]=PKW(P0,8), pw1[1]=PKW(P0,10), pw1); \
    VRD(5); SBAR(); GAPA(C1=__builtin_amdgcn_mfma_f32_32x32x16_bf16(kf[3],qr[1],C1,0,0,0),   P0[14],P0[15],P1[0],P1[1],   pw1[2]=PKW(P0,12),pw1[3]=PKW(P0,14), pw1); \
    VRD(2); SBAR(); GAPA(C0=__builtin_amdgcn_mfma_f32_32x32x16_bf16(kf[4],qr[2],C0,0,0,0),   P1[2],P1[3],P1[4],P1[5],     pw2[0]=PKW(P1,0), pw2[1]=PKW(P1,2), pw2); \
    VRD(6); SBAR(); GAPA(C1=__builtin_amdgcn_mfma_f32_32x32x16_bf16(kf[5],qr[2],C1,0,0,0),   P1[6],P1[7],P1[8],P1[9],     pw2[2]=PKW(P1,4), pw2[3]=PKW(P1,6), pw2); \
    VRD(3); SBAR(); GAPA(C0=__builtin_amdgcn_mfma_f32_32x32x16_bf16(kf[6],qr[3],C0,0,0,0),   P1[10],P1[11],P1[12],P1[13], pw3[0]=PKW(P1,8), pw3[1]=PKW(P1,10), pw3); \
    VRD(7); SBAR(); GAPA(C1=__builtin_amdgcn_mfma_f32_32x32x16_bf16(kf[7],qr[3],C1,0,0,0),   P1[14],P1[15],0.f,0.f,       pw3[2]=PKW(P1,12),pw3[3]=PKW(P1,14), pw3); \
    l_reg+=sacc; \
    if(GK){DMA_K((t)+3,sl_cur);} if(GV){DMA_V((t)+1,sl_next);} \
    CMASK(C0,C1,t); \
    { float a=MX3(C0[0],C0[1],C1[0]),b=MX3(C0[2],C0[3],C1[1]); a=MX3(a,C1[2],C1[3]); \
      _Pragma("unroll") for(int r=4;r<16;r+=4){a=MX3(a,C0[r],C0[r+1]);b=MX3(b,C0[r+2],C0[r+3]);a=MX3(a,C1[r],C1[r+1]);b=MX3(b,C1[r+2],C1[r+3]);} \
      float rm=__builtin_fmaxf(a,b); { auto rr=__builtin_amdgcn_permlane32_swap(__float_as_uint(rm),__float_as_uint(rm),false,false); rm=__builtin_fmaxf(__uint_as_float(rr[0]),__uint_as_float(rr[1])); } \
      resc=false; \
      if(__builtin_expect(__any(rm>(float)THRL),0)){ const float dl=__builtin_fmaxf(rm,0.f); mhat+=dl; \
        _Pragma("unroll") for(int r=0;r<16;++r){C0[r]-=dl;C1[r]-=dl;} \
        _Pragma("unroll") for(int r=0;r<16;++r)negm[r]=-mhat; asm volatile("":"+v"(negm)); \
        const float f=__builtin_amdgcn_exp2f(-dl); l_reg*=f; if(hi==0)wsf[r32]=f; resc=true; } } \
    SBAR(); \
    GAPB(o[0]=__builtin_amdgcn_mfma_f32_32x32x16_bf16(PAF(0),VFR(0),o[0],0,0,0), C0,0); \
    GAPB(o[1]=__builtin_amdgcn_mfma_f32_32x32x16_bf16(PAF(0),VFR(4),o[1],0,0,0), C0,4); \
    KRD(GL,0); GAPB(o[0]=__builtin_amdgcn_mfma_f32_32x32x16_bf16(PAF(1),VFR(1),o[0],0,0,0), C0,8); \
    KRD(GL,1); GAPB(o[1]=__builtin_amdgcn_mfma_f32_32x32x16_bf16(PAF(1),VFR(5),o[1],0,0,0), C0,12); \
    KRD(GL,2); GAPB(o[0]=__builtin_amdgcn_mfma_f32_32x32x16_bf16(PAF(2),VFR(2),o[0],0,0,0), C1,0); \
    KRD(GL,3); GAPB(o[1]=__builtin_amdgcn_mfma_f32_32x32x16_bf16(PAF(2),VFR(6),o[1],0,0,0), C1,4); \
    GAPB(o[0]=__builtin_amdgcn_mfma_f32_32x32x16_bf16(PAF(3),VFR(3),o[0],0,0,0), C1,8); \
    GAPB(o[1]=__builtin_amdgcn_mfma_f32_32x32x16_bf16(PAF(3),VFR(7),o[1],0,0,0), C1,12); \
    }while(0)
  int t=1;
  #undef CMASK
  #define CMASK(P0,P1,t) do{}while(0)
  for(;t+5<NT;t+=2){
    STEP(pB0,pB1,pA0,pA1,t,true,true,true);     WAIT_BAR(2); RESC(); ROT();
    STEP(pA0,pA1,pB0,pB1,t+1,true,true,true);   WAIT_BAR(2); RESC(); ROT();
  }
  #undef CMASK
  #define CMASK(P0,P1,t) do{}while(0)
  #define ENDW(tt) do{ if((tt)+3<NT){WAIT_BAR(2);} else if((tt)+2<NT){WAIT_BAR(1);} else {WAIT_BAR(0);} }while(0)
  for(;t+1<NT;t+=2){
    STEP(pB0,pB1,pA0,pA1,t,(t+3<NT),(t+1<NT),(t+1<NT));       ENDW(t);   RESC(); ROT();
    STEP(pA0,pA1,pB0,pB1,t+1,(t+4<NT),(t+2<NT),(t+2<NT));     ENDW(t+1); RESC(); ROT();
  }
  STEP(pB0,pB1,pA0,pA1,NT-1,false,false,false); RESC();
  { float sacc=pB0[0]+pB0[1]; _Pragma("unroll") for(int r=2;r<16;++r)sacc+=pB0[r]; _Pragma("unroll") for(int r=0;r<16;++r)sacc+=pB1[r]; l_reg+=sacc;
    pw0=(u32x4){PKW(pB0,0),PKW(pB0,2),PKW(pB0,4),PKW(pB0,6)};pw1=(u32x4){PKW(pB0,8),PKW(pB0,10),PKW(pB0,12),PKW(pB0,14)};pw2=(u32x4){PKW(pB1,0),PKW(pB1,2),PKW(pB1,4),PKW(pB1,6)};pw3=(u32x4){PKW(pB1,8),PKW(pB1,10),PKW(pB1,12),PKW(pB1,14)};
    SBAR(); pv(o,vb0+sl_cur,PAF(0),PAF(1),PAF(2),PAF(3)); }
  #undef PKW
  #undef PAF
  #undef VFR
  #undef PIN
  #undef MX3
  #undef GAPA
  #undef GAPB
  #undef EX
  #undef VRD
  #undef KRD
  #undef STEP
  #undef ENDW
  {auto rr=__builtin_amdgcn_permlane32_swap(__float_as_uint(l_reg),__float_as_uint(l_reg),false,false);l_reg=__uint_as_float(rr[0])+__uint_as_float(rr[1]);}
  if(hi==0)wsf[32+r32]=l_reg;asm volatile("s_waitcnt lgkmcnt(0)":::"memory");
  float rli[16];
  #pragma unroll
  for(int r=0;r<16;++r)rli[r]=__builtin_amdgcn_rcpf(wsf[32+crow(r,hi)]);
  bf16*Ow=O+(rowbase+q0+wid*QBLK)*QP+h*D;
  { bf16*stg=(bf16*)(shm+LDS_OST)+wid*2048;
    #pragma unroll
    for(int r=0;r<16;++r){const int orow=crow(r,hi);
      #pragma unroll
      for(int d0=0;d0<2;++d0)stg[orow*64+d0*32+r32]=__float2bfloat16(o[d0][r]*rli[r]);}
    asm volatile("s_waitcnt lgkmcnt(0)":::"memory");
    #pragma unroll
    for(int i=0;i<4;++i){const int row=i*8+(lane>>3),ch=lane&7; const u32x4 v=*(const u32x4*)(stg+row*64+ch*8); ATTN_STORE16(Ow+(long)row*QP+ch*8,v);} }
  asm volatile("s_waitcnt lgkmcnt(0)\n\ts_barrier":::"memory");
  #undef DMA_K
  #undef DMA_V
  #undef CMASK
  #undef START
  #undef RESC
  #undef ROT
}
constexpr int ATTN_LDS_BYTES=LDS_BYTES;
struct AttnTensors { const bf16* Q; const bf16* K; const bf16* V; bf16* O; };
template<int THRL=8> __device__ __forceinline__ void attn_phase(char*lds,const AttnTensors&T,int vcu,int G){
  for(int i=0;;++i){
    int u;
    if(G==256){ if(i>=6)break; u=(i<4)?(4*vcu+i):(1024+2*vcu+(i-4)); }
    else{ u=vcu+i*G; if(u>=1536)break; }
    long rowbase; int h,qb,NT;
    if(u<1024){ const int bh=u>>5; qb=u&31; rowbase=(long)(bh>>3)*8192; h=bh&7; NT=128; }
    else { const int v=u-1024; const int bh=v>>4; qb=v&15; rowbase=32768+(long)(bh>>3)*4096; h=bh&7; NT=64; }
    attn_unit<THRL>(rowbase,h,qb,NT,T.Q,T.K,T.V,T.O,lds);
  }
}
#undef SBAR
#undef WAIT_BAR
}
#ifndef PH_MASK
#define PH_MASK 0x3ff
#endif
#define PH(k) if constexpr ((PH_MASK >> (k)) & 1)
constexpr int NWAVES = 8;
constexpr int RING_BYTES = 131072, LDS_BYTES = 147456;

#define LAS __attribute__((address_space(3)))
typedef unsigned short bf16;
typedef unsigned v4u __attribute__((ext_vector_type(4)));
typedef float f32x4 __attribute__((ext_vector_type(4)));
#define LDS_WAIT() asm volatile("s_waitcnt lgkmcnt(0)" ::: "memory")
__device__ __forceinline__ unsigned f2bf(float f) { unsigned u = __builtin_bit_cast(unsigned, f); return (u + 0x7fffu + ((u >> 16) & 1u)) >> 16; }
__device__ __forceinline__ unsigned pk2(float lo, float hi) { return f2bf(lo) | (f2bf(hi) << 16); }
__device__ __forceinline__ float wave_sum(float v) {
#pragma unroll
    for (int o = 1; o < 64; o <<= 1) v += __shfl_xor(v, o);
    return v;
}
__device__ __forceinline__ void transpose_item(const float* W, int ldw, int src_col0, int k0, bf16* WT, int K, int dst_row0, LAS float* scr, int lane, const float* gk = nullptr) {
    float tv[32];
    const float* wp = W + (size_t)(k0 + (lane >> 5)) * ldw + src_col0 + (lane & 31);
#pragma unroll
    for (int i = 0; i < 32; ++i) tv[i] = wp[(size_t)(2 * i) * ldw];
#pragma unroll
    for (int i = 0; i < 32; ++i) { const int kk = 2 * i + (lane >> 5); scr[kk * 33 + (lane & 31)] = gk ? tv[i] * gk[k0 + kk] : tv[i]; }
    LDS_WAIT(); asm volatile("" ::: "memory");
    const int c = lane & 7;
#pragma unroll
    for (int j = 0; j < 4; ++j) { const int n = (lane >> 3) + 8 * j; const LAS float* s = scr + (8 * c) * 33 + n;
        v4u o; o.x = pk2(s[0 * 33], s[1 * 33]); o.y = pk2(s[2 * 33], s[3 * 33]); o.z = pk2(s[4 * 33], s[5 * 33]); o.w = pk2(s[6 * 33], s[7 * 33]);
        *(v4u*)(WT + (size_t)(dst_row0 + n) * K + k0 + 8 * c) = o; }
    LDS_WAIT(); asm volatile("" ::: "memory");
}

template <int W> __device__ __forceinline__ void pool_item(const bf16* Zb, bf16* PL, int row, int ch) {
    constexpr int left = W / 2;
    const int T = row < MP ? 8192 : 4096, t = row < MP ? (row & 8191) : ((row - MP) & 4095);
    const bf16* zp = Zb + (size_t)(row - t) * 512 + ch * 8;
    v4u q[W];
#pragma unroll
    for (int k = 0; k < W; ++k) { int tt = t - left + k; tt = tt < 0 ? 0 : (tt > T - 1 ? T - 1 : tt); q[k] = *(const v4u*)(zp + (size_t)tt * 512); }
    float a[8];
#pragma unroll
    for (int e = 0; e < 8; ++e) a[e] = 0.f;
#pragma unroll
    for (int k = 0; k < W; ++k) { const int tt = t - left + k; const float wv = (tt >= 0 && tt < T) ? 1.f : 0.f;
        a[0] += wv * pg8::bf_lo(q[k].x); a[1] += wv * pg8::bf_hi(q[k].x); a[2] += wv * pg8::bf_lo(q[k].y); a[3] += wv * pg8::bf_hi(q[k].y);
        a[4] += wv * pg8::bf_lo(q[k].z); a[5] += wv * pg8::bf_hi(q[k].z); a[6] += wv * pg8::bf_lo(q[k].w); a[7] += wv * pg8::bf_hi(q[k].w); }
    const int lo = (t - left) > 0 ? (t - left) : 0, hi = (t + W - 1 - left) < (T - 1) ? (t + W - 1 - left) : (T - 1);
    const float ic = 1.0f / (float)(hi - lo + 1); const v4u s = q[left];
    v4u o; o.x = pk2(a[0] * ic - pg8::bf_lo(s.x), a[1] * ic - pg8::bf_hi(s.x)); o.y = pk2(a[2] * ic - pg8::bf_lo(s.y), a[3] * ic - pg8::bf_hi(s.y));
    o.z = pk2(a[4] * ic - pg8::bf_lo(s.z), a[5] * ic - pg8::bf_hi(s.z)); o.w = pk2(a[6] * ic - pg8::bf_lo(s.w), a[7] * ic - pg8::bf_hi(s.w));
    *(v4u*)(PL + (size_t)row * 512 + ch * 8) = o;
}
struct Args { const float* in[25]; float* out; unsigned char* ws; };
static_assert(sizeof(Args) == 27 * 8, "Args has no padding");

__device__ __forceinline__ void gateup_items(int r, const float* Wg, const float* Wu, bf16* WT, LAS float* scr, int lane, const float* gk) {
    const int kb = r / 176, G = r % 176, tile = G >> 3, w = G & 7;
    transpose_item((w < 4) ? Wg : Wu, DFF, tile * 128 + (w & 3) * 32, kb * 64, WT, 1024, G * 32, scr, lane, gk);
}

__global__ void __launch_bounds__(NWAVES * 64, 2) fwd_mega(Args args) {
    extern __shared__ __attribute__((aligned(16))) unsigned char lds[];
    cg::grid_group grid = cg::this_grid();
    const int tid = threadIdx.x, lane = tid & 63, wave = __builtin_amdgcn_readfirstlane(tid >> 6);
    const int G = gridDim.x, bx = blockIdx.x, vcu = (G % 8 == 0) ? (bx % 8) * (G / 8) + bx / 8 : bx;
    unsigned char* ws = args.ws;
    LAS unsigned char* ldsp = (LAS unsigned char*)lds;
    const float* x_p = args.in[0]; const float* x_s = args.in[1]; const float* p_p = args.in[2]; const float* p_s = args.in[3];
    float* out = args.out;
    float* SS = (float*)(ws + WS_SS); float* SSE = (float*)(ws + WS_SSE);
    bf16* W1 = (bf16*)(ws + WS_W1); bf16* WD1 = (bf16*)(ws + WS_WD1); bf16* WIN = (bf16*)(ws + WS_WIN); bf16* WUA = (bf16*)(ws + WS_WUA); bf16* WPC = (bf16*)(ws + WS_WPC);
    bf16* WOUT = (bf16*)(ws + WS_WOUT); bf16* W2 = (bf16*)(ws + WS_W2); bf16* WD2 = (bf16*)(ws + WS_WD2); bf16* WPG = (bf16*)(ws + WS_WPG); bf16* WPP = (bf16*)(ws + WS_WPP);
    bf16* HB = (bf16*)(ws + WS_HB); bf16* ACT = (bf16*)(ws + WS_ACT); bf16* QO = (bf16*)(ws + WS_QO); bf16* Zb = (bf16*)(ws + WS_Z); bf16* PL = (bf16*)(ws + WS_PL);
    bf16* MX = (bf16*)(ws + WS_MX); bf16* KB = (bf16*)(ws + WS_K); bf16* VB = (bf16*)(ws + WS_V); bf16* PB = (bf16*)(ws + WS_PB); bf16* SGB = (bf16*)(ws + WS_SGB); bf16* EB = (bf16*)(ws + WS_E);
    const int gw = vcu * NWAVES + wave, NGW = G * NWAVES;
    const int gt = bx * (NWAVES * 64) + tid, NGT = G * NWAVES * 64;

    PH(0) {
        LAS float* scr = (LAS float*)(ldsp + wave * 16384);
        constexpr int I1 = 16 * 176, I2 = 44 * 32, I3 = 16 * 104, I4 = 8 * 32, I6 = 16 * 32, I10 = 4 * 32;
        constexpr int NITEMS = 2 * I1 + 2 * I2 + I3 + I4 + 2 * I6 + I10;
        for (int it = gw; it < NITEMS; it += NGW) {
            int r = it;
            if (r < I1) { gateup_items(r, args.in[5], args.in[6], W1, scr, lane, nullptr); continue; } r -= I1;
            if (r < I1) { gateup_items(r, args.in[18], args.in[19], W2, scr, lane, args.in[17]); continue; } r -= I1;
            if (r < I2) { transpose_item(args.in[7], 1024, (r % 32) * 32, (r / 32) * 64, WD1, DFF, (r % 32) * 32, scr, lane); continue; } r -= I2;
            if (r < I2) { transpose_item(args.in[20], 1024, (r % 32) * 32, (r / 32) * 64, WD2, DFF, (r % 32) * 32, scr, lane); continue; } r -= I2;
            if (r < I3) { const int kb = r / 104, Gp = r % 104; const int c0 = Gp < 24 ? ((Gp >> 3) * 256 + (Gp & 3) * 64 + ((Gp >> 2) & 1) * 32) : Gp * 32;
                transpose_item(args.in[9], INW, c0, kb * 64, WIN, 1024, Gp * 32, scr, lane, args.in[8]); continue; } r -= I3;
            if (r < I4) { transpose_item(args.in[12], 1024, (r % 32) * 32, (r / 32) * 64, WUA, 512, (r % 32) * 32, scr, lane); continue; } r -= I4;
            if (r < I6) { transpose_item(args.in[16], 1024, (r % 32) * 32, (r / 32) * 64, WOUT, 1024, (r % 32) * 32, scr, lane); continue; } r -= I6;
            if (r < I6) { transpose_item(args.in[22], 1024, (r % 32) * 32, (r / 32) * 64, WPG, 1024, (r % 32) * 32, scr, lane, args.in[21]); continue; } r -= I6;
            transpose_item(args.in[23], 1024, (r % 32) * 32, (r / 32) * 64, WPP, PLE, (r % 32) * 32, scr, lane);
        }
        if (gt < 128) ((float*)(ws + WS_GQK))[gt] = gt < 64 ? args.in[10][gt] : args.in[11][gt - 64];
        { const float* pw = args.in[13]; const float* psc = args.in[14]; const float* wup = args.in[15];
          for (int idx = gt; idx < 128 * 1024; idx += NGT) { const int d = idx & 1023, c0 = (idx >> 10) * 4, g0 = c0 & ~127; float a0 = 0.f, a1 = 0.f, a2 = 0.f, a3 = 0.f;
              const float* pr = pw + (size_t)c0 * 128; const float* bp = wup + (size_t)g0 * 1024 + d;
#pragma unroll 16
              for (int j = 0; j < 128; ++j) { const float b = bp[(size_t)j * 1024] * psc[g0 + j]; a0 += pr[j] * b; a1 += pr[128 + j] * b; a2 += pr[256 + j] * b; a3 += pr[384 + j] * b; }
              *(unsigned long long*)(WPC + (size_t)d * 512 + c0) = (unsigned long long)pk2(a0, a1) | ((unsigned long long)pk2(a2, a3) << 32); } }
        { const float* g1 = args.in[4]; f32x4 gv[4];
#pragma unroll
          for (int j = 0; j < 4; ++j) gv[j] = ((const f32x4*)g1)[lane + 64 * j];
          for (int m0 = gw * 4; m0 < MTOT; m0 += NGW * 4) { const float* xr = m0 < MP ? x_p + (size_t)m0 * 1024 : x_s + (size_t)(m0 - MP) * 1024;
              f32x4 v[4][4]; float s[4];
#pragma unroll
              for (int r = 0; r < 4; ++r)
#pragma unroll
                  for (int j = 0; j < 4; ++j) v[r][j] = ((const f32x4*)(xr + r * 1024))[lane + 64 * j];
#pragma unroll
              for (int r = 0; r < 4; ++r) { s[r] = 0.f;
#pragma unroll
                  for (int j = 0; j < 4; ++j) s[r] += (v[r][j].x * v[r][j].x + v[r][j].y * v[r][j].y) + (v[r][j].z * v[r][j].z + v[r][j].w * v[r][j].w); }
#pragma unroll
              for (int r = 0; r < 4; ++r) { const float rstd = rsqrtf(wave_sum(s[r]) * (1.f / 1024.f) + EPSN);
                  unsigned long long* o8 = (unsigned long long*)(HB + (size_t)(m0 + r) * 1024) + lane;
#pragma unroll
                  for (int j = 0; j < 4; ++j) { const f32x4 y = v[r][j] * rstd * gv[j]; o8[64 * j] = (unsigned long long)pk2(y.x, y.y) | ((unsigned long long)pk2(y.z, y.w) << 32); } } } }
    }
    grid.sync();

    PH(1) { pg8::Gemm g{HB, W1, MTOT, 2 * DFF, 1024, 0, 0}; pg8::StaticOrder S; S.init(MTOT, 2 * DFF, G, bx);
      pg8::EpiGateUp<false> E{ACT, DFF, nullptr};
      pg8::gemm_phase<pg8::EpiGateUp<false>, pg8::StaticOrder, true, true>(ldsp, g, S, E); }
    grid.sync();
    PH(2) { pg8::Gemm g{ACT, WD1, MTOT, 1024, DFF, 0, 0}; pg8::StaticOrder S; S.init(MTOT, 1024, G, bx);
      pg8::EpiResid<true> E{x_p, x_s, HB, SS, 0.5f};
      pg8::gemm_phase<pg8::EpiResid<true>, pg8::StaticOrder, true, true>(ldsp, g, S, E); }
    grid.sync();
    PH(3) { pg8::Gemm g{HB, WIN, MTOT, INW, 1024, 0, 0}; pg8::StaticOrder S; S.init(MTOT, INW, G, bx);
      pg8::EpiWin E{SS, (const float*)(ws + WS_GQK), ws, attn_body::C2};
      pg8::gemm_phase<pg8::EpiWin, pg8::StaticOrder, true, true>(ldsp, g, S, E); }
    grid.sync();
    PH(4) {
      for (int wi = gw; wi < MTOT; wi += NGW) { const int grp = wi & 3, row = (wi >> 2) * 4 + (lane >> 4), ch = grp * 16 + (lane & 15);
          if (grp == 0) pool_item<2>(Zb, PL, row, ch); else if (grp == 1) pool_item<4>(Zb, PL, row, ch); else if (grp == 2) pool_item<8>(Zb, PL, row, ch); else pool_item<16>(Zb, PL, row, ch); }
      asm volatile("s_waitcnt vmcnt(0)" ::: "memory"); __syncthreads();
      const attn_body::AttnTensors AT{(const attn_body::bf16*)QO, (const attn_body::bf16*)KB, (const attn_body::bf16*)VB, (attn_body::bf16*)QO};
      attn_body::attn_phase<8>((char*)lds, AT, vcu, G); }
    grid.sync();
    PH(5) { for (int idx = gt; idx < MTOT * 32; idx += NGT) { const int row = idx >> 5, ch = idx & 31; const float* pr = (row < MP ? p_p + (size_t)row * PLE : p_s + (size_t)(row - MP) * PLE) + ch * 8;
          const f32x4 a = *(const f32x4*)pr, b = *(const f32x4*)(pr + 4); v4u o; o.x = pk2(a.x, a.y); o.y = pk2(a.z, a.w); o.z = pk2(b.x, b.y); o.w = pk2(b.z, b.w);
          *(v4u*)(PB + (size_t)row * PLE + ch * 8) = o; }
      asm volatile("s_waitcnt vmcnt(0)" ::: "memory"); __syncthreads();
      pg8::SegOrder S; S.init(MTOT, 1024, G, bx);
      { pg8::Gemm g{QO, WUA, MTOT, 1024, 512, (long)((const char*)PL - (const char*)QO), (long)((const char*)WPC - (const char*)WUA)}; pg8::EpiGateMix E{MX, SGB}; pg8::gemm_phase<pg8::EpiGateMix, pg8::SegOrder, true, true>(ldsp, g, S, E); } }
    grid.sync();
    PH(6) { pg8::StaticOrder S; S.init(MTOT, 1024, G, bx);
      { pg8::Gemm g{MX, WOUT, MTOT, 1024, 1024, 0, 0}; pg8::EpiResid<false> E{nullptr, nullptr, HB, SS, 1.0f}; pg8::gemm_phase<pg8::EpiResid<false>, pg8::StaticOrder, true, true>(ldsp, g, S, E); }
      asm volatile("s_waitcnt vmcnt(0)" ::: "memory"); __syncthreads();
      { pg8::Gemm g{PB, WPP, MTOT, 1024, PLE, 0, 0}; pg8::EpiE E{EB, SSE}; pg8::gemm_phase<pg8::EpiE, pg8::StaticOrder, true, true>(ldsp, g, S, E); } }
    grid.sync();
    PH(7) { pg8::Gemm g{HB, W2, MTOT, 2 * DFF, 1024, 0, 0}; pg8::StaticOrder S; S.init(MTOT, 2 * DFF, G, bx);
      pg8::EpiGateUp<true> E{ACT, DFF, SS};
      pg8::gemm_phase<pg8::EpiGateUp<true>, pg8::StaticOrder, true, true>(ldsp, g, S, E); }
    grid.sync();
    PH(8) { pg8::Gemm g{ACT, WD2, MTOT, 1024, DFF, 0, 0}; pg8::StaticOrder S; S.init(MTOT, 1024, G, bx);
      pg8::EpiResid<false> E{nullptr, nullptr, HB, SS, 0.5f};
      pg8::gemm_phase<pg8::EpiResid<false>, pg8::StaticOrder, true, true>(ldsp, g, S, E); }
    grid.sync();
    PH(9) { pg8::Gemm g{HB, WPG, MTOT, 1024, 1024, 0, 0}; pg8::StaticOrder S; S.init(MTOT, 1024, G, bx);
      pg8::EpiFinal E{out, HB, EB, SS, SSE, args.in[24]};
      pg8::gemm_phase<pg8::EpiFinal, pg8::StaticOrder, true, true>(ldsp, g, S, E); }
}

extern "C" void kernel_launch(void* const* d_in, const int* in_sizes, int n_in, void* d_out, int out_size, void* d_ws, size_t ws_size, hipStream_t stream) {
    static int grid = 0;
    if (grid == 0) {
        if (n_in != 25 || out_size != MTOT * 1024 || ws_size < WS_END) { fprintf(stderr, "kernel_launch: unexpected problem (n_in %d, out %d, ws %zu); nothing launched\n", n_in, out_size, ws_size); grid = -1; return; }
        int dev = 0, cus = 0, per_cu = 0;
        if (hipGetDevice(&dev) != hipSuccess || hipDeviceGetAttribute(&cus, hipDeviceAttributeMultiprocessorCount, dev) != hipSuccess) { grid = -1; return; }
        if (hipFuncSetAttribute((const void*)fwd_mega, hipFuncAttributeMaxDynamicSharedMemorySize, LDS_BYTES) != hipSuccess) { fprintf(stderr, "kernel_launch: hipFuncSetAttribute failed\n"); grid = -1; return; }
        if (hipOccupancyMaxActiveBlocksPerMultiprocessor(&per_cu, (const void*)fwd_mega, NWAVES * 64, LDS_BYTES) != hipSuccess || per_cu < 1) { fprintf(stderr, "kernel_launch: occupancy query says %d blocks per CU\n", per_cu); (void)hipGetLastError(); }
        grid = cus;
    }
    if (grid < 0) return;
    Args a{};
    for (int i = 0; i < 25; ++i) a.in[i] = (const float*)d_in[i];
    a.out = (float*)d_out; a.ws = (unsigned char*)d_ws;
    void* kargs[] = {&a};
    const hipError_t e = hipLaunchCooperativeKernel((const void*)fwd_mega, dim3(grid), dim3(NWAVES * 64), kargs, LDS_BYTES, stream);
    if (e != hipSuccess) fprintf(stderr, "kernel_launch: cooperative launch failed: %s (grid %d)\n", hipGetErrorString(e), grid);
}
```

```cpp
#include <hip/hip_runtime.h>
#include <hip/hip_cooperative_groups.h>
#include <hip/hip_bf16.h>
#include <cstdio>
#include <cstdint>
#include <cmath>
namespace cg = cooperative_groups;

constexpr int DMODEL = 1024, MP = 4 * 8192, MS = 4 * 4096, MTOT = MP + MS;
constexpr int DFF = 2816, INW = 3328, PLE = 256;
constexpr float EPSN = 1e-6f;
constexpr size_t HK = 512u * 1024u;
constexpr size_t WS_GQK = 1 * HK;
constexpr size_t WS_SS = 2 * HK, WS_SSE = 8 * HK;
constexpr size_t WS_W1 = 16 * HK, WS_WD1 = 38 * HK, WS_WIN = 49 * HK, WS_WUA = 62 * HK, WS_WPC = 64 * HK, WS_WOUT = 66 * HK, WS_W2 = 70 * HK, WS_WD2 = 92 * HK, WS_WPG = 103 * HK, WS_WPP = 107 * HK;
constexpr size_t WS_HB = 112 * HK;
constexpr size_t WS_ACT = 304 * HK;
constexpr size_t WS_QO = WS_ACT, WS_Z = WS_ACT + 96 * HK, WS_PL = WS_ACT + 192 * HK, WS_MX = WS_ACT + 288 * HK, WS_K = WS_ACT + 480 * HK, WS_V = WS_ACT + 504 * HK, WS_PB = WS_K;
constexpr size_t WS_SGB = 832 * HK, WS_E = WS_SGB, WS_END = 1024 * HK;
static_assert(WS_WPP + 1024 * 256 * 2 <= WS_HB && WS_HB + (size_t)MTOT * 1024 * 2 <= WS_ACT && WS_ACT + (size_t)MTOT * DFF * 2 <= WS_SGB && WS_V + (size_t)MTOT * 128 * 2 <= WS_SGB && WS_SGB + (size_t)MTOT * 1024 * 2 <= WS_END, "d_ws map");
static_assert(WS_W1 + 5632 * 1024 * 2 <= WS_WD1 && WS_WD1 + 1024 * 2816 * 2 <= WS_WIN && WS_WIN + 3328 * 1024 * 2 <= WS_WUA && WS_W2 + 5632 * 1024 * 2 <= WS_WD2 && WS_WD2 + 1024 * 2816 * 2 <= WS_WPG && WS_WPG + 1024 * 1024 * 2 <= WS_WPP, "weights map");


namespace pg8 {
#define PG8_LAS __attribute__((address_space(3)))
typedef unsigned short bf16_t;
typedef short bf16x8 __attribute__((ext_vector_type(8)));
typedef float f32x4 __attribute__((ext_vector_type(4)));
typedef unsigned u32x4 __attribute__((ext_vector_type(4)));
#ifndef PG8_PFD
#define PG8_PFD 3
#endif
constexpr int PFD = PG8_PFD;
constexpr int BM = 256, BK = 64, HALF = 128, HTB = HALF * BK * 2  , STAGE_BYTES = 8 * HTB, NXCD = 8, WGM = 8;

__host__ __device__ __forceinline__ int lds_byte(int r, int c) { const int st = (r >> 4) * 2 + (c >> 5), rr = r & 15, cc = c & 31, ob = rr * 64 + cc * 2; return st * 1024 + (ob ^ (((ob >> 9) & 1) << 5)); }
__host__ __device__ __forceinline__ void stage_rc(int b, int& R, int& C) { const int st = b / 1024, sb = b % 1024, swz = sb ^ (((sb >> 9) & 1) << 5); R = (st >> 1) * 16 + swz / 64; C = (st & 1) * 32 + (swz % 64) / 2; }
__host__ __device__ __forceinline__ int perm32(int rho) { const int n = rho >> 4, i = rho & 15; return 8 * (i >> 2) + 4 * n + (i & 3); }

struct Unit { int pm, pn, seg; };
struct Gemm { const bf16_t* A; const bf16_t* Bt; int M, N, K; long dA, dB; };

struct StaticOrder {
    int nM, nN, nwg, G, c;
    __host__ __device__ void init(int M, int N, int G_, int c_) { nM = M / BM; nN = N / BM; nwg = nM * nN; G = G_; c = c_; }
    __host__ __device__ bool next(int i, Unit& u) const {
        const long L = (long)i * G + c; if (L >= nwg) return false;
        int wgid = (int)L; { const int q = nwg / NXCD, r = nwg % NXCD, xcd = wgid % NXCD, off = wgid / NXCD; wgid = (xcd < r ? xcd * (q + 1) : r * (q + 1) + (xcd - r) * q) + off; }
        const int nig = WGM * nN, gid = wgid / nig, fm = gid * WGM, gsz = (nM - fm) < WGM ? (nM - fm) : WGM;
        u.pm = fm + ((wgid % nig) % gsz); u.pn = (wgid % nig) / gsz; u.seg = 0; return true;
    }
    __device__ __forceinline__ void a_ready(const Unit&) const {}
    __device__ __forceinline__ void done(const Unit&) const {}
};
struct SegOrder : StaticOrder {
    __host__ __device__ bool next(int i, Unit& u) const { const bool ok = StaticOrder::next(i >> 1, u); u.seg = i & 1; return ok; }
};
__device__ __forceinline__ unsigned cvt_pk_bf16(float lo, float hi) { unsigned r; asm volatile("v_cvt_pk_bf16_f32 %0, %1, %2" : "=v"(r) : "v"(lo), "v"(hi)); return r; }
typedef unsigned u32x2 __attribute__((ext_vector_type(2)));
__device__ __forceinline__ float bf_lo(unsigned w) { return __uint_as_float(w << 16); }
__device__ __forceinline__ float bf_hi(unsigned w) { return __uint_as_float(w & 0xffff0000u); }
__device__ __forceinline__ float sigm(float x) { return __builtin_amdgcn_rcpf(1.0f + __builtin_amdgcn_exp2f(-1.4426950408889634f * x)); }
__device__ __forceinline__ float row_rstd(const float* ss, int row) {
    const f32x4* p = (const f32x4*)(ss + (size_t)row * 16);
    const f32x4 a = p[0], b = p[1], c = p[2], d = p[3];
    const float s = (((a.x + a.y) + (a.z + a.w)) + ((b.x + b.y) + (b.z + b.w))) + (((c.x + c.y) + (c.z + c.w)) + ((d.x + d.y) + (d.z + d.w)));
    return rsqrtf(s * (1.0f / 1024.0f) + EPSN);
}

template <bool ROWSCALE> struct EpiGateUp {
    static constexpr bool PERM = true, AFTER_DRAIN = false, SEG = false;
    bf16_t* O; int ldc; const float* ss;
    __device__ __forceinline__ void operator()(const f32x4 (&acc)[2][2][4][2], const Unit& u, int wr, int wc, int fr, int fq) const {
        const int row0 = u.pm * BM + wr * 64 + fr, col0 = u.pn * HALF + wc * 32 + 8 * fq;
#pragma unroll
        for (int ai = 0; ai < 2; ++ai)
#pragma unroll
            for (int m = 0; m < 4; ++m) { const int row = row0 + ai * HALF + m * 16; const float rs = ROWSCALE ? row_rstd(ss, row) : 1.0f;
                float o[8];
#pragma unroll
                for (int n = 0; n < 2; ++n)
#pragma unroll
                    for (int e = 0; e < 4; ++e) { const float g = acc[ai][0][m][n][e] * rs, up = acc[ai][1][m][n][e] * rs; o[n * 4 + e] = g * sigm(g) * up; }
                u32x4 w; w.x = cvt_pk_bf16(o[0], o[1]); w.y = cvt_pk_bf16(o[2], o[3]); w.z = cvt_pk_bf16(o[4], o[5]); w.w = cvt_pk_bf16(o[6], o[7]);
                *(u32x4*)(O + (size_t)row * ldc + col0) = w; asm volatile("" ::: "memory"); __builtin_amdgcn_sched_barrier(0); }
    }
};

template <bool F32BASE> struct EpiResid {
    static constexpr bool PERM = true, AFTER_DRAIN = false, SEG = false;
    const float* base0; const float* base1; bf16_t* hb; float* ss; float alpha;
    __device__ __forceinline__ void operator()(const f32x4 (&acc)[2][2][4][2], const Unit& u, int wr, int wc, int fr, int fq) const {
        const int row0 = u.pm * BM + wr * 64 + fr, col0 = u.pn * BM + wc * 32 + 8 * fq;
#pragma unroll
        for (int ai = 0; ai < 2; ++ai)
#pragma unroll
            for (int m = 0; m < 4; ++m) { const int row = row0 + ai * HALF + m * 16; const size_t off = (size_t)row * DMODEL + col0; float s = 0.f;
#pragma unroll
                for (int bj = 0; bj < 2; ++bj) { const f32x4 c0 = acc[ai][bj][m][0], c1 = acc[ai][bj][m][1]; f32x4 b0, b1;
                    if (F32BASE) { const float* bp = (row < MP ? base0 + (size_t)row * DMODEL : base1 + (size_t)(row - MP) * DMODEL) + col0 + bj * HALF; b0 = *(const f32x4*)bp; b1 = *(const f32x4*)(bp + 4); }
                    else { const u32x4 w = *(const u32x4*)(hb + off + bj * HALF); b0 = (f32x4){bf_lo(w.x), bf_hi(w.x), bf_lo(w.y), bf_hi(w.y)}; b1 = (f32x4){bf_lo(w.z), bf_hi(w.z), bf_lo(w.w), bf_hi(w.w)}; }
                    const f32x4 v0 = b0 + c0 * alpha, v1 = b1 + c1 * alpha;
                    s += ((v0.x * v0.x + v0.y * v0.y) + (v0.z * v0.z + v0.w * v0.w)) + ((v1.x * v1.x + v1.y * v1.y) + (v1.z * v1.z + v1.w * v1.w));
                    u32x4 o; o.x = cvt_pk_bf16(v0.x, v0.y); o.y = cvt_pk_bf16(v0.z, v0.w); o.z = cvt_pk_bf16(v1.x, v1.y); o.w = cvt_pk_bf16(v1.z, v1.w);
                    *(u32x4*)(hb + off + bj * HALF) = o; }
                s += __shfl_xor(s, 16); s += __shfl_xor(s, 32);
                if (fq == 0) ss[(size_t)row * 16 + u.pn * 4 + wc] = s;
                asm volatile("" ::: "memory"); __builtin_amdgcn_sched_barrier(0); }
    }
};

struct EpiWin {
    static constexpr bool PERM = false, AFTER_DRAIN = false, SEG = false;
    const float* ss; const float* gqk; unsigned char* ws; float qscale;
    __device__ __forceinline__ void operator()(const f32x4 (&acc)[2][2][4][2], const Unit& u, int wr, int wc, int fr, int fq) const {
        const int row0 = u.pm * BM + wr * 64 + fr;
        const int pn = u.pn;
        const bool is_rope = (pn < 2) || (pn == 2 && wc < 2);
        if (is_rope) {
            const float* g = gqk + ((pn < 2) ? 0 : 64); const float osc = (pn < 2) ? qscale : 1.0f;
            bf16_t* dst = (bf16_t*)(ws + ((pn < 2) ? (WS_QO + (size_t)(pn * 4 + wc) * 128) : (WS_K + (size_t)wc * 128))); const int ld = (pn < 2) ? 512 : 128;
            float inv[4];
#pragma unroll
            for (int e = 0; e < 4; ++e) inv[e] = __builtin_amdgcn_exp2f(-(float)(4 * fq + e) * 0.8304820237218406f);
#pragma unroll
            for (int m = 0; m < 4; ++m)
#pragma unroll
                for (int ai = 0; ai < 2; ++ai) { const int row = row0 + ai * HALF + m * 16; const float rs = row_rstd(ss, row);
                    int t = row < MP ? (row & 8191) : ((row - MP) & 4095); asm volatile("" : "+v"(t));
                    float s = 0.f;
#pragma unroll
                    for (int bj = 0; bj < 2; ++bj)
#pragma unroll
                        for (int n = 0; n < 2; ++n) { const f32x4 a = acc[ai][bj][m][n]; s += (a.x * a.x + a.y * a.y) + (a.z * a.z + a.w * a.w); }
                    s += __shfl_xor(s, 16); s += __shfl_xor(s, 32);
                    s *= rs * rs;
                    const float r = rsqrtf(s * (1.0f / 64.0f) + EPSN) * rs * osc;
#pragma unroll
                    for (int bj = 0; bj < 2; ++bj) { const float pos = (float)(bj == 0 ? (t >> 6) : (t & 63));
                        const f32x4 x1 = acc[ai][bj][m][0] * r * *(const f32x4*)(g + bj * 32 + 4 * fq), x2 = acc[ai][bj][m][1] * r * *(const f32x4*)(g + bj * 32 + 16 + 4 * fq); f32x4 o1, o2;
#pragma unroll
                        for (int e = 0; e < 4; ++e) { const float ang = pos * inv[e]; const float c = __cosf(ang), sn = __sinf(ang); o1[e] = x1[e] * c - x2[e] * sn; o2[e] = x2[e] * c + x1[e] * sn; }
                        u32x2 w1, w2; w1.x = cvt_pk_bf16(o1.x, o1.y); w1.y = cvt_pk_bf16(o1.z, o1.w); w2.x = cvt_pk_bf16(o2.x, o2.y); w2.y = cvt_pk_bf16(o2.z, o2.w);
                        bf16_t* p = dst + (size_t)row * ld + bj * 32 + 4 * fq; *(u32x2*)p = w1; *(u32x2*)(p + 16) = w2; }
                    asm volatile("" ::: "memory"); __builtin_amdgcn_sched_barrier(0); }
        } else if (pn == 2) {
            bf16_t* dst = (bf16_t*)(ws + WS_V) + (wc - 2) * 64 + 4 * fq;
#pragma unroll
            for (int ai = 0; ai < 2; ++ai)
#pragma unroll
                for (int m = 0; m < 4; ++m) { const int row = row0 + ai * HALF + m * 16; const float rs = row_rstd(ss, row);
#pragma unroll
                    for (int bj = 0; bj < 2; ++bj)
#pragma unroll
                        for (int n = 0; n < 2; ++n) { const f32x4 v = acc[ai][bj][m][n] * rs; u32x2 w; w.x = cvt_pk_bf16(v.x, v.y); w.y = cvt_pk_bf16(v.z, v.w); *(u32x2*)(dst + (size_t)row * 128 + bj * 32 + n * 16) = w; }
                    asm volatile("" ::: "memory"); __builtin_amdgcn_sched_barrier(0); }
        } else {
            const bool sg = pn >= 5; const int ld = sg ? 1024 : 512; const int ct = pn < 5 ? pn - 3 : (pn < 9 ? pn - 5 : pn - 9);
            bf16_t* dst = (bf16_t*)(ws + (pn < 5 ? WS_Z : (pn < 9 ? WS_MX : WS_SGB))) + ct * 256 + wc * 32 + 4 * fq;
#pragma unroll
            for (int ai = 0; ai < 2; ++ai)
#pragma unroll
                for (int m = 0; m < 4; ++m) { const int row = row0 + ai * HALF + m * 16; const float rs = row_rstd(ss, row);
#pragma unroll
                    for (int bj = 0; bj < 2; ++bj)
#pragma unroll
                        for (int n = 0; n < 2; ++n) { f32x4 v = acc[ai][bj][m][n] * rs; if (sg) { v.x = sigm(v.x); v.y = sigm(v.y); v.z = sigm(v.z); v.w = sigm(v.w); }
                            u32x2 w; w.x = cvt_pk_bf16(v.x, v.y); w.y = cvt_pk_bf16(v.z, v.w); *(u32x2*)(dst + (size_t)row * ld + bj * HALF + n * 16) = w; }
                    asm volatile("" ::: "memory"); __builtin_amdgcn_sched_barrier(0); }
        }
    }
};

struct EpiGateMix {
    static constexpr bool PERM = true, AFTER_DRAIN = false, SEG = true;
    bf16_t* Mx; const bf16_t* SGB;
    __device__ __forceinline__ void operator()(f32x4 (&acc)[2][2][4][2], const Unit& u, int wr, int wc, int fr, int fq) const {
        const int row0 = u.pm * BM + wr * 64 + fr, col0 = u.pn * BM + wc * 32 + 8 * fq;
#pragma unroll
        for (int ai = 0; ai < 2; ++ai)
#pragma unroll
            for (int m = 0; m < 4; ++m) { const size_t off = (size_t)(row0 + ai * HALF + m * 16) * DMODEL + col0;
#pragma unroll
                for (int bj = 0; bj < 2; ++bj) { const u32x4 g = *(const u32x4*)(SGB + off + bj * HALF);
                    f32x4 g0 = (f32x4){bf_lo(g.x), bf_hi(g.x), bf_lo(g.y), bf_hi(g.y)}, g1 = (f32x4){bf_lo(g.z), bf_hi(g.z), bf_lo(g.w), bf_hi(g.w)};
                    if (u.seg == 0) { const u32x4 a = *(const u32x4*)(Mx + off + bj * HALF);
                        const f32x4 a0 = (f32x4){bf_lo(a.x), bf_hi(a.x), bf_lo(a.y), bf_hi(a.y)}, a1 = (f32x4){bf_lo(a.z), bf_hi(a.z), bf_lo(a.w), bf_hi(a.w)};
#pragma unroll
                        for (int e = 0; e < 4; ++e) { acc[ai][bj][m][0][e] *= a0[e] * __builtin_amdgcn_rcpf(g0[e]); acc[ai][bj][m][1][e] *= a1[e] * __builtin_amdgcn_rcpf(g1[e]); } }
                    else { const f32x4 v0 = acc[ai][bj][m][0] * g0, v1 = acc[ai][bj][m][1] * g1;
                        u32x4 w; w.x = cvt_pk_bf16(v0.x, v0.y); w.y = cvt_pk_bf16(v0.z, v0.w); w.z = cvt_pk_bf16(v1.x, v1.y); w.w = cvt_pk_bf16(v1.z, v1.w);
                        *(u32x4*)(Mx + off + bj * HALF) = w; } }
                asm volatile("" ::: "memory"); }
    }
};

struct EpiE {
    static constexpr bool PERM = true, AFTER_DRAIN = false, SEG = false;
    bf16_t* E; float* ss;
    __device__ __forceinline__ void operator()(const f32x4 (&acc)[2][2][4][2], const Unit& u, int wr, int wc, int fr, int fq) const {
        const int row0 = u.pm * BM + wr * 64 + fr, col0 = u.pn * BM + wc * 32 + 8 * fq;
#pragma unroll
        for (int ai = 0; ai < 2; ++ai)
#pragma unroll
            for (int m = 0; m < 4; ++m) { const int row = row0 + ai * HALF + m * 16; float s = 0.f;
#pragma unroll
                for (int bj = 0; bj < 2; ++bj) { const f32x4 c0 = acc[ai][bj][m][0], c1 = acc[ai][bj][m][1];
                    s += ((c0.x * c0.x + c0.y * c0.y) + (c0.z * c0.z + c0.w * c0.w)) + ((c1.x * c1.x + c1.y * c1.y) + (c1.z * c1.z + c1.w * c1.w));
                    u32x4 w; w.x = cvt_pk_bf16(c0.x, c0.y); w.y = cvt_pk_bf16(c0.z, c0.w); w.z = cvt_pk_bf16(c1.x, c1.y); w.w = cvt_pk_bf16(c1.z, c1.w);
                    *(u32x4*)(E + (size_t)row * DMODEL + col0 + bj * HALF) = w; }
                s += __shfl_xor(s, 16); s += __shfl_xor(s, 32);
                if (fq == 0) ss[(size_t)row * 16 + u.pn * 4 + wc] = s; }
    }
};

struct EpiFinal {
    static constexpr bool PERM = true, AFTER_DRAIN = false, SEG = false;
    float* out; const bf16_t* hb; const bf16_t* E; const float* ss; const float* sse; const float* gpost;
    __device__ __forceinline__ void operator()(const f32x4 (&acc)[2][2][4][2], const Unit& u, int wr, int wc, int fr, int fq) const {
        const int row0 = u.pm * BM + wr * 64 + fr, col0 = u.pn * BM + wc * 32 + 8 * fq;
        f32x4 gv[2][2];
#pragma unroll
        for (int bj = 0; bj < 2; ++bj)
#pragma unroll
            for (int n = 0; n < 2; ++n) gv[bj][n] = *(const f32x4*)(gpost + col0 + bj * HALF + n * 4);
#pragma unroll
        for (int ai = 0; ai < 2; ++ai)
#pragma unroll
            for (int m = 0; m < 4; ++m) { const int row = row0 + ai * HALF + m * 16; const float rs = row_rstd(ss, row), re = row_rstd(sse, row);
                const size_t off = (size_t)row * DMODEL + col0;
#pragma unroll
                for (int bj = 0; bj < 2; ++bj) { const u32x4 hw = *(const u32x4*)(hb + off + bj * HALF), ew = *(const u32x4*)(E + off + bj * HALF);
                    const f32x4 h0 = (f32x4){bf_lo(hw.x), bf_hi(hw.x), bf_lo(hw.y), bf_hi(hw.y)}, h1 = (f32x4){bf_lo(hw.z), bf_hi(hw.z), bf_lo(hw.w), bf_hi(hw.w)};
                    const f32x4 e0 = (f32x4){bf_lo(ew.x), bf_hi(ew.x), bf_lo(ew.y), bf_hi(ew.y)} * re * gv[bj][0], e1 = (f32x4){bf_lo(ew.z), bf_hi(ew.z), bf_lo(ew.w), bf_hi(ew.w)} * re * gv[bj][1];
                    const f32x4 a0 = acc[ai][bj][m][0] * rs, a1 = acc[ai][bj][m][1] * rs; f32x4 y0, y1;
#pragma unroll
                    for (int e = 0; e < 4; ++e) { y0[e] = h0[e] + sigm(a0[e]) * e0[e]; y1[e] = h1[e] + sigm(a1[e]) * e1[e]; }
                    *(f32x4*)(out + off + bj * HALF) = y0; *(f32x4*)(out + off + bj * HALF + 4) = y1; }
                asm volatile("" ::: "memory"); __builtin_amdgcn_sched_barrier(0); }
    }
};

template <class Epi, class Sched, bool ALIGN_EPI = false, bool SP2 = false>
__device__ __forceinline__ void gemm_phase(PG8_LAS unsigned char* lds, const Gemm g, const Sched& S, const Epi& E) {
    int tid = threadIdx.x; asm volatile("" : "+v"(tid));
    const int wid = __builtin_amdgcn_readfirstlane(tid >> 6), lane = tid & 63, wr = wid >> 2, wc = wid & 3, fr = lane & 15, fq = lane >> 4;
    const int K = g.K, nt = K / BK;
    unsigned voffA[2], voffB[2];
#pragma unroll
    for (int i = 0; i < 2; ++i) { int R, C; stage_rc(tid * 16 + i * 8192, R, C); const int Rb = Epi::PERM ? ((R & ~31) + perm32(R & 31)) : R;
        voffA[i] = (unsigned)(R * K + C) * 2u; voffB[i] = (unsigned)(Rb * K + C) * 2u; }
    const size_t kstep = (size_t)(BK * 2);
    const size_t hstep = (size_t)HALF * K * 2;
    const size_t tstep = 2 * hstep;
    const unsigned ldsw = (unsigned)wid * 1024u;
    const int aoff = lds_byte(wr * 64 + fr, fq * 8), boff = lds_byte(wc * 32 + fr, fq * 8);
#define PG8_SA(b, h) (((b) * 2 + (h)) * HTB)
#define PG8_SB(b, h) ((4 + (b) * 2 + (h)) * HTB)
#define PG8_STAGE(bufoff, gbase, voff) do { _Pragma("unroll") for (int _i = 0; _i < 2; ++_i) \
        __builtin_amdgcn_global_load_lds((const unsigned*)((const char*)(gbase) + (voff)[_i]), (PG8_LAS unsigned*)(lds + (bufoff) + ldsw + _i * 8192), 16, 0, 0); } while (0)
#define PG8_LDA(dst, b, h) do { _Pragma("unroll") for (int m = 0; m < 4; ++m) _Pragma("unroll") for (int k = 0; k < 2; ++k) dst[m][k] = *(const PG8_LAS bf16x8*)(lds + PG8_SA(b, h) + aoff + m * 2048 + k * 1024); } while (0)
#define PG8_LDB(dst, b, h) do { _Pragma("unroll") for (int n = 0; n < 2; ++n) _Pragma("unroll") for (int k = 0; k < 2; ++k) dst[n][k] = *(const PG8_LAS bf16x8*)(lds + PG8_SB(b, h) + boff + n * 2048 + k * 1024); } while (0)
#define PG8_MMA(ai, bj, At, Bt) do { __builtin_amdgcn_s_setprio(1); _Pragma("unroll") for (int m = 0; m < 4; ++m) _Pragma("unroll") for (int n = 0; n < 2; ++n) _Pragma("unroll") for (int k = 0; k < 2; ++k) \
        acc[ai][bj][m][n] = __builtin_amdgcn_mfma_f32_16x16x32_bf16(Bt[n][k], At[m][k], acc[ai][bj][m][n], 0, 0, 0); __builtin_amdgcn_s_setprio(0); } while (0)
#define PG8_WAIT_V(n) asm volatile("s_waitcnt vmcnt(" #n ")" ::: "memory")
#define PG8_WAIT_L(n) asm volatile("s_waitcnt lgkmcnt(" #n ")" ::: "memory")
#define PG8_BAR __builtin_amdgcn_s_barrier()
#define PG8_SCHED __builtin_amdgcn_sched_barrier(0)
    Unit cur, nxt; int ui = 0;
    if (!S.next(0, cur)) return;
    f32x4 acc[2][2][4][2];
#pragma unroll
    for (int a = 0; a < 2; ++a)
#pragma unroll
        for (int b = 0; b < 2; ++b)
#pragma unroll
            for (int m = 0; m < 4; ++m)
#pragma unroll
                for (int n = 0; n < 2; ++n) acc[a][b][m][n] = (f32x4){0.f, 0.f, 0.f, 0.f};
    bf16x8 At[4][2], B0[2][2], B1[2][2];
    const char* cA = (const char*)g.A + (size_t)cur.pm * tstep + (size_t)cur.seg * g.dA; const char* cB = (const char*)g.Bt + (size_t)cur.pn * tstep + (size_t)cur.seg * g.dB;
    S.a_ready(cur);
    if constexpr (SP2) {
        PG8_STAGE(PG8_SB(0, 0), cB, voffB); PG8_STAGE(PG8_SB(0, 1), cB + hstep, voffB); PG8_STAGE(PG8_SA(0, 0), cA, voffA); PG8_STAGE(PG8_SA(0, 1), cA + hstep, voffA);
        if (wr == 1) PG8_BAR;
        PG8_WAIT_V(2); PG8_BAR;
        PG8_STAGE(PG8_SB(1, 0), cB + kstep, voffB); PG8_STAGE(PG8_SA(1, 0), cA + kstep, voffA); PG8_STAGE(PG8_SB(1, 1), cB + hstep + kstep, voffB);
        PG8_WAIT_V(6); PG8_BAR;
    } else {
        PG8_STAGE(PG8_SB(0, 0), cB, voffB); PG8_STAGE(PG8_SA(0, 0), cA, voffA); PG8_STAGE(PG8_SB(0, 1), cB + hstep, voffB); PG8_STAGE(PG8_SA(0, 1), cA + hstep, voffA);
        if (wr == 1) PG8_BAR;
        PG8_WAIT_V(4); PG8_BAR;
        PG8_STAGE(PG8_SB(1, 0), cB + kstep, voffB); PG8_STAGE(PG8_SA(1, 0), cA + kstep, voffA); PG8_STAGE(PG8_SB(1, 1), cB + hstep + kstep, voffB);
        PG8_WAIT_V(6); PG8_BAR;
    }
    for (;;) {
        const bool has_next = S.next(ui + 1, nxt);
        const char* nA = has_next ? (const char*)g.A + (size_t)nxt.pm * tstep + (size_t)nxt.seg * g.dA : cA; const char* nB = has_next ? (const char*)g.Bt + (size_t)nxt.pn * tstep + (size_t)nxt.seg * g.dB : cB;
#pragma unroll 1
        for (int t = 0; t < nt; t += 2) {
            const bool last = (t == nt - 2);
            const char* a1 = cA + (size_t)(t + 1) * kstep;
            const char* a2 = last ? nA : cA + (size_t)(t + 2) * kstep; const char* b2 = last ? nB : cB + (size_t)(t + 2) * kstep;
            const char* a3 = a2 + kstep; const char* b3 = b2 + kstep;
            if (last && has_next) S.a_ready(nxt);
            if constexpr (SP2) {
            PG8_LDB(B0, 0, 0); PG8_LDB(B1, 0, 1); PG8_SCHED; PG8_LDA(At, 0, 0); PG8_STAGE(PG8_SA(1, 1), a1 + hstep, voffA);
            PG8_WAIT_V(8); PG8_WAIT_L(0); PG8_BAR; PG8_MMA(0, 0, At, B0); PG8_MMA(0, 1, At, B1); PG8_BAR; PG8_SCHED;
            PG8_LDA(At, 0, 1); PG8_STAGE(PG8_SB(0, 0), b2, voffB); PG8_STAGE(PG8_SB(0, 1), b2 + hstep, voffB); PG8_STAGE(PG8_SA(0, 0), a2, voffA);
            PG8_WAIT_V(8); PG8_WAIT_L(0); PG8_BAR; PG8_MMA(1, 0, At, B0); PG8_MMA(1, 1, At, B1); PG8_BAR; PG8_SCHED;
            PG8_LDB(B0, 1, 0); PG8_LDB(B1, 1, 1); PG8_SCHED; PG8_LDA(At, 1, 0); PG8_STAGE(PG8_SA(0, 1), a2 + hstep, voffA);
            PG8_WAIT_V(8); PG8_WAIT_L(0); PG8_BAR; PG8_MMA(0, 0, At, B0); PG8_MMA(0, 1, At, B1); PG8_BAR; PG8_SCHED;
            PG8_LDA(At, 1, 1); PG8_STAGE(PG8_SB(1, 0), b3, voffB); PG8_STAGE(PG8_SB(1, 1), b3 + hstep, voffB); PG8_STAGE(PG8_SA(1, 0), a3, voffA);
            PG8_WAIT_V(8); PG8_WAIT_L(0); PG8_BAR; PG8_MMA(1, 0, At, B0); PG8_MMA(1, 1, At, B1); PG8_BAR; PG8_SCHED;
            } else {
            PG8_LDB(B0, 0, 0); PG8_SCHED; PG8_LDA(At, 0, 0); PG8_STAGE(PG8_SA(1, 1), a1 + hstep, voffA);
            PG8_WAIT_L(8); PG8_BAR; PG8_WAIT_L(0); PG8_MMA(0, 0, At, B0); PG8_BAR; PG8_SCHED;
            PG8_LDB(B1, 0, 1); PG8_STAGE(PG8_SB(0, 0), b2, voffB);
            PG8_BAR; PG8_WAIT_L(0); PG8_MMA(0, 1, At, B1); PG8_BAR;
            PG8_LDA(At, 0, 1); PG8_STAGE(PG8_SA(0, 0), a2, voffA);
            PG8_BAR; PG8_WAIT_L(0); PG8_MMA(1, 0, At, B0); PG8_BAR; PG8_SCHED;
            PG8_STAGE(PG8_SB(0, 1), b2 + hstep, voffB);
            PG8_WAIT_V(6); PG8_BAR; PG8_MMA(1, 1, At, B1); PG8_BAR;
            PG8_LDB(B0, 1, 0); PG8_SCHED; PG8_LDA(At, 1, 0); PG8_STAGE(PG8_SA(0, 1), a2 + hstep, voffA);
            PG8_WAIT_L(8); PG8_BAR; PG8_WAIT_L(0); PG8_MMA(0, 0, At, B0); PG8_BAR; PG8_SCHED;
            PG8_LDB(B1, 1, 1); PG8_STAGE(PG8_SB(1, 0), b3, voffB);
            PG8_BAR; PG8_WAIT_L(0); PG8_MMA(0, 1, At, B1); PG8_BAR;
            PG8_LDA(At, 1, 1); PG8_STAGE(PG8_SA(1, 0), a3, voffA);
            PG8_BAR; PG8_WAIT_L(0); PG8_MMA(1, 0, At, B0); PG8_BAR; PG8_SCHED;
            PG8_STAGE(PG8_SB(1, 1), b3 + hstep, voffB);
            PG8_WAIT_V(6); PG8_BAR; PG8_MMA(1, 1, At, B1); PG8_BAR;
            }
        }
        if constexpr (ALIGN_EPI) { if (wr == 0) PG8_BAR; }
        if constexpr (!Epi::AFTER_DRAIN) { E(acc, cur, wr, wc, fr, fq); S.done(cur); }
        if (!has_next) break;
        if (!(Epi::SEG && cur.seg == 0))
#pragma unroll
        for (int a = 0; a < 2; ++a)
#pragma unroll
            for (int b = 0; b < 2; ++b)
#pragma unroll
                for (int m = 0; m < 4; ++m)
#pragma unroll
                    for (int n = 0; n < 2; ++n) acc[a][b][m][n] = (f32x4){0.f, 0.f, 0.f, 0.f};
        cur = nxt; cA = nA; cB = nB; ++ui;
        if constexpr (ALIGN_EPI) { if (wr == 1) PG8_BAR; }
    }
    PG8_WAIT_V(0);
    if constexpr (!ALIGN_EPI) { if (wr == 0) PG8_BAR; }
    PG8_BAR;
    if constexpr (Epi::AFTER_DRAIN) { E.fused(acc, cur, wr, wc, fr, fq, lds, wid, lane); S.done(cur); }
#undef PG8_SA
#undef PG8_SB
#undef PG8_STAGE
#undef PG8_LDA
#undef PG8_LDB
#undef PG8_MMA
#undef PG8_WAIT_V
#undef PG8_WAIT_L
#undef PG8_BAR
#undef PG8_SCHED
}
}
#include <hip/hip_bf16.h>
#include <cmath>
namespace attn_body {
using bf16=__hip_bfloat16;
using bf16x8=__attribute__((ext_vector_type(8)))short;
using s16x4=__attribute__((ext_vector_type(4)))short;
using f32x16=__attribute__((ext_vector_type(16)))float;
using u32x4=__attribute__((ext_vector_type(4)))unsigned;
constexpr int D=64,QP=512,KP=128;
constexpr int NW=8,QBLK=32,QB=QBLK*NW,KVBLK=64;
constexpr int ATTN_UNIT_ROWS=QB;
__device__ __forceinline__ int crow(int r,int hi){return (r&3)+8*(r>>2)+4*hi;}
#define SBAR() __builtin_amdgcn_sched_barrier(0)
__device__ __forceinline__ void cmask(f32x16&p0,f32x16&p1,int jb,int qrel,int hi){
  const float NEG=-INFINITY; int kb=64*jb+4*hi;
  #pragma unroll
  for(int r=0;r<16;++r){int kv=kb+(r&3)+8*(r>>2); if(kv>qrel)p0[r]=NEG; if(kv+32>qrel)p1[r]=NEG;}
}

constexpr int NSLOT=3, SLOTB=8192;
constexpr int LDS_K=0, LDS_V=NSLOT*SLOTB, LDS_WS=2*NSLOT*SLOTB, LDS_OST=LDS_WS+NW*64*4, LDS_BYTES=LDS_OST+NW*4096;
constexpr float C2=0.125f*1.4426950408889634f;
__device__ __forceinline__ void glds16(const void*gsrc,unsigned lds_dst){unsigned keep;
  asm volatile("s_mov_b32 %0, m0\n\ts_mov_b32 m0, %2\n\ts_nop 0\n\tglobal_load_lds_dwordx4 %1, off\n\ts_mov_b32 m0, %0":"=&s"(keep):"v"(gsrc),"s"(lds_dst):"memory");}
__device__ __forceinline__ float max3f(float a,float b,float c){float r;asm("v_max3_f32 %0, %1, %2, %3":"=v"(r):"v"(a),"v"(b),"v"(c));return r;}
__device__ __forceinline__ float max2f(float a,float b){float r;asm("v_max_f32_e32 %0, %1, %2":"=v"(r):"v"(a),"v"(b));return r;}
__device__ __forceinline__ float fadd_s(float a,float b){float r;asm("v_add_f32_e32 %0, %1, %2":"=v"(r):"v"(a),"v"(b));return r;}
__device__ __forceinline__ float fsub_s(float a,float b){float r;asm("v_sub_f32_e32 %0, %1, %2":"=v"(r):"v"(a),"v"(b));return r;}
typedef float f32x2_t __attribute__((ext_vector_type(2))); typedef __bf16 bf16x2_t __attribute__((ext_vector_type(2)));
__device__ __forceinline__ unsigned cvtpk_s(float lo,float hi){f32x2_t v={lo,hi};bf16x2_t b=__builtin_convertvector(v,bf16x2_t);return __builtin_bit_cast(unsigned,b);}
#define WAIT_BAR(N) asm volatile("s_waitcnt vmcnt(" #N ") lgkmcnt(0)\n\ts_barrier":::"memory")

__device__ __forceinline__ void qkt(f32x16&p0,f32x16&p1,const char*Kslot,const bf16x8*qr,const f32x16&negm,int r32,int hi){
  const char*kb=Kslot+hi*1024+r32*16;
  #pragma unroll
  for(int d0=0;d0<4;++d0){
    const bf16x8 b0=*reinterpret_cast<const bf16x8*>(kb+d0*2048);
    const bf16x8 b1=*reinterpret_cast<const bf16x8*>(kb+d0*2048+512);
    if(d0==0){p0=__builtin_amdgcn_mfma_f32_32x32x16_bf16(b0,qr[0],negm,0,0,0);p1=__builtin_amdgcn_mfma_f32_32x32x16_bf16(b1,qr[0],negm,0,0,0);}
    else{p0=__builtin_amdgcn_mfma_f32_32x32x16_bf16(b0,qr[d0],p0,0,0,0);p1=__builtin_amdgcn_mfma_f32_32x32x16_bf16(b1,qr[d0],p1,0,0,0);}}
}
typedef __attribute__((address_space(3))) const char* lds_cptr;
typedef short v4i16_t __attribute__((ext_vector_type(4)));
__device__ __forceinline__ void kload8(bf16x8*kf,lds_cptr kp){
  kf[0]=*(const __attribute__((address_space(3))) bf16x8*)(kp);      kf[1]=*(const __attribute__((address_space(3))) bf16x8*)(kp+512);
  kf[2]=*(const __attribute__((address_space(3))) bf16x8*)(kp+2048); kf[3]=*(const __attribute__((address_space(3))) bf16x8*)(kp+2560);
  kf[4]=*(const __attribute__((address_space(3))) bf16x8*)(kp+4096); kf[5]=*(const __attribute__((address_space(3))) bf16x8*)(kp+4608);
  kf[6]=*(const __attribute__((address_space(3))) bf16x8*)(kp+6144); kf[7]=*(const __attribute__((address_space(3))) bf16x8*)(kp+6656);
}
__device__ __forceinline__ void kload2(bf16x8*kf,lds_cptr kp,int j){ kf[2*j]=*(const __attribute__((address_space(3))) bf16x8*)(kp+j*2048); kf[2*j+1]=*(const __attribute__((address_space(3))) bf16x8*)(kp+j*2048+512); }
__device__ __forceinline__ s16x4 vtr(lds_cptr p){ return __builtin_bit_cast(s16x4,__builtin_amdgcn_ds_read_tr16_b64_v4i16((__attribute__((address_space(3))) v4i16_t*)p)); }
__device__ __forceinline__ float rowmax(const f32x16&p0,const f32x16&p1){
  float a=max3f(p0[0],p0[1],p1[0]),b=max3f(p0[2],p0[3],p1[1]);a=max3f(a,p1[2],p1[3]);
  #pragma unroll
  for(int r=4;r<16;r+=4){a=max3f(a,p0[r],p0[r+1]);b=max3f(b,p0[r+2],p0[r+3]);a=max3f(a,p1[r],p1[r+1]);b=max3f(b,p1[r+2],p1[r+3]);}
  const float m=max2f(a,b);
  auto rr=__builtin_amdgcn_permlane32_swap(__float_as_uint(m),__float_as_uint(m),false,false);
  return max2f(__uint_as_float(rr[0]),__uint_as_float(rr[1]));
}
__device__ __forceinline__ void pv(f32x16*o,int vb,bf16x8 pa0,bf16x8 pa1,bf16x8 pa2,bf16x8 pa3){
  #pragma unroll
  for(int d0=0;d0<2;++d0){s16x4 lo[4],hi[4];
    #pragma unroll
    for(int ks=0;ks<4;++ks){
      asm volatile("ds_read_b64_tr_b16 %0,%1 offset:%c2":"=&v"(lo[ks]):"v"(vb),"i"(d0*4096+ks*1024):"memory");
      asm volatile("ds_read_b64_tr_b16 %0,%1 offset:%c2":"=&v"(hi[ks]):"v"(vb),"i"(d0*4096+ks*1024+512):"memory");}
    asm volatile("s_waitcnt lgkmcnt(0)":::"memory");SBAR();
    #define PK(k) (bf16x8){lo[k][0],lo[k][1],lo[k][2],lo[k][3],hi[k][0],hi[k][1],hi[k][2],hi[k][3]}
    o[d0]=__builtin_amdgcn_mfma_f32_32x32x16_bf16(pa0,PK(0),o[d0],0,0,0);
    o[d0]=__builtin_amdgcn_mfma_f32_32x32x16_bf16(pa1,PK(1),o[d0],0,0,0);
    o[d0]=__builtin_amdgcn_mfma_f32_32x32x16_bf16(pa2,PK(2),o[d0],0,0,0);
    o[d0]=__builtin_amdgcn_mfma_f32_32x32x16_bf16(pa3,PK(3),o[d0],0,0,0);
    #undef PK
  }
}

#ifndef ATTN_STORE16
#define ATTN_STORE16(p,v) (*(u32x4*)(p)=(v))
#endif
template<int THRL> __device__ __forceinline__ void attn_unit(long rowbase,int h,int qb,int NT,const bf16*Q,const bf16*__restrict__ K,const bf16*__restrict__ V,bf16*O,char*shm){
  int tid=threadIdx.x; asm volatile("":"+v"(tid)); const int lane=tid&63,r32=lane&31,hi=lane>>5; const int wid=__builtin_amdgcn_readfirstlane(tid>>6);
  const int q0=qb*QB;
  const bf16*Qw=Q+(rowbase+q0+wid*QBLK)*QP+h*D;
  const bf16*Kh=K+rowbase*KP+(h>>2)*D,*Vh=V+rowbase*KP+(h>>2)*D;
  const unsigned lds0=(unsigned)(uintptr_t)shm;
  float*wsf=(float*)(shm+LDS_WS)+wid*64;
  const bf16*ksrc=Kh+(long)lane*KP+wid*8;
  const bf16*vsrc=Vh+(long)(16*(wid&3)+(lane>>2))*KP+(wid>>2)*32+(lane&3)*8;
  const unsigned kdst=lds0+LDS_K+wid*1024, vdst=lds0+LDS_V+wid*1024;
  #define DMA_K(t,slot) glds16(ksrc+(long)(t)*KVBLK*KP,(unsigned)__builtin_amdgcn_readfirstlane(kdst+(slot)))
  #define DMA_V(t,slot) glds16(vsrc+(long)(t)*KVBLK*KP,(unsigned)__builtin_amdgcn_readfirstlane(vdst+(slot)))
  const int vb0=(int)(lds0+LDS_V)+((lane>>4)&1)*32+(lane&3)*8+(4*hi+((lane&15)>>2))*64;
  const char*Kbase=shm+LDS_K; bf16x8 kf[8];
  const lds_cptr shm3=(lds_cptr)shm; const lds_cptr kp0=shm3+LDS_K+hi*1024+r32*16; const lds_cptr vp0=shm3+LDS_V+((lane>>4)&1)*32+(lane&3)*8+(4*hi+((lane&15)>>2))*64;
  DMA_K(0,0);DMA_V(0,0);DMA_K(1,SLOTB);
  bf16x8 qr[4];
  #pragma unroll
  for(int d0=0;d0<4;++d0)qr[d0]=*reinterpret_cast<const bf16x8*>(&Qw[(long)r32*QP+d0*16+hi*8]);
  float mhat=0.f,l_reg=0.f;f32x16 o[2];o[0]=f32x16{};o[1]=f32x16{};f32x16 negm=f32x16{};asm volatile("":"+v"(negm));
    #define CMASK(P0,P1,t) do{}while(0)
  bool resc=false;
  #define START(P0,P1) do{ const float rm=rowmax(P0,P1); resc=false; \
    { const float dl=rm; mhat=fadd_s(mhat,dl); \
      _Pragma("unroll") for(int r=0;r<16;++r){P0[r]=fsub_s(P0[r],dl);P1[r]=fsub_s(P1[r],dl);} \
      _Pragma("unroll") for(int r=0;r<16;++r)negm[r]=-mhat; asm volatile("":"+v"(negm)); } \
    _Pragma("unroll") for(int r=0;r<16;++r)P0[r]=__builtin_amdgcn_exp2f(P0[r]); }while(0)
  #define RESC() do{ if(resc){ asm volatile("s_waitcnt lgkmcnt(0)":::"memory"); \
      _Pragma("unroll") for(int d_=0;d_<2;++d_) _Pragma("unroll") for(int r=0;r<16;++r)o[d_][r]*=wsf[crow(r,hi)]; } }while(0)
  f32x16 pA0,pA1,pB0,pB1;
  int sl_prev=0,sl_cur=0,sl_next=SLOTB;
  #define ROT() do{sl_prev=sl_cur;sl_cur=sl_next;sl_next=(sl_next==(NSLOT-1)*SLOTB)?0:sl_next+SLOTB;}while(0)
  DMA_K(2,2*SLOTB);
  WAIT_BAR(3);
  qkt(pA0,pA1,Kbase,qr,negm,r32,hi);asm volatile("s_nop 15\n\ts_nop 7":"+v"(pA0),"+v"(pA1));CMASK(pA0,pA1,0);
  START(pA0,pA1);
  _Pragma("unroll") for(int r=0;r<16;++r)pA1[r]=__builtin_amdgcn_exp2f(pA1[r]);
  WAIT_BAR(0);
  DMA_K(3,0);DMA_V(1,SLOTB);
  ROT();
  kload8(kf,kp0+sl_cur);
  WAIT_BAR(2);
  s16x4 vlo[8],vhi[8]; u32x4 pw0,pw1,pw2,pw3;
  #define PKW(P,B) cvtpk_s(P[B],P[B+1])
  #define PAF(k) __builtin_bit_cast(bf16x8,pw##k)
  #define VFR(i) (bf16x8){vlo[i][0],vlo[i][1],vlo[i][2],vlo[i][3],vhi[i][0],vhi[i][1],vhi[i][2],vhi[i][3]}
  #define PIN(x) asm volatile("":"+v"(x))
  #define MX3(a,b,c) __builtin_fmaxf(__builtin_fmaxf((a),(b)),(c))
  #define GAPA(MF,A0,A1,A2,A3,W0,W1,PW) do{ MF; sacc+=A0; sacc+=A1; sacc+=A2; sacc+=A3; PIN(sacc); W0; W1; PIN(PW); SBAR(); }while(0)
  #define EX(v) __builtin_amdgcn_exp2f(v)
  #define GAPB(MF,X,B) do{ MF; X[B]=EX(X[B]); X[B+1]=EX(X[B+1]); X[B+2]=EX(X[B+2]); X[B+3]=EX(X[B+3]); PIN(X); SBAR(); }while(0)
  #define VRD(i) do{ vlo[i]=vtr(vp_+(((i)>>2)*4096+((i)&3)*1024)); vhi[i]=vtr(vp_+(((i)>>2)*4096+((i)&3)*1024+512)); }while(0)
  #define KRD(G,j) do{ if(G){ kload2(kf,kp0+sl_next,j); SBAR(); } }while(0)
  #define STEP(C0,C1,P0,P1,t,GK,GV,GL) do{ SBAR(); \
    const lds_cptr vp_=vp0+sl_prev; \
    VRD(0); SBAR(); float sacc=(P0[0]+P0[1]); \
    GAPA(C0=__builtin_amdgcn_mfma_f32_32x32x16_bf16(kf[0],qr[0],negm,0,0,0), P0[2],P0[3],P0[4],P0[5],     pw0[0]=PKW(P0,0), pw0[1]=PKW(P0,2), pw0); \
    VRD(4); SBAR(); GAPA(C1=__builtin_amdgcn_mfma_f32_32x32x16_bf16(kf[1],qr[0],negm,0,0,0), P0[6],P0[7],P0[8],P0[9],     pw0[2]=PKW(P0,4), pw0[3]=PKW(P0,6), pw0); \
    VRD(1); SBAR(); GAPA(C0=__builtin_amdgcn_mfma_f32_32x32x16_bf16(kf[2],qr[1],C0,0,0,0),   P0[10],P0[11],P0[12],P0[13], pw1[0]=PKW(P0,8), pw1[1]=PKW(P0,10), pw1); \
    VRD(5); SBAR(); GAPA(C1=__builtin_amdgcn_mfma_f32_32x32x16_bf16(kf[3],qr[1],C1,0,0,0),   P0[14],P0[15],P1[0],P1[1],   pw1[2]=PKW(P0,12),pw1[3]=PKW(P0,14), pw1); \
    VRD(2); SBAR(); GAPA(C0=__builtin_amdgcn_mfma_f32_32x32x16_bf16(kf[4],qr[2],C0,0,0,0),   P1[2],P1[3],P1[4],P1[5],     pw2[0]=PKW(P1,0), pw2[1]=PKW(P1,2), pw2); \
    VRD(6); SBAR(); GAPA(C1=__builtin_amdgcn_mfma_f32_32x32x16_bf16(kf[5],qr[2],C1,0,0,0),   P1[6],P1[7],P1[8],P1[9],     pw2[2]=PKW(P1,4), pw2[3]=PKW(P1,6), pw2); \
    VRD(3); SBAR(); GAPA(C0=__builtin_amdgcn_mfma_f32_32x32x16_bf16(kf[6],qr[3],C0,0,0,0),   P1[10],P1[11],P1[12],P1[13], pw3[0]=PKW(P1,8), pw3[1]=PKW(P1,10), pw3); \
    VRD(7); SBAR(); GAPA(C1=__builtin_amdgcn_mfma_f32_32x32x16_bf16(kf[7],qr[3],C1,0,0,0),   P1[14],P1[15],0.f,0.f,       pw3[2]=PKW(P1,12),pw3[3]=PKW(P1,14), pw3); \
    l_reg+=sacc; \
    if(GK){DMA_K((t)+3,sl_cur);} if(GV){DMA_V((t)+1,sl_next);} \
    CMASK(C0,C1,t); \
    { float a=MX3(C0[0],C0[1],C1[0]),b=MX3(C0[2],C0[3],C1[1]); a=MX3(a,C1[2],C1[3]); \
      _Pragma("unroll") for(int r=4;r<16;r+=4){a=MX3(a,C0[r],C0[r+1]);b=MX3(b,C0[r+2],C0[r+3]);a=MX3(a,C1[r],C1[r+1]);b=MX3(b,C1[r+2],C1[r+3]);} \
      float rm=__builtin_fmaxf(a,b); { auto rr=__builtin_amdgcn_permlane32_swap(__float_as_uint(rm),__float_as_uint(rm),false,false); rm=__builtin_fmaxf(__uint_as_float(rr[0]),__uint_as_float(rr[1])); } \
      resc=false; \
      if(__builtin_expect(__any(rm>(float)THRL),0)){ const float dl=__builtin_fmaxf(rm,0.f); mhat+=dl; \
        _Pragma("unroll") for(int r=0;r<16;++r){C0[r]-=dl;C1[r]-=dl;} \
        _Pragma("unroll") for(int r=0;r<16;++r)negm[r]=-mhat; asm volatile("":"+v"(negm)); \
        const float f=__builtin_amdgcn_exp2f(-dl); l_reg*=f; if(hi==0)wsf[r32]=f; resc=true; } } \
    SBAR(); \
    GAPB(o[0]=__builtin_amdgcn_mfma_f32_32x32x16_bf16(PAF(0),VFR(0),o[0],0,0,0), C0,0); \
    GAPB(o[1]=__builtin_amdgcn_mfma_f32_32x32x16_bf16(PAF(0),VFR(4),o[1],0,0,0), C0,4); \
    KRD(GL,0); GAPB(o[0]=__builtin_amdgcn_mfma_f32_32x32x16_bf16(PAF(1),VFR(1),o[0],0,0,0), C0,8); \
    KRD(GL,1); GAPB(o[1]=__builtin_amdgcn_mfma_f32_32x32x16_bf16(PAF(1),VFR(5),o[1],0,0,0), C0,12); \
    KRD(GL,2); GAPB(o[0]=__builtin_amdgcn_mfma_f32_32x32x16_bf16(PAF(2),VFR(2),o[0],0,0,0), C1,0); \
    KRD(GL,3); GAPB(o[1]=__builtin_amdgcn_mfma_f32_32x32x16_bf16(PAF(2),VFR(6),o[1],0,0,0), C1,4); \
    GAPB(o[0]=__builtin_amdgcn_mfma_f32_32x32x16_bf16(PAF(3),VFR(3),o[0],0,0,0), C1,8); \
    GAPB(o[1]=__builtin_amdgcn_mfma_f32_32x32x16_bf16(PAF(3),VFR(7),o[1],0,0,0), C1,12); \
    }while(0)
  int t=1;
  #undef CMASK
  #define CMASK(P0,P1,t) do{}while(0)
  for(;t+5<NT;t+=2){
    STEP(pB0,pB1,pA0,pA1,t,true,true,true);     WAIT_BAR(2); RESC(); ROT();
    STEP(pA0,pA1,pB0,pB1,t+1,true,true,true);   WAIT_BAR(2); RESC(); ROT();
  }
  #undef CMASK
  #define CMASK(P0,P1,t) do{}while(0)
  #define ENDW(tt) do{ if((tt)+3<NT){WAIT_BAR(2);} else if((tt)+2<NT){WAIT_BAR(1);} else {WAIT_BAR(0);} }while(0)
  for(;t+1<NT;t+=2){
    STEP(pB0,pB1,pA0,pA1,t,(t+3<NT),(t+1<NT),(t+1<NT));       ENDW(t);   RESC(); ROT();
    STEP(pA0,pA1,pB0,pB1,t+1,(t+4<NT),(t+2<NT),(t+2<NT));     ENDW(t+1); RESC(); ROT();
  }
  STEP(pB0,pB1,pA0,pA1,NT-1,false,false,false); RESC();
  { float sacc=pB0[0]+pB0[1]; _Pragma("unroll") for(int r=2;r<16;++r)sacc+=pB0[r]; _Pragma("unroll") for(int r=0;r<16;++r)sacc+=pB1[r]; l_reg+=sacc;
    pw0=(u32x4){PKW(pB0,0),PKW(pB0,2),PKW(pB0,4),PKW(pB0,6)};pw1=(u32x4){PKW(pB0,8),PKW(pB0,10),PKW(pB0,12),PKW(pB0,14)};pw2=(u32x4){PKW(pB1,0),PKW(pB1,2),PKW(pB1,4),PKW(pB1,6)};pw3=(u32x4){PKW(pB1,8),PKW(pB1,10),PKW(pB1,12),PKW(pB1,14)};
    SBAR(); pv(o,vb0+sl_cur,PAF(0),PAF(1),PAF(2),PAF(3)); }
  #undef PKW
  #undef PAF
  #undef VFR
  #undef PIN
  #undef MX3
  #undef GAPA
  #undef GAPB
  #undef EX
  #undef VRD
  #undef KRD
  #undef STEP
  #undef ENDW
  {auto rr=__builtin_amdgcn_permlane32_swap(__float_as_uint(l_reg),__float_as_uint(l_reg),false,false);l_reg=__uint_as_float(rr[0])+__uint_as_float(rr[1]);}
  if(hi==0)wsf[32+r32]=l_reg;asm volatile("s_waitcnt lgkmcnt(0)":::"memory");
  float rli[16];
  #pragma unroll
  for(int r=0;r<16;++r)rli[r]=__builtin_amdgcn_rcpf(wsf[32+crow(r,hi)]);
  bf16*Ow=O+(rowbase+q0+wid*QBLK)*QP+h*D;
  { bf16*stg=(bf16*)(shm+LDS_OST)+wid*2048;
    #pragma unroll
    for(int r=0;r<16;++r){const int orow=crow(r,hi);
      #pragma unroll
      for(int d0=0;d0<2;++d0)stg[orow*64+d0*32+r32]=__float2bfloat16(o[d0][r]*rli[r]);}
    asm volatile("s_waitcnt lgkmcnt(0)":::"memory");
    #pragma unroll
    for(int i=0;i<4;++i){const int row=i*8+(lane>>3),ch=lane&7; const u32x4 v=*(const u32x4*)(stg+row*64+ch*8); ATTN_STORE16(Ow+(long)row*QP+ch*8,v);} }
  asm volatile("s_waitcnt lgkmcnt(0)\n\ts_barrier":::"memory");
  #undef DMA_K
  #undef DMA_V
  #undef CMASK
  #undef START
  #undef RESC
  #undef ROT
}
constexpr int ATTN_LDS_BYTES=LDS_BYTES;
struct AttnTensors { const bf16* Q; const bf16* K; const bf16* V; bf16* O; };
template<int THRL=8> __device__ __forceinline__ void attn_phase(char*lds,const AttnTensors&T,int vcu,int G){
  for(int i=0;;++i){
    int u;
    if(G==256){ if(i>=6)break; u=(i<4)?(4*vcu+i):(1024+2*vcu+(i-4)); }
    else{ u=vcu+i*G; if(u>=1536)break; }
    long rowbase; int h,qb,NT;
    if(u<1024){ const int bh=u>>5; qb=u&31; rowbase=(long)(bh>>3)*8192; h=bh&7; NT=128; }
    else { const int v=u-1024; const int bh=v>>4; qb=v&15; rowbase=32768+(long)(bh>>3)*4096; h=bh&7; NT=64; }
    attn_unit<THRL>(rowbase,h,qb,NT,T.Q,T.K,T.V,T.O,lds);
  }
}
#undef SBAR
#undef WAIT_BAR
}
#ifndef PH_MASK
#define PH_MASK 0x3ff
#endif
#define PH(k) if constexpr ((PH_MASK >> (k)) & 1)
constexpr int NWAVES = 8;
constexpr int RING_BYTES = 131072, LDS_BYTES = 147456;

#define LAS __attribute__((address_space(3)))
typedef unsigned short bf16;
typedef unsigned v4u __attribute__((ext_vector_type(4)));
typedef float f32x4 __attribute__((ext_vector_type(4)));
#define LDS_WAIT() asm volatile("s_waitcnt lgkmcnt(0)" ::: "memory")
__device__ __forceinline__ unsigned f2bf(float f) { unsigned u = __builtin_bit_cast(unsigned, f); return (u + 0x7fffu + ((u >> 16) & 1u)) >> 16; }
__device__ __forceinline__ unsigned pk2(float lo, float hi) { return f2bf(lo) | (f2bf(hi) << 16); }
__device__ __forceinline__ float wave_sum(float v) {
#pragma unroll
    for (int o = 1; o < 64; o <<= 1) v += __shfl_xor(v, o);
    return v;
}
__device__ __forceinline__ void transpose_item(const float* W, int ldw, int src_col0, int k0, bf16* WT, int K, int dst_row0, LAS float* scr, int lane, const float* gk = nullptr) {
    float tv[32];
    const float* wp = W + (size_t)(k0 + (lane >> 5)) * ldw + src_col0 + (lane & 31);
#pragma unroll
    for (int i = 0; i < 32; ++i) tv[i] = wp[(size_t)(2 * i) * ldw];
#pragma unroll
    for (int i = 0; i < 32; ++i) { const int kk = 2 * i + (lane >> 5); scr[kk * 33 + (lane & 31)] = gk ? tv[i] * gk[k0 + kk] : tv[i]; }
    LDS_WAIT(); asm volatile("" ::: "memory");
    const int c = lane & 7;
#pragma unroll
    for (int j = 0; j < 4; ++j) { const int n = (lane >> 3) + 8 * j; const LAS float* s = scr + (8 * c) * 33 + n;
        v4u o; o.x = pk2(s[0 * 33], s[1 * 33]); o.y = pk2(s[2 * 33], s[3 * 33]); o.z = pk2(s[4 * 33], s[5 * 33]); o.w = pk2(s[6 * 33], s[7 * 33]);
        *(v4u*)(WT + (size_t)(dst_row0 + n) * K + k0 + 8 * c) = o; }
    LDS_WAIT(); asm volatile("" ::: "memory");
}

typedef __attribute__((address_space(1))) unsigned gu32;
#define RLX_AGENT __ATOMIC_RELAXED, __HIP_MEMORY_SCOPE_AGENT
#define LDS_WAIT() asm volatile("s_waitcnt lgkmcnt(0)" ::: "memory")
#define VM_WAIT() asm volatile("s_waitcnt vmcnt(0)" ::: "memory")
#define XB_TMO      128
#define XB_XCNT(j)  (256  + 64 * (j))
#define XB_XSUB(j)  (1280 + 64 * (j))
#define XB_XGEN(j)  (2304 + 64 * (j))
#define XB_TOP      3328
#define XB_TOPGEN   3392
#define XCD_BAR_WORDS 3456
#define XB_SPIN_CAP (1u << 18)

__device__ __forceinline__ unsigned xb_ld(unsigned* p)              { return __hip_atomic_load(p, __ATOMIC_RELAXED, __HIP_MEMORY_SCOPE_AGENT); }
__device__ __forceinline__ unsigned xb_add(unsigned* p, unsigned v) { return __hip_atomic_fetch_add(p, v, __ATOMIC_RELAXED, __HIP_MEMORY_SCOPE_AGENT); }
__device__ __forceinline__ unsigned xb_xcc_id() { return (unsigned)__builtin_amdgcn_s_getreg((3 << 11) | 20) & 0xFu; }
#define XB_SPIN(cond, bar) do { unsigned _sp = 0; while (cond) { __builtin_amdgcn_s_sleep(1); \
    if ((++_sp & 255u) == 0u) { if (xb_ld(&(bar)[XB_TMO])) break; if (_sp > XB_SPIN_CAP) { atomicAdd(&(bar)[XB_TMO], 1u); break; } } } } while (0)

struct XcdBarrier {
    unsigned* bar; unsigned x;
    volatile LAS unsigned* st;
};

__device__ __forceinline__ XcdBarrier xcd_barrier_post(unsigned* bar, volatile LAS unsigned* st) {
    XcdBarrier b; b.bar = bar; b.x = xb_xcc_id(); b.st = st;
    if (threadIdx.x == 0) (void)xb_add(&bar[XB_XCNT(b.x)], 1u);
    return b;
}
__device__ __forceinline__ void xcd_barrier_complete(unsigned* bar, unsigned x, unsigned& nloc, unsigned& nx) {
    const unsigned G = gridDim.x * gridDim.y * gridDim.z;
    unsigned sum, cnt, mine, sp = 0u;
    for (;;) {
        sum = 0u; cnt = 0u; mine = 0u;
#pragma unroll
        for (unsigned j = 0; j < 16; ++j) { const unsigned c = xb_ld(&bar[XB_XCNT(j)]); sum += c; cnt += (c > 0u) ? 1u : 0u; mine = (j == x) ? c : mine; }
        if (sum == G) break;
        __builtin_amdgcn_s_sleep(1);
        if ((++sp & 255u) == 0u) { if (xb_ld(&bar[XB_TMO])) break; if (sp > XB_SPIN_CAP) { atomicAdd(&bar[XB_TMO], 1u); break; } }
    }
    nloc = mine > 0u ? mine : 1u; nx = cnt > 0u ? cnt : 1u;
}

__device__ __forceinline__ void xcd_barrier(const XcdBarrier& b) {
    asm volatile("s_waitcnt vmcnt(0)" ::: "memory");
    __syncthreads();
    if (threadIdx.x == 0) {
        unsigned* bar = b.bar;
        __builtin_amdgcn_s_waitcnt(0);
        unsigned nloc = b.st[0], nx = b.st[1];
        if (nloc == 0u) { xcd_barrier_complete(bar, b.x, nloc, nx); b.st[0] = nloc; b.st[1] = nx; }
        const unsigned old = xb_add(&bar[XB_XSUB(b.x)], 1u);
        const unsigned gen = old / nloc;
        if (old + 1u == (gen + 1u) * nloc) {
            __builtin_amdgcn_fence(__ATOMIC_RELEASE, "agent");
            asm volatile("s_waitcnt vmcnt(0)" ::: "memory");
            const unsigned og = xb_add(&bar[XB_TOP], 1u);
            const unsigned tg = og / nx;
            if (og + 1u == (tg + 1u) * nx) xb_add(&bar[XB_TOPGEN], 1u);
            else XB_SPIN(xb_ld(&bar[XB_TOPGEN]) == tg, bar);
            __builtin_amdgcn_fence(__ATOMIC_ACQUIRE, "agent");
            xb_add(&bar[XB_XGEN(b.x)], 1u);
            asm volatile("s_waitcnt vmcnt(0)" ::: "memory");
        } else {
            XB_SPIN(xb_ld(&bar[XB_XGEN(b.x)]) == gen, bar);
            __builtin_amdgcn_fence(__ATOMIC_ACQUIRE, "agent");
            asm volatile("s_waitcnt vmcnt(0)" ::: "memory");
        }
    }
    __syncthreads();
}

template <int W> __device__ __forceinline__ void pool_item(const bf16* Zb, bf16* PL, int row, int ch) {
    constexpr int left = W / 2;
    const int T = row < MP ? 8192 : 4096, t = row < MP ? (row & 8191) : ((row - MP) & 4095);
    const bf16* zp = Zb + (size_t)(row - t) * 512 + ch * 8;
    v4u q[W];
#pragma unroll
    for (int k = 0; k < W; ++k) { int tt = t - left + k; tt = tt < 0 ? 0 : (tt > T - 1 ? T - 1 : tt); q[k] = *(const v4u*)(zp + (size_t)tt * 512); }
    float a[8];
#pragma unroll
    for (int e = 0; e < 8; ++e) a[e] = 0.f;
#pragma unroll
    for (int k = 0; k < W; ++k) { const int tt = t - left + k; const float wv = (tt >= 0 && tt < T) ? 1.f : 0.f;
        a[0] += wv * pg8::bf_lo(q[k].x); a[1] += wv * pg8::bf_hi(q[k].x); a[2] += wv * pg8::bf_lo(q[k].y); a[3] += wv * pg8::bf_hi(q[k].y);
        a[4] += wv * pg8::bf_lo(q[k].z); a[5] += wv * pg8::bf_hi(q[k].z); a[6] += wv * pg8::bf_lo(q[k].w); a[7] += wv * pg8::bf_hi(q[k].w); }
    const int lo = (t - left) > 0 ? (t - left) : 0, hi = (t + W - 1 - left) < (T - 1) ? (t + W - 1 - left) : (T - 1);
    const float ic = 1.0f / (float)(hi - lo + 1); const v4u s = q[left];
    v4u o; o.x = pk2(a[0] * ic - pg8::bf_lo(s.x), a[1] * ic - pg8::bf_hi(s.x)); o.y = pk2(a[2] * ic - pg8::bf_lo(s.y), a[3] * ic - pg8::bf_hi(s.y));
    o.z = pk2(a[4] * ic - pg8::bf_lo(s.z), a[5] * ic - pg8::bf_hi(s.z)); o.w = pk2(a[6] * ic - pg8::bf_lo(s.w), a[7] * ic - pg8::bf_hi(s.w));
    *(v4u*)(PL + (size_t)row * 512 + ch * 8) = o;
}
struct Args { const float* in[25]; float* out; unsigned char* ws; };
static_assert(sizeof(Args) == 27 * 8, "Args has no padding");

__device__ __forceinline__ void gateup_items(int r, const float* Wg, const float* Wu, bf16* WT, LAS float* scr, int lane, const float* gk) {
    const int kb = r / 176, G = r % 176, tile = G >> 3, w = G & 7;
    transpose_item((w < 4) ? Wg : Wu, DFF, tile * 128 + (w & 3) * 32, kb * 64, WT, 1024, G * 32, scr, lane, gk);
}

__global__ void __launch_bounds__(NWAVES * 64, 2) fwd_mega(Args args) {
    extern __shared__ __attribute__((aligned(16))) unsigned char lds[];
    cg::grid_group grid = cg::this_grid();
    const int tid = threadIdx.x, lane = tid & 63, wave = __builtin_amdgcn_readfirstlane(tid >> 6);
    const int G = gridDim.x, bx = blockIdx.x, vcu = (G % 8 == 0) ? (bx % 8) * (G / 8) + bx / 8 : bx;
    unsigned char* ws = args.ws;
    LAS unsigned char* ldsp = (LAS unsigned char*)lds;
    const float* x_p = args.in[0]; const float* x_s = args.in[1]; const float* p_p = args.in[2]; const float* p_s = args.in[3];
    float* out = args.out;
    float* SS = (float*)(ws + WS_SS); float* SSE = (float*)(ws + WS_SSE);
    bf16* W1 = (bf16*)(ws + WS_W1); bf16* WD1 = (bf16*)(ws + WS_WD1); bf16* WIN = (bf16*)(ws + WS_WIN); bf16* WUA = (bf16*)(ws + WS_WUA); bf16* WPC = (bf16*)(ws + WS_WPC);
    bf16* WOUT = (bf16*)(ws + WS_WOUT); bf16* W2 = (bf16*)(ws + WS_W2); bf16* WD2 = (bf16*)(ws + WS_WD2); bf16* WPG = (bf16*)(ws + WS_WPG); bf16* WPP = (bf16*)(ws + WS_WPP);
    bf16* HB = (bf16*)(ws + WS_HB); bf16* ACT = (bf16*)(ws + WS_ACT); bf16* QO = (bf16*)(ws + WS_QO); bf16* Zb = (bf16*)(ws + WS_Z); bf16* PL = (bf16*)(ws + WS_PL);
    bf16* MX = (bf16*)(ws + WS_MX); bf16* KB = (bf16*)(ws + WS_K); bf16* VB = (bf16*)(ws + WS_V); bf16* PB = (bf16*)(ws + WS_PB); bf16* SGB = (bf16*)(ws + WS_SGB); bf16* EB = (bf16*)(ws + WS_E);
    volatile LAS unsigned* bst = (volatile LAS unsigned*)(ldsp + 139264);
    if (tid < 2) bst[tid] = 0u;
    __syncthreads();
    const XcdBarrier xbar = xcd_barrier_post((unsigned*)ws, bst);
    const int gw = vcu * NWAVES + wave, NGW = G * NWAVES;
    const int gt = bx * (NWAVES * 64) + tid, NGT = G * NWAVES * 64;

    PH(0) {
        LAS float* scr = (LAS float*)(ldsp + wave * 16384);
        constexpr int I1 = 16 * 176, I2 = 44 * 32, I3 = 16 * 104, I4 = 8 * 32, I6 = 16 * 32, I10 = 4 * 32;
        constexpr int NITEMS = 2 * I1 + 2 * I2 + I3 + I4 + 2 * I6 + I10;
        for (int it = gw; it < NITEMS; it += NGW) {
            int r = it;
            if (r < I1) { gateup_items(r, args.in[5], args.in[6], W1, scr, lane, nullptr); continue; } r -= I1;
            if (r < I1) { gateup_items(r, args.in[18], args.in[19], W2, scr, lane, args.in[17]); continue; } r -= I1;
            if (r < I2) { transpose_item(args.in[7], 1024, (r % 32) * 32, (r / 32) * 64, WD1, DFF, (r % 32) * 32, scr, lane); continue; } r -= I2;
            if (r < I2) { transpose_item(args.in[20], 1024, (r % 32) * 32, (r / 32) * 64, WD2, DFF, (r % 32) * 32, scr, lane); continue; } r -= I2;
            if (r < I3) { const int kb = r / 104, Gp = r % 104; const int c0 = Gp < 24 ? ((Gp >> 3) * 256 + (Gp & 3) * 64 + ((Gp >> 2) & 1) * 32) : Gp * 32;
                transpose_item(args.in[9], INW, c0, kb * 64, WIN, 1024, Gp * 32, scr, lane, args.in[8]); continue; } r -= I3;
            if (r < I4) { transpose_item(args.in[12], 1024, (r % 32) * 32, (r / 32) * 64, WUA, 512, (r % 32) * 32, scr, lane); continue; } r -= I4;
            if (r < I6) { transpose_item(args.in[16], 1024, (r % 32) * 32, (r / 32) * 64, WOUT, 1024, (r % 32) * 32, scr, lane); continue; } r -= I6;
            if (r < I6) { transpose_item(args.in[22], 1024, (r % 32) * 32, (r / 32) * 64, WPG, 1024, (r % 32) * 32, scr, lane, args.in[21]); continue; } r -= I6;
            transpose_item(args.in[23], 1024, (r % 32) * 32, (r / 32) * 64, WPP, PLE, (r % 32) * 32, scr, lane);
        }
        if (gt < 128) ((float*)(ws + WS_GQK))[gt] = gt < 64 ? args.in[10][gt] : args.in[11][gt - 64];
        { const float* pw = args.in[13]; const float* psc = args.in[14]; const float* wup = args.in[15];
          for (int idx = gt; idx < 128 * 1024; idx += NGT) { const int d = idx & 1023, c0 = (idx >> 10) * 4, g0 = c0 & ~127; float a0 = 0.f, a1 = 0.f, a2 = 0.f, a3 = 0.f;
              const float* pr = pw + (size_t)c0 * 128; const float* bp = wup + (size_t)g0 * 1024 + d;
#pragma unroll 16
              for (int j = 0; j < 128; ++j) { const float b = bp[(size_t)j * 1024] * psc[g0 + j]; a0 += pr[j] * b; a1 += pr[128 + j] * b; a2 += pr[256 + j] * b; a3 += pr[384 + j] * b; }
              *(unsigned long long*)(WPC + (size_t)d * 512 + c0) = (unsigned long long)pk2(a0, a1) | ((unsigned long long)pk2(a2, a3) << 32); } }
        { const float* g1 = args.in[4]; f32x4 gv[4];
#pragma unroll
          for (int j = 0; j < 4; ++j) gv[j] = ((const f32x4*)g1)[lane + 64 * j];
          for (int m0 = gw * 4; m0 < MTOT; m0 += NGW * 4) { const float* xr = m0 < MP ? x_p + (size_t)m0 * 1024 : x_s + (size_t)(m0 - MP) * 1024;
              f32x4 v[4][4]; float s[4];
#pragma unroll
              for (int r = 0; r < 4; ++r)
#pragma unroll
                  for (int j = 0; j < 4; ++j) v[r][j] = ((const f32x4*)(xr + r * 1024))[lane + 64 * j];
#pragma unroll
              for (int r = 0; r < 4; ++r) { s[r] = 0.f;
#pragma unroll
                  for (int j = 0; j < 4; ++j) s[r] += (v[r][j].x * v[r][j].x + v[r][j].y * v[r][j].y) + (v[r][j].z * v[r][j].z + v[r][j].w * v[r][j].w); }
#pragma unroll
              for (int r = 0; r < 4; ++r) { const float rstd = rsqrtf(wave_sum(s[r]) * (1.f / 1024.f) + EPSN);
                  unsigned long long* o8 = (unsigned long long*)(HB + (size_t)(m0 + r) * 1024) + lane;
#pragma unroll
                  for (int j = 0; j < 4; ++j) { const f32x4 y = v[r][j] * rstd * gv[j]; o8[64 * j] = (unsigned long long)pk2(y.x, y.y) | ((unsigned long long)pk2(y.z, y.w) << 32); } } } }
    }
    grid.sync();

    PH(1) { pg8::Gemm g{HB, W1, MTOT, 2 * DFF, 1024, 0, 0}; pg8::StaticOrder S; S.init(MTOT, 2 * DFF, G, bx);
      pg8::EpiGateUp<false> E{ACT, DFF, nullptr};
      pg8::gemm_phase<pg8::EpiGateUp<false>, pg8::StaticOrder, true, true>(ldsp, g, S, E); }
    xcd_barrier(xbar);
    PH(2) { pg8::Gemm g{ACT, WD1, MTOT, 1024, DFF, 0, 0}; pg8::StaticOrder S; S.init(MTOT, 1024, G, bx);
      pg8::EpiResid<true> E{x_p, x_s, HB, SS, 0.5f};
      pg8::gemm_phase<pg8::EpiResid<true>, pg8::StaticOrder, true, true>(ldsp, g, S, E); }
    xcd_barrier(xbar);
    PH(3) { pg8::Gemm g{HB, WIN, MTOT, INW, 1024, 0, 0}; pg8::StaticOrder S; S.init(MTOT, INW, G, bx);
      pg8::EpiWin E{SS, (const float*)(ws + WS_GQK), ws, attn_body::C2};
      pg8::gemm_phase<pg8::EpiWin, pg8::StaticOrder, true, true>(ldsp, g, S, E); }
    xcd_barrier(xbar);
    PH(4) {
      for (int wi = gw; wi < MTOT; wi += NGW) { const int grp = wi & 3, row = (wi >> 2) * 4 + (lane >> 4), ch = grp * 16 + (lane & 15);
          if (grp == 0) pool_item<2>(Zb, PL, row, ch); else if (grp == 1) pool_item<4>(Zb, PL, row, ch); else if (grp == 2) pool_item<8>(Zb, PL, row, ch); else pool_item<16>(Zb, PL, row, ch); }
      asm volatile("s_waitcnt vmcnt(0)" ::: "memory"); __syncthreads();
      const attn_body::AttnTensors AT{(const attn_body::bf16*)QO, (const attn_body::bf16*)KB, (const attn_body::bf16*)VB, (attn_body::bf16*)QO};
      attn_body::attn_phase<8>((char*)lds, AT, vcu, G); }
    xcd_barrier(xbar);
    PH(5) { for (int idx = gt; idx < MTOT * 32; idx += NGT) { const int row = idx >> 5, ch = idx & 31; const float* pr = (row < MP ? p_p + (size_t)row * PLE : p_s + (size_t)(row - MP) * PLE) + ch * 8;
          const f32x4 a = *(const f32x4*)pr, b = *(const f32x4*)(pr + 4); v4u o; o.x = pk2(a.x, a.y); o.y = pk2(a.z, a.w); o.z = pk2(b.x, b.y); o.w = pk2(b.z, b.w);
          *(v4u*)(PB + (size_t)row * PLE + ch * 8) = o; }
      asm volatile("s_waitcnt vmcnt(0)" ::: "memory"); __syncthreads();
      pg8::SegOrder S; S.init(MTOT, 1024, G, bx);
      { pg8::Gemm g{QO, WUA, MTOT, 1024, 512, (long)((const char*)PL - (const char*)QO), (long)((const char*)WPC - (const char*)WUA)}; pg8::EpiGateMix E{MX, SGB}; pg8::gemm_phase<pg8::EpiGateMix, pg8::SegOrder, true, true>(ldsp, g, S, E); } }
    xcd_barrier(xbar);
    PH(6) { pg8::StaticOrder S; S.init(MTOT, 1024, G, bx);
      { pg8::Gemm g{MX, WOUT, MTOT, 1024, 1024, 0, 0}; pg8::EpiResid<false> E{nullptr, nullptr, HB, SS, 1.0f}; pg8::gemm_phase<pg8::EpiResid<false>, pg8::StaticOrder, true, true>(ldsp, g, S, E); }
 }
    asm volatile("s_waitcnt vmcnt(0)" ::: "memory"); __syncthreads();
    PH(6) { pg8::Gemm g{PB, WPP, MTOT, 1024, PLE, 0, 0}; pg8::StaticOrder S; S.init(MTOT, 1024, G, bx); pg8::EpiE E{EB, SSE};
      pg8::gemm_phase<pg8::EpiE, pg8::StaticOrder, true, true>(ldsp, g, S, E); }
    xcd_barrier(xbar);
    PH(7) { pg8::Gemm g{HB, W2, MTOT, 2 * DFF, 1024, 0, 0}; pg8::StaticOrder S; S.init(MTOT, 2 * DFF, G, bx);
      pg8::EpiGateUp<true> E{ACT, DFF, SS};
      pg8::gemm_phase<pg8::EpiGateUp<true>, pg8::StaticOrder, true, true>(ldsp, g, S, E); }
    xcd_barrier(xbar);
    PH(8) { pg8::Gemm g{ACT, WD2, MTOT, 1024, DFF, 0, 0}; pg8::StaticOrder S; S.init(MTOT, 1024, G, bx);
      pg8::EpiResid<false> E{nullptr, nullptr, HB, SS, 0.5f};
      pg8::gemm_phase<pg8::EpiResid<false>, pg8::StaticOrder, true, true>(ldsp, g, S, E); }
    xcd_barrier(xbar);
    PH(9) { pg8::Gemm g{HB, WPG, MTOT, 1024, 1024, 0, 0}; pg8::StaticOrder S; S.init(MTOT, 1024, G, bx);
      pg8::EpiFinal E{out, HB, EB, SS, SSE, args.in[24]};
      pg8::gemm_phase<pg8::EpiFinal, pg8::StaticOrder, true, true>(ldsp, g, S, E); }
}

extern "C" void kernel_launch(void* const* d_in, const int* in_sizes, int n_in, void* d_out, int out_size, void* d_ws, size_t ws_size, hipStream_t stream) {
    static int grid = 0;
    if (grid == 0) {
        if (n_in != 25 || out_size != MTOT * 1024 || ws_size < WS_END) { fprintf(stderr, "kernel_launch: unexpected problem (n_in %d, out %d, ws %zu); nothing launched\n", n_in, out_size, ws_size); grid = -1; return; }
        int dev = 0, cus = 0, per_cu = 0;
        if (hipGetDevice(&dev) != hipSuccess || hipDeviceGetAttribute(&cus, hipDeviceAttributeMultiprocessorCount, dev) != hipSuccess) { grid = -1; return; }
        if (hipFuncSetAttribute((const void*)fwd_mega, hipFuncAttributeMaxDynamicSharedMemorySize, LDS_BYTES) != hipSuccess) { fprintf(stderr, "kernel_launch: hipFuncSetAttribute failed\n"); grid = -1; return; }
        if (hipOccupancyMaxActiveBlocksPerMultiprocessor(&per_cu, (const void*)fwd_mega, NWAVES * 64, LDS_BYTES) != hipSuccess || per_cu < 1) { fprintf(stderr, "kernel_launch: occupancy query says %d blocks per CU\n", per_cu); (void)hipGetLastError(); }
        grid = cus;
    }
    if (grid < 0) return;
    if (hipMemsetAsync(d_ws, 0, 16384, stream) != hipSuccess) { fprintf(stderr, "kernel_launch: memset failed\n"); return; }
    Args a{};
    for (int i = 0; i < 25; ++i) a.in[i] = (const float*)d_in[i];
    a.out = (float*)d_out; a.ws = (unsigned char*)d_ws;
    void* kargs[] = {&a};
    const hipError_t e = hipLaunchCooperativeKernel((const void*)fwd_mega, dim3(grid), dim3(NWAVES * 64), kargs, LDS_BYTES, stream);
    if (e != hipSuccess) fprintf(stderr, "kernel_launch: cooperative launch failed: %s (grid %d)\n", hipGetErrorString(e), grid);
}
```

```cpp
#include <hip/hip_runtime.h>
#include <hip/hip_cooperative_groups.h>
#include <hip/hip_bf16.h>
#include <cstdio>
#include <cstdint>
#include <cmath>
namespace cg = cooperative_groups;

constexpr int DMODEL = 1024, MP = 4 * 8192, MS = 4 * 4096, MTOT = MP + MS;
constexpr int DFF = 2816, INW = 3328, PLE = 256;
constexpr float EPSN = 1e-6f;
constexpr size_t HK = 512u * 1024u;
constexpr size_t WS_GQK = 1 * HK;
constexpr size_t WS_SS = 2 * HK, WS_SSE = 8 * HK;
constexpr size_t WS_W1 = 16 * HK, WS_WD1 = 38 * HK, WS_WIN = 49 * HK, WS_WUA = 62 * HK, WS_WPC = 64 * HK, WS_WOUT = 66 * HK, WS_W2 = 70 * HK, WS_WD2 = 92 * HK, WS_WPG = 103 * HK, WS_WPP = 107 * HK;
constexpr size_t WS_HB = 112 * HK;
constexpr size_t WS_ACT = 304 * HK;
constexpr size_t WS_QO = WS_ACT, WS_Z = WS_ACT + 96 * HK, WS_PL = WS_ACT + 192 * HK, WS_MX = WS_ACT + 288 * HK, WS_K = WS_ACT + 480 * HK, WS_V = WS_ACT + 504 * HK, WS_PB = WS_K;
constexpr size_t WS_SGB = 832 * HK, WS_E = WS_SGB, WS_END = 1024 * HK;
static_assert(WS_WPP + 1024 * 256 * 2 <= WS_HB && WS_HB + (size_t)MTOT * 1024 * 2 <= WS_ACT && WS_ACT + (size_t)MTOT * DFF * 2 <= WS_SGB && WS_V + (size_t)MTOT * 128 * 2 <= WS_SGB && WS_SGB + (size_t)MTOT * 1024 * 2 <= WS_END, "d_ws map");
static_assert(WS_W1 + 5632 * 1024 * 2 <= WS_WD1 && WS_WD1 + 1024 * 2816 * 2 <= WS_WIN && WS_WIN + 3328 * 1024 * 2 <= WS_WUA && WS_W2 + 5632 * 1024 * 2 <= WS_WD2 && WS_WD2 + 1024 * 2816 * 2 <= WS_WPG && WS_WPG + 1024 * 1024 * 2 <= WS_WPP, "weights map");


namespace pg8 {
#define PG8_LAS __attribute__((address_space(3)))
typedef unsigned short bf16_t;
typedef short bf16x8 __attribute__((ext_vector_type(8)));
typedef float f32x4 __attribute__((ext_vector_type(4)));
typedef unsigned u32x4 __attribute__((ext_vector_type(4)));
#ifndef PG8_PFD
#define PG8_PFD 3
#endif
constexpr int PFD = PG8_PFD;
constexpr int BM = 256, BK = 64, HALF = 128, HTB = HALF * BK * 2  , STAGE_BYTES = 8 * HTB, NXCD = 8, WGM = 8;

__host__ __device__ __forceinline__ int lds_byte(int r, int c) { const int st = (r >> 4) * 2 + (c >> 5), rr = r & 15, cc = c & 31, ob = rr * 64 + cc * 2; return st * 1024 + (ob ^ (((ob >> 9) & 1) << 5)); }
__host__ __device__ __forceinline__ void stage_rc(int b, int& R, int& C) { const int st = b / 1024, sb = b % 1024, swz = sb ^ (((sb >> 9) & 1) << 5); R = (st >> 1) * 16 + swz / 64; C = (st & 1) * 32 + (swz % 64) / 2; }
__host__ __device__ __forceinline__ int perm32(int rho) { const int n = rho >> 4, i = rho & 15; return 8 * (i >> 2) + 4 * n + (i & 3); }

struct Unit { int pm, pn, seg; };
struct Gemm { const bf16_t* A; const bf16_t* Bt; int M, N, K; long dA, dB; };

struct StaticOrder {
    int nM, nN, nwg, G, c;
    __host__ __device__ void init(int M, int N, int G_, int c_) { nM = M / BM; nN = N / BM; nwg = nM * nN; G = G_; c = c_; }
    __host__ __device__ bool next(int i, Unit& u) const {
        const long L = (long)i * G + c; if (L >= nwg) return false;
        int wgid = (int)L; { const int q = nwg / NXCD, r = nwg % NXCD, xcd = wgid % NXCD, off = wgid / NXCD; wgid = (xcd < r ? xcd * (q + 1) : r * (q + 1) + (xcd - r) * q) + off; }
        const int nig = WGM * nN, gid = wgid / nig, fm = gid * WGM, gsz = (nM - fm) < WGM ? (nM - fm) : WGM;
        u.pm = fm + ((wgid % nig) % gsz); u.pn = (wgid % nig) / gsz; u.seg = 0; return true;
    }
    __device__ __forceinline__ void a_ready(const Unit&) const {}
    __device__ __forceinline__ void done(const Unit&) const {}
};
struct SegOrder : StaticOrder {
    __host__ __device__ bool next(int i, Unit& u) const { const bool ok = StaticOrder::next(i >> 1, u); u.seg = i & 1; return ok; }
};
__device__ __forceinline__ unsigned cvt_pk_bf16(float lo, float hi) { unsigned r; asm volatile("v_cvt_pk_bf16_f32 %0, %1, %2" : "=v"(r) : "v"(lo), "v"(hi)); return r; }
typedef unsigned u32x2 __attribute__((ext_vector_type(2)));
__device__ __forceinline__ float bf_lo(unsigned w) { return __uint_as_float(w << 16); }
__device__ __forceinline__ float bf_hi(unsigned w) { return __uint_as_float(w & 0xffff0000u); }
__device__ __forceinline__ float sigm(float x) { return __builtin_amdgcn_rcpf(1.0f + __builtin_amdgcn_exp2f(-1.4426950408889634f * x)); }
__device__ __forceinline__ float row_rstd(const float* ss, int row) {
    const f32x4* p = (const f32x4*)(ss + (size_t)row * 16);
    const f32x4 a = p[0], b = p[1], c = p[2], d = p[3];
    const float s = (((a.x + a.y) + (a.z + a.w)) + ((b.x + b.y) + (b.z + b.w))) + (((c.x + c.y) + (c.z + c.w)) + ((d.x + d.y) + (d.z + d.w)));
    return rsqrtf(s * (1.0f / 1024.0f) + EPSN);
}

__device__ __forceinline__ void load_rstd8(const float* ss, int row0, int fq, float (&rs)[2][4]) {
    f32x4 pv[2][4];
#pragma unroll
    for (int ai = 0; ai < 2; ++ai)
#pragma unroll
        for (int m = 0; m < 4; ++m) pv[ai][m] = *(const f32x4*)(ss + (size_t)(row0 + ai * HALF + m * 16) * 16 + 4 * fq);
#pragma unroll
    for (int ai = 0; ai < 2; ++ai)
#pragma unroll
        for (int m = 0; m < 4; ++m) { float s = (pv[ai][m].x + pv[ai][m].y) + (pv[ai][m].z + pv[ai][m].w); s += __shfl_xor(s, 16); s += __shfl_xor(s, 32); rs[ai][m] = rsqrtf(s * (1.0f / 1024.0f) + EPSN); }
}

template <bool ROWSCALE> struct EpiGateUp {
    static constexpr bool PERM = true, AFTER_DRAIN = false, SEG = false; static constexpr int NST = ROWSCALE ? 12 : 6;
    bf16_t* O; int ldc; const float* ss;
    __device__ __forceinline__ void operator()(const f32x4 (&acc)[2][2][4][2], const Unit& u, int wr, int wc, int fr, int fq) const {
        const int row0 = u.pm * BM + wr * 64 + fr, col0 = u.pn * HALF + wc * 32 + 8 * fq;
        float rs[2][4];
        if (ROWSCALE) load_rstd8(ss, row0, fq, rs);
#pragma unroll
        for (int ai = 0; ai < 2; ++ai)
#pragma unroll
            for (int m = 0; m < 4; ++m) { const int row = row0 + ai * HALF + m * 16; const float r = ROWSCALE ? rs[ai][m] : 1.0f;
                float o[8];
#pragma unroll
                for (int n = 0; n < 2; ++n)
#pragma unroll
                    for (int e = 0; e < 4; ++e) { const float g = acc[ai][0][m][n][e] * r, up = acc[ai][1][m][n][e] * r; o[n * 4 + e] = g * sigm(g) * up; }
                u32x4 w; w.x = cvt_pk_bf16(o[0], o[1]); w.y = cvt_pk_bf16(o[2], o[3]); w.z = cvt_pk_bf16(o[4], o[5]); w.w = cvt_pk_bf16(o[6], o[7]);
                *(u32x4*)(O + (size_t)row * ldc + col0) = w; }
    }
};

template <bool F32BASE> struct EpiResid {
    static constexpr bool PERM = true, AFTER_DRAIN = false, SEG = false; static constexpr int NST = F32BASE ? 40 : 30;
    const float* base0; const float* base1; bf16_t* hb; float* ss; float alpha;
    __device__ __forceinline__ void operator()(const f32x4 (&acc)[2][2][4][2], const Unit& u, int wr, int wc, int fr, int fq) const {
        const int row0 = u.pm * BM + wr * 64 + fr, col0 = u.pn * BM + wc * 32 + 8 * fq;
#pragma unroll
        for (int ai = 0; ai < 2; ++ai) {
            f32x4 b[4][2][2];
#pragma unroll
            for (int m = 0; m < 4; ++m) { const int row = row0 + ai * HALF + m * 16;
#pragma unroll
                for (int bj = 0; bj < 2; ++bj) {
                    if (F32BASE) { const float* bp = (row < MP ? base0 + (size_t)row * DMODEL : base1 + (size_t)(row - MP) * DMODEL) + col0 + bj * HALF; b[m][bj][0] = *(const f32x4*)bp; b[m][bj][1] = *(const f32x4*)(bp + 4); }
                    else { const u32x4 w = *(const u32x4*)(hb + (size_t)row * DMODEL + col0 + bj * HALF); b[m][bj][0] = __builtin_bit_cast(f32x4, w); } } }
            asm volatile("" ::: "memory");
#pragma unroll
            for (int m = 0; m < 4; ++m) { const int row = row0 + ai * HALF + m * 16; const size_t off = (size_t)row * DMODEL + col0; float s = 0.f;
#pragma unroll
                for (int bj = 0; bj < 2; ++bj) { const f32x4 c0 = acc[ai][bj][m][0], c1 = acc[ai][bj][m][1]; f32x4 b0, b1;
                    if (F32BASE) { b0 = b[m][bj][0]; b1 = b[m][bj][1]; }
                    else { const u32x4 w = __builtin_bit_cast(u32x4, b[m][bj][0]); b0 = (f32x4){bf_lo(w.x), bf_hi(w.x), bf_lo(w.y), bf_hi(w.y)}; b1 = (f32x4){bf_lo(w.z), bf_hi(w.z), bf_lo(w.w), bf_hi(w.w)}; }
                    const f32x4 v0 = b0 + c0 * alpha, v1 = b1 + c1 * alpha;
                    s += ((v0.x * v0.x + v0.y * v0.y) + (v0.z * v0.z + v0.w * v0.w)) + ((v1.x * v1.x + v1.y * v1.y) + (v1.z * v1.z + v1.w * v1.w));
                    u32x4 o; o.x = cvt_pk_bf16(v0.x, v0.y); o.y = cvt_pk_bf16(v0.z, v0.w); o.z = cvt_pk_bf16(v1.x, v1.y); o.w = cvt_pk_bf16(v1.z, v1.w);
                    *(u32x4*)(hb + off + bj * HALF) = o; }
                s += __shfl_xor(s, 16); s += __shfl_xor(s, 32);
                if (fq == 0) ss[(size_t)row * 16 + u.pn * 4 + wc] = s; }
            asm volatile("" ::: "memory"); }
    }
};

struct EpiWin {
    static constexpr bool PERM = false, AFTER_DRAIN = false, SEG = false; static constexpr int NST = 30;
    const float* ss; const float* gqk; unsigned char* ws; float qscale;
    __device__ __forceinline__ void operator()(const f32x4 (&acc)[2][2][4][2], const Unit& u, int wr, int wc, int fr, int fq) const {
        const int row0 = u.pm * BM + wr * 64 + fr;
        const int pn = u.pn;
        const bool is_rope = (pn < 2) || (pn == 2 && wc < 2);
        float rs[2][4];
        load_rstd8(ss, row0, fq, rs);
        if (is_rope) {
            const float* g = gqk + ((pn < 2) ? 0 : 64); const float osc = (pn < 2) ? qscale : 1.0f;
            bf16_t* dst = (bf16_t*)(ws + ((pn < 2) ? (WS_QO + (size_t)(pn * 4 + wc) * 128) : (WS_K + (size_t)wc * 128))); const int ld = (pn < 2) ? 512 : 128;
            f32x4 gv[2][2]; float inv[4];
#pragma unroll
            for (int bj = 0; bj < 2; ++bj)
#pragma unroll
                for (int n = 0; n < 2; ++n) gv[bj][n] = *(const f32x4*)(g + bj * 32 + n * 16 + 4 * fq);
#pragma unroll
            for (int e = 0; e < 4; ++e) inv[e] = __builtin_amdgcn_exp2f(-(float)(4 * fq + e) * 0.8304820237218406f);
#pragma unroll
            for (int m = 0; m < 4; ++m)
#pragma unroll
                for (int ai = 0; ai < 2; ++ai) { const int row = row0 + ai * HALF + m * 16;
                    int t = row < MP ? (row & 8191) : ((row - MP) & 4095); asm volatile("" : "+v"(t));
                    float s = 0.f;
#pragma unroll
                    for (int bj = 0; bj < 2; ++bj)
#pragma unroll
                        for (int n = 0; n < 2; ++n) { const f32x4 a = acc[ai][bj][m][n]; s += (a.x * a.x + a.y * a.y) + (a.z * a.z + a.w * a.w); }
                    s += __shfl_xor(s, 16); s += __shfl_xor(s, 32);
                    const float rr = rs[ai][m];
                    s *= rr * rr;
                    const float r = rsqrtf(s * (1.0f / 64.0f) + EPSN) * rr * osc;
#pragma unroll
                    for (int bj = 0; bj < 2; ++bj) { const float pos = (float)(bj == 0 ? (t >> 6) : (t & 63));
                        const f32x4 x1 = acc[ai][bj][m][0] * r * gv[bj][0], x2 = acc[ai][bj][m][1] * r * gv[bj][1]; f32x4 o1, o2;
#pragma unroll
                        for (int e = 0; e < 4; ++e) { const float ang = pos * inv[e]; const float c = __cosf(ang), sn = __sinf(ang); o1[e] = x1[e] * c - x2[e] * sn; o2[e] = x2[e] * c + x1[e] * sn; }
                        u32x2 w1, w2; w1.x = cvt_pk_bf16(o1.x, o1.y); w1.y = cvt_pk_bf16(o1.z, o1.w); w2.x = cvt_pk_bf16(o2.x, o2.y); w2.y = cvt_pk_bf16(o2.z, o2.w);
                        bf16_t* p = dst + (size_t)row * ld + bj * 32 + 4 * fq; *(u32x2*)p = w1; *(u32x2*)(p + 16) = w2; }
                    __builtin_amdgcn_sched_barrier(0); }
        } else if (pn == 2) {
            bf16_t* dst = (bf16_t*)(ws + WS_V) + (wc - 2) * 64 + 4 * fq;
#pragma unroll
            for (int ai = 0; ai < 2; ++ai)
#pragma unroll
                for (int m = 0; m < 4; ++m) { const int row = row0 + ai * HALF + m * 16; const float r = rs[ai][m];
#pragma unroll
                    for (int bj = 0; bj < 2; ++bj)
#pragma unroll
                        for (int n = 0; n < 2; ++n) { const f32x4 v = acc[ai][bj][m][n] * r; u32x2 w; w.x = cvt_pk_bf16(v.x, v.y); w.y = cvt_pk_bf16(v.z, v.w); *(u32x2*)(dst + (size_t)row * 128 + bj * 32 + n * 16) = w; } }
        } else {
            const bool sg = pn >= 5; const int ld = sg ? 1024 : 512; const int ct = pn < 5 ? pn - 3 : (pn < 9 ? pn - 5 : pn - 9);
            bf16_t* dst = (bf16_t*)(ws + (pn < 5 ? WS_Z : (pn < 9 ? WS_MX : WS_SGB))) + ct * 256 + wc * 32 + 4 * fq;
#pragma unroll
            for (int ai = 0; ai < 2; ++ai)
#pragma unroll
                for (int m = 0; m < 4; ++m) { const int row = row0 + ai * HALF + m * 16; const float r = rs[ai][m];
#pragma unroll
                    for (int bj = 0; bj < 2; ++bj)
#pragma unroll
                        for (int n = 0; n < 2; ++n) { f32x4 v = acc[ai][bj][m][n] * r; if (sg) { v.x = sigm(v.x); v.y = sigm(v.y); v.z = sigm(v.z); v.w = sigm(v.w); }
                            u32x2 w; w.x = cvt_pk_bf16(v.x, v.y); w.y = cvt_pk_bf16(v.z, v.w); *(u32x2*)(dst + (size_t)row * ld + bj * HALF + n * 16) = w; } }
        }
    }
};

struct EpiGateMix {
    static constexpr bool PERM = true, AFTER_DRAIN = false, SEG = true; static constexpr int NST = 24;
    bf16_t* Mx; const bf16_t* SGB;
    __device__ __forceinline__ void operator()(f32x4 (&acc)[2][2][4][2], const Unit& u, int wr, int wc, int fr, int fq) const {
        const int row0 = u.pm * BM + wr * 64 + fr, col0 = u.pn * BM + wc * 32 + 8 * fq;
#pragma unroll
        for (int ai = 0; ai < 2; ++ai) {
            u32x4 gw[4][2], aw[4][2];
#pragma unroll
            for (int m = 0; m < 4; ++m)
#pragma unroll
                for (int bj = 0; bj < 2; ++bj) { const size_t off = (size_t)(row0 + ai * HALF + m * 16) * DMODEL + col0 + bj * HALF; gw[m][bj] = *(const u32x4*)(SGB + off); if (u.seg == 0) aw[m][bj] = *(const u32x4*)(Mx + off); }
            asm volatile("" ::: "memory");
#pragma unroll
            for (int m = 0; m < 4; ++m)
#pragma unroll
                for (int bj = 0; bj < 2; ++bj) { const size_t off = (size_t)(row0 + ai * HALF + m * 16) * DMODEL + col0 + bj * HALF; const u32x4 g = gw[m][bj];
                    const f32x4 g0 = (f32x4){bf_lo(g.x), bf_hi(g.x), bf_lo(g.y), bf_hi(g.y)}, g1 = (f32x4){bf_lo(g.z), bf_hi(g.z), bf_lo(g.w), bf_hi(g.w)};
                    if (u.seg == 0) { const u32x4 a = aw[m][bj];
                        const f32x4 a0 = (f32x4){bf_lo(a.x), bf_hi(a.x), bf_lo(a.y), bf_hi(a.y)}, a1 = (f32x4){bf_lo(a.z), bf_hi(a.z), bf_lo(a.w), bf_hi(a.w)};
#pragma unroll
                        for (int e = 0; e < 4; ++e) { acc[ai][bj][m][0][e] *= a0[e] * __builtin_amdgcn_rcpf(g0[e]); acc[ai][bj][m][1][e] *= a1[e] * __builtin_amdgcn_rcpf(g1[e]); } }
                    else { const f32x4 v0 = acc[ai][bj][m][0] * g0, v1 = acc[ai][bj][m][1] * g1;
                        u32x4 w; w.x = cvt_pk_bf16(v0.x, v0.y); w.y = cvt_pk_bf16(v0.z, v0.w); w.z = cvt_pk_bf16(v1.x, v1.y); w.w = cvt_pk_bf16(v1.z, v1.w);
                        *(u32x4*)(Mx + off) = w; } }
            asm volatile("" ::: "memory"); }
    }
};

struct EpiE {
    static constexpr bool PERM = true, AFTER_DRAIN = false, SEG = false; static constexpr int NST = 16;
    bf16_t* E; float* ss;
    __device__ __forceinline__ void operator()(const f32x4 (&acc)[2][2][4][2], const Unit& u, int wr, int wc, int fr, int fq) const {
        const int row0 = u.pm * BM + wr * 64 + fr, col0 = u.pn * BM + wc * 32 + 8 * fq;
#pragma unroll
        for (int ai = 0; ai < 2; ++ai)
#pragma unroll
            for (int m = 0; m < 4; ++m) { const int row = row0 + ai * HALF + m * 16; float s = 0.f;
#pragma unroll
                for (int bj = 0; bj < 2; ++bj) { const f32x4 c0 = acc[ai][bj][m][0], c1 = acc[ai][bj][m][1];
                    s += ((c0.x * c0.x + c0.y * c0.y) + (c0.z * c0.z + c0.w * c0.w)) + ((c1.x * c1.x + c1.y * c1.y) + (c1.z * c1.z + c1.w * c1.w));
                    u32x4 w; w.x = cvt_pk_bf16(c0.x, c0.y); w.y = cvt_pk_bf16(c0.z, c0.w); w.z = cvt_pk_bf16(c1.x, c1.y); w.w = cvt_pk_bf16(c1.z, c1.w);
                    *(u32x4*)(E + (size_t)row * DMODEL + col0 + bj * HALF) = w; }
                s += __shfl_xor(s, 16); s += __shfl_xor(s, 32);
                if (fq == 0) ss[(size_t)row * 16 + u.pn * 4 + wc] = s; }
    }
};

struct EpiFinal {
    static constexpr bool PERM = true, AFTER_DRAIN = false, SEG = false; static constexpr int NST = 40;
    float* out; const bf16_t* hb; const bf16_t* E; const float* ss; const float* sse; const float* gpost;
    __device__ __forceinline__ void operator()(const f32x4 (&acc)[2][2][4][2], const Unit& u, int wr, int wc, int fr, int fq) const {
        const int row0 = u.pm * BM + wr * 64 + fr, col0 = u.pn * BM + wc * 32 + 8 * fq;
        f32x4 gv[2][2]; float rs[2][4], re[2][4];
#pragma unroll
        for (int bj = 0; bj < 2; ++bj)
#pragma unroll
            for (int n = 0; n < 2; ++n) gv[bj][n] = *(const f32x4*)(gpost + col0 + bj * HALF + n * 4);
        load_rstd8(ss, row0, fq, rs); load_rstd8(sse, row0, fq, re);
#pragma unroll
        for (int ai = 0; ai < 2; ++ai)
#pragma unroll
        for (int mp = 0; mp < 2; ++mp) {
            u32x4 hw[2][2], ew[2][2];
#pragma unroll
            for (int mm = 0; mm < 2; ++mm)
#pragma unroll
                for (int bj = 0; bj < 2; ++bj) { const size_t off = (size_t)(row0 + ai * HALF + (2 * mp + mm) * 16) * DMODEL + col0 + bj * HALF; hw[mm][bj] = *(const u32x4*)(hb + off); ew[mm][bj] = *(const u32x4*)(E + off); }
            asm volatile("" ::: "memory");
#pragma unroll
            for (int mm = 0; mm < 2; ++mm) { const int m = 2 * mp + mm; const float r = rs[ai][m], q = re[ai][m];
#pragma unroll
                for (int bj = 0; bj < 2; ++bj) { const size_t off = (size_t)(row0 + ai * HALF + m * 16) * DMODEL + col0 + bj * HALF; const u32x4 h = hw[mm][bj], ee = ew[mm][bj];
                    const f32x4 h0 = (f32x4){bf_lo(h.x), bf_hi(h.x), bf_lo(h.y), bf_hi(h.y)}, h1 = (f32x4){bf_lo(h.z), bf_hi(h.z), bf_lo(h.w), bf_hi(h.w)};
                    const f32x4 e0 = (f32x4){bf_lo(ee.x), bf_hi(ee.x), bf_lo(ee.y), bf_hi(ee.y)} * q * gv[bj][0], e1 = (f32x4){bf_lo(ee.z), bf_hi(ee.z), bf_lo(ee.w), bf_hi(ee.w)} * q * gv[bj][1];
                    const f32x4 a0 = acc[ai][bj][m][0] * r, a1 = acc[ai][bj][m][1] * r; f32x4 y0, y1;
#pragma unroll
                    for (int e = 0; e < 4; ++e) { y0[e] = h0[e] + sigm(a0[e]) * e0[e]; y1[e] = h1[e] + sigm(a1[e]) * e1[e]; }
                    *(f32x4*)(out + off) = y0; *(f32x4*)(out + off + 4) = y1; } }
            asm volatile("" ::: "memory"); }
    }
};

template <class Epi, class Sched, bool ALIGN_EPI = false, bool SP2 = false>
__device__ __forceinline__ void gemm_phase(PG8_LAS unsigned char* lds, const Gemm g, const Sched& S, const Epi& E) {
    int tid = threadIdx.x; asm volatile("" : "+v"(tid));
    const int wid = __builtin_amdgcn_readfirstlane(tid >> 6), lane = tid & 63, wr = wid >> 2, wc = wid & 3, fr = lane & 15, fq = lane >> 4;
    const int K = g.K, nt = K / BK;
    unsigned voffA[2], voffB[2];
#pragma unroll
    for (int i = 0; i < 2; ++i) { int R, C; stage_rc(tid * 16 + i * 8192, R, C); const int Rb = Epi::PERM ? ((R & ~31) + perm32(R & 31)) : R;
        voffA[i] = (unsigned)(R * K + C) * 2u; voffB[i] = (unsigned)(Rb * K + C) * 2u; }
    const size_t kstep = (size_t)(BK * 2);
    const size_t hstep = (size_t)HALF * K * 2;
    const size_t tstep = 2 * hstep;
    const unsigned ldsw = (unsigned)wid * 1024u;
    const int aoff = lds_byte(wr * 64 + fr, fq * 8), boff = lds_byte(wc * 32 + fr, fq * 8);
#define PG8_SA(b, h) (((b) * 2 + (h)) * HTB)
#define PG8_SB(b, h) ((4 + (b) * 2 + (h)) * HTB)
#define PG8_STAGE(bufoff, gbase, voff) do { _Pragma("unroll") for (int _i = 0; _i < 2; ++_i) \
        __builtin_amdgcn_global_load_lds((const unsigned*)((const char*)(gbase) + (voff)[_i]), (PG8_LAS unsigned*)(lds + (bufoff) + ldsw + _i * 8192), 16, 0, 0); } while (0)
#define PG8_LDA(dst, b, h) do { _Pragma("unroll") for (int m = 0; m < 4; ++m) _Pragma("unroll") for (int k = 0; k < 2; ++k) dst[m][k] = *(const PG8_LAS bf16x8*)(lds + PG8_SA(b, h) + aoff + m * 2048 + k * 1024); } while (0)
#define PG8_LDB(dst, b, h) do { _Pragma("unroll") for (int n = 0; n < 2; ++n) _Pragma("unroll") for (int k = 0; k < 2; ++k) dst[n][k] = *(const PG8_LAS bf16x8*)(lds + PG8_SB(b, h) + boff + n * 2048 + k * 1024); } while (0)
#define PG8_MMA(ai, bj, At, Bt) do { __builtin_amdgcn_s_setprio(1); _Pragma("unroll") for (int m = 0; m < 4; ++m) _Pragma("unroll") for (int n = 0; n < 2; ++n) _Pragma("unroll") for (int k = 0; k < 2; ++k) \
        acc[ai][bj][m][n] = __builtin_amdgcn_mfma_f32_16x16x32_bf16(Bt[n][k], At[m][k], acc[ai][bj][m][n], 0, 0, 0); __builtin_amdgcn_s_setprio(0); } while (0)
#define PG8_WAIT_V(n) asm volatile("s_waitcnt vmcnt(" #n ")" ::: "memory")
#define PG8_WAIT_L(n) asm volatile("s_waitcnt lgkmcnt(" #n ")" ::: "memory")
#define PG8_WAIT_VN(n) asm volatile("s_waitcnt vmcnt(%0)" :: "n"(n) : "memory")
#define PG8_BAR __builtin_amdgcn_s_barrier()
#define PG8_SCHED __builtin_amdgcn_sched_barrier(0)
    Unit cur, nxt; int ui = 0;
    if (!S.next(0, cur)) return;
    f32x4 acc[2][2][4][2];
#pragma unroll
    for (int a = 0; a < 2; ++a)
#pragma unroll
        for (int b = 0; b < 2; ++b)
#pragma unroll
            for (int m = 0; m < 4; ++m)
#pragma unroll
                for (int n = 0; n < 2; ++n) acc[a][b][m][n] = (f32x4){0.f, 0.f, 0.f, 0.f};
    bf16x8 At[4][2], B0[2][2], B1[2][2];
    const char* cA = (const char*)g.A + (size_t)cur.pm * tstep + (size_t)cur.seg * g.dA; const char* cB = (const char*)g.Bt + (size_t)cur.pn * tstep + (size_t)cur.seg * g.dB;
    S.a_ready(cur);
    if constexpr (SP2) {
        PG8_STAGE(PG8_SB(0, 0), cB, voffB); PG8_STAGE(PG8_SB(0, 1), cB + hstep, voffB); PG8_STAGE(PG8_SA(0, 0), cA, voffA); PG8_STAGE(PG8_SA(0, 1), cA + hstep, voffA);
        if (wr == 1) PG8_BAR;
        PG8_WAIT_V(2); PG8_BAR;
        PG8_STAGE(PG8_SB(1, 0), cB + kstep, voffB); PG8_STAGE(PG8_SA(1, 0), cA + kstep, voffA); PG8_STAGE(PG8_SB(1, 1), cB + hstep + kstep, voffB);
        PG8_WAIT_V(6); PG8_BAR;
    } else {
        PG8_STAGE(PG8_SB(0, 0), cB, voffB); PG8_STAGE(PG8_SA(0, 0), cA, voffA); PG8_STAGE(PG8_SB(0, 1), cB + hstep, voffB); PG8_STAGE(PG8_SA(0, 1), cA + hstep, voffA);
        if (wr == 1) PG8_BAR;
        PG8_WAIT_V(4); PG8_BAR;
        PG8_STAGE(PG8_SB(1, 0), cB + kstep, voffB); PG8_STAGE(PG8_SA(1, 0), cA + kstep, voffA); PG8_STAGE(PG8_SB(1, 1), cB + hstep + kstep, voffB);
        PG8_WAIT_V(6); PG8_BAR;
    }
    for (;;) {
        const bool has_next = S.next(ui + 1, nxt);
        const char* nA = has_next ? (const char*)g.A + (size_t)nxt.pm * tstep + (size_t)nxt.seg * g.dA : cA; const char* nB = has_next ? (const char*)g.Bt + (size_t)nxt.pn * tstep + (size_t)nxt.seg * g.dB : cB;
#pragma unroll 1
        for (int t = 0; t < nt; t += 2) {
            const bool last = (t == nt - 2);
            const char* a1 = cA + (size_t)(t + 1) * kstep;
            const char* a2 = last ? nA : cA + (size_t)(t + 2) * kstep; const char* b2 = last ? nB : cB + (size_t)(t + 2) * kstep;
            const char* a3 = a2 + kstep; const char* b3 = b2 + kstep;
            if (last && has_next) S.a_ready(nxt);
            if constexpr (SP2) {
            const bool after_epi = (t == 0) && (ui > 0);
            PG8_LDB(B0, 0, 0); PG8_LDB(B1, 0, 1); PG8_SCHED; PG8_LDA(At, 0, 0); PG8_STAGE(PG8_SA(1, 1), a1 + hstep, voffA);
            if (after_epi) { PG8_WAIT_VN(8 + Epi::NST); } else { PG8_WAIT_V(8); } PG8_WAIT_L(0); PG8_BAR; PG8_MMA(0, 0, At, B0); PG8_MMA(0, 1, At, B1); PG8_BAR; PG8_SCHED;
            PG8_LDA(At, 0, 1); PG8_STAGE(PG8_SB(0, 0), b2, voffB); PG8_STAGE(PG8_SB(0, 1), b2 + hstep, voffB); PG8_STAGE(PG8_SA(0, 0), a2, voffA);
            if (after_epi) { PG8_WAIT_VN(8 + Epi::NST); } else { PG8_WAIT_V(8); } PG8_WAIT_L(0); PG8_BAR; PG8_MMA(1, 0, At, B0); PG8_MMA(1, 1, At, B1); PG8_BAR; PG8_SCHED;
            PG8_LDB(B0, 1, 0); PG8_LDB(B1, 1, 1); PG8_SCHED; PG8_LDA(At, 1, 0); PG8_STAGE(PG8_SA(0, 1), a2 + hstep, voffA);
            PG8_WAIT_V(8); PG8_WAIT_L(0); PG8_BAR; PG8_MMA(0, 0, At, B0); PG8_MMA(0, 1, At, B1); PG8_BAR; PG8_SCHED;
            PG8_LDA(At, 1, 1); PG8_STAGE(PG8_SB(1, 0), b3, voffB); PG8_STAGE(PG8_SB(1, 1), b3 + hstep, voffB); PG8_STAGE(PG8_SA(1, 0), a3, voffA);
            PG8_WAIT_V(8); PG8_WAIT_L(0); PG8_BAR; PG8_MMA(1, 0, At, B0); PG8_MMA(1, 1, At, B1); PG8_BAR; PG8_SCHED;
            } else {
            PG8_LDB(B0, 0, 0); PG8_SCHED; PG8_LDA(At, 0, 0); PG8_STAGE(PG8_SA(1, 1), a1 + hstep, voffA);
            PG8_WAIT_L(8); PG8_BAR; PG8_WAIT_L(0); PG8_MMA(0, 0, At, B0); PG8_BAR; PG8_SCHED;
            PG8_LDB(B1, 0, 1); PG8_STAGE(PG8_SB(0, 0), b2, voffB);
            PG8_BAR; PG8_WAIT_L(0); PG8_MMA(0, 1, At, B1); PG8_BAR;
            PG8_LDA(At, 0, 1); PG8_STAGE(PG8_SA(0, 0), a2, voffA);
            PG8_BAR; PG8_WAIT_L(0); PG8_MMA(1, 0, At, B0); PG8_BAR; PG8_SCHED;
            PG8_STAGE(PG8_SB(0, 1), b2 + hstep, voffB);
            PG8_WAIT_V(6); PG8_BAR; PG8_MMA(1, 1, At, B1); PG8_BAR;
            PG8_LDB(B0, 1, 0); PG8_SCHED; PG8_LDA(At, 1, 0); PG8_STAGE(PG8_SA(0, 1), a2 + hstep, voffA);
            PG8_WAIT_L(8); PG8_BAR; PG8_WAIT_L(0); PG8_MMA(0, 0, At, B0); PG8_BAR; PG8_SCHED;
            PG8_LDB(B1, 1, 1); PG8_STAGE(PG8_SB(1, 0), b3, voffB);
            PG8_BAR; PG8_WAIT_L(0); PG8_MMA(0, 1, At, B1); PG8_BAR;
            PG8_LDA(At, 1, 1); PG8_STAGE(PG8_SA(1, 0), a3, voffA);
            PG8_BAR; PG8_WAIT_L(0); PG8_MMA(1, 0, At, B0); PG8_BAR; PG8_SCHED;
            PG8_STAGE(PG8_SB(1, 1), b3 + hstep, voffB);
            PG8_WAIT_V(6); PG8_BAR; PG8_MMA(1, 1, At, B1); PG8_BAR;
            }
        }
        if constexpr (ALIGN_EPI) { if (wr == 0) PG8_BAR; }
        if constexpr (!Epi::AFTER_DRAIN) { E(acc, cur, wr, wc, fr, fq); S.done(cur); }
        if (!has_next) break;
        if (!(Epi::SEG && cur.seg == 0))
#pragma unroll
        for (int a = 0; a < 2; ++a)
#pragma unroll
            for (int b = 0; b < 2; ++b)
#pragma unroll
                for (int m = 0; m < 4; ++m)
#pragma unroll
                    for (int n = 0; n < 2; ++n) acc[a][b][m][n] = (f32x4){0.f, 0.f, 0.f, 0.f};
        cur = nxt; cA = nA; cB = nB; ++ui;
        if constexpr (ALIGN_EPI) { if (wr == 1) PG8_BAR; }
    }
    PG8_WAIT_V(0);
    if constexpr (!ALIGN_EPI) { if (wr == 0) PG8_BAR; }
    PG8_BAR;
    if constexpr (Epi::AFTER_DRAIN) { E.fused(acc, cur, wr, wc, fr, fq, lds, wid, lane); S.done(cur); }
#undef PG8_SA
#undef PG8_SB
#undef PG8_STAGE
#undef PG8_LDA
#undef PG8_LDB
#undef PG8_MMA
#undef PG8_WAIT_V
#undef PG8_WAIT_L
#undef PG8_WAIT_VN
#undef PG8_BAR
#undef PG8_SCHED
}
}
#include <hip/hip_bf16.h>
#include <cmath>
namespace attn_body {
using bf16=__hip_bfloat16;
using bf16x8=__attribute__((ext_vector_type(8)))short;
using s16x4=__attribute__((ext_vector_type(4)))short;
using f32x16=__attribute__((ext_vector_type(16)))float;
using u32x4=__attribute__((ext_vector_type(4)))unsigned;
constexpr int D=64,QP=512,KP=128;
constexpr int NW=8,QBLK=32,QB=QBLK*NW,KVBLK=64;
constexpr int ATTN_UNIT_ROWS=QB;
__device__ __forceinline__ int crow(int r,int hi){return (r&3)+8*(r>>2)+4*hi;}
#define SBAR() __builtin_amdgcn_sched_barrier(0)
__device__ __forceinline__ void cmask(f32x16&p0,f32x16&p1,int jb,int qrel,int hi){
  const float NEG=-INFINITY; int kb=64*jb+4*hi;
  #pragma unroll
  for(int r=0;r<16;++r){int kv=kb+(r&3)+8*(r>>2); if(kv>qrel)p0[r]=NEG; if(kv+32>qrel)p1[r]=NEG;}
}

constexpr int NSLOT=3, SLOTB=8192;
constexpr int LDS_K=0, LDS_V=NSLOT*SLOTB, LDS_WS=2*NSLOT*SLOTB, LDS_OST=LDS_WS+NW*64*4, LDS_BYTES=LDS_OST+NW*4096;
constexpr float C2=0.125f*1.4426950408889634f;
__device__ __forceinline__ void glds16(const void*gsrc,unsigned lds_dst){unsigned keep;
  asm volatile("s_mov_b32 %0, m0\n\ts_mov_b32 m0, %2\n\ts_nop 0\n\tglobal_load_lds_dwordx4 %1, off\n\ts_mov_b32 m0, %0":"=&s"(keep):"v"(gsrc),"s"(lds_dst):"memory");}
__device__ __forceinline__ float max3f(float a,float b,float c){float r;asm("v_max3_f32 %0, %1, %2, %3":"=v"(r):"v"(a),"v"(b),"v"(c));return r;}
__device__ __forceinline__ float max2f(float a,float b){float r;asm("v_max_f32_e32 %0, %1, %2":"=v"(r):"v"(a),"v"(b));return r;}
__device__ __forceinline__ float fadd_s(float a,float b){float r;asm("v_add_f32_e32 %0, %1, %2":"=v"(r):"v"(a),"v"(b));return r;}
__device__ __forceinline__ float fsub_s(float a,float b){float r;asm("v_sub_f32_e32 %0, %1, %2":"=v"(r):"v"(a),"v"(b));return r;}
typedef float f32x2_t __attribute__((ext_vector_type(2))); typedef __bf16 bf16x2_t __attribute__((ext_vector_type(2)));
__device__ __forceinline__ unsigned cvtpk_s(float lo,float hi){f32x2_t v={lo,hi};bf16x2_t b=__builtin_convertvector(v,bf16x2_t);return __builtin_bit_cast(unsigned,b);}
#define WAIT_BAR(N) asm volatile("s_waitcnt vmcnt(" #N ") lgkmcnt(0)\n\ts_barrier":::"memory")

__device__ __forceinline__ void qkt(f32x16&p0,f32x16&p1,const char*Kslot,const bf16x8*qr,const f32x16&negm,int r32,int hi){
  const char*kb=Kslot+hi*1024+r32*16;
  #pragma unroll
  for(int d0=0;d0<4;++d0){
    const bf16x8 b0=*reinterpret_cast<const bf16x8*>(kb+d0*2048);
    const bf16x8 b1=*reinterpret_cast<const bf16x8*>(kb+d0*2048+512);
    if(d0==0){p0=__builtin_amdgcn_mfma_f32_32x32x16_bf16(b0,qr[0],negm,0,0,0);p1=__builtin_amdgcn_mfma_f32_32x32x16_bf16(b1,qr[0],negm,0,0,0);}
    else{p0=__builtin_amdgcn_mfma_f32_32x32x16_bf16(b0,qr[d0],p0,0,0,0);p1=__builtin_amdgcn_mfma_f32_32x32x16_bf16(b1,qr[d0],p1,0,0,0);}}
}
typedef __attribute__((address_space(3))) const char* lds_cptr;
typedef short v4i16_t __attribute__((ext_vector_type(4)));
__device__ __forceinline__ void kload8(bf16x8*kf,lds_cptr kp){
  kf[0]=*(const __attribute__((address_space(3))) bf16x8*)(kp);      kf[1]=*(const __attribute__((address_space(3))) bf16x8*)(kp+512);
  kf[2]=*(const __attribute__((address_space(3))) bf16x8*)(kp+2048); kf[3]=*(const __attribute__((address_space(3))) bf16x8*)(kp+2560);
  kf[4]=*(const __attribute__((address_space(3))) bf16x8*)(kp+4096); kf[5]=*(const __attribute__((address_space(3))) bf16x8*)(kp+4608);
  kf[6]=*(const __attribute__((address_space(3))) bf16x8*)(kp+6144); kf[7]=*(const __attribute__((address_space(3))) bf16x8*)(kp+6656);
}
__device__ __forceinline__ void kload2(bf16x8*kf,lds_cptr kp,int j){ kf[2*j]=*(const __attribute__((address_space(3))) bf16x8*)(kp+j*2048); kf[2*j+1]=*(const __attribute__((address_space(3))) bf16x8*)(kp+j*2048+512); }
__device__ __forceinline__ s16x4 vtr(lds_cptr p){ return __builtin_bit_cast(s16x4,__builtin_amdgcn_ds_read_tr16_b64_v4i16((__attribute__((address_space(3))) v4i16_t*)p)); }
__device__ __forceinline__ float rowmax(const f32x16&p0,const f32x16&p1){
  float a=max3f(p0[0],p0[1],p1[0]),b=max3f(p0[2],p0[3],p1[1]);a=max3f(a,p1[2],p1[3]);
  #pragma unroll
  for(int r=4;r<16;r+=4){a=max3f(a,p0[r],p0[r+1]);b=max3f(b,p0[r+2],p0[r+3]);a=max3f(a,p1[r],p1[r+1]);b=max3f(b,p1[r+2],p1[r+3]);}
  const float m=max2f(a,b);
  auto rr=__builtin_amdgcn_permlane32_swap(__float_as_uint(m),__float_as_uint(m),false,false);
  return max2f(__uint_as_float(rr[0]),__uint_as_float(rr[1]));
}
__device__ __forceinline__ void pv(f32x16*o,int vb,bf16x8 pa0,bf16x8 pa1,bf16x8 pa2,bf16x8 pa3){
  #pragma unroll
  for(int d0=0;d0<2;++d0){s16x4 lo[4],hi[4];
    #pragma unroll
    for(int ks=0;ks<4;++ks){
      asm volatile("ds_read_b64_tr_b16 %0,%1 offset:%c2":"=&v"(lo[ks]):"v"(vb),"i"(d0*4096+ks*1024):"memory");
      asm volatile("ds_read_b64_tr_b16 %0,%1 offset:%c2":"=&v"(hi[ks]):"v"(vb),"i"(d0*4096+ks*1024+512):"memory");}
    asm volatile("s_waitcnt lgkmcnt(0)":::"memory");SBAR();
    #define PK(k) (bf16x8){lo[k][0],lo[k][1],lo[k][2],lo[k][3],hi[k][0],hi[k][1],hi[k][2],hi[k][3]}
    o[d0]=__builtin_amdgcn_mfma_f32_32x32x16_bf16(pa0,PK(0),o[d0],0,0,0);
    o[d0]=__builtin_amdgcn_mfma_f32_32x32x16_bf16(pa1,PK(1),o[d0],0,0,0);
    o[d0]=__builtin_amdgcn_mfma_f32_32x32x16_bf16(pa2,PK(2),o[d0],0,0,0);
    o[d0]=__builtin_amdgcn_mfma_f32_32x32x16_bf16(pa3,PK(3),o[d0],0,0,0);
    #undef PK
  }
}

#ifndef ATTN_STORE16
#define ATTN_STORE16(p,v) (*(u32x4*)(p)=(v))
#endif
template<int THRL> __device__ __forceinline__ void attn_unit(long rowbase,int h,int qb,int NT,const bf16*Q,const bf16*__restrict__ K,const bf16*__restrict__ V,bf16*O,char*shm){
  int tid=threadIdx.x; asm volatile("":"+v"(tid)); const int lane=tid&63,r32=lane&31,hi=lane>>5; const int wid=__builtin_amdgcn_readfirstlane(tid>>6);
  const int q0=qb*QB;
  const bf16*Qw=Q+(rowbase+q0+wid*QBLK)*QP+h*D;
  const bf16*Kh=K+rowbase*KP+(h>>2)*D,*Vh=V+rowbase*KP+(h>>2)*D;
  const unsigned lds0=(unsigned)(uintptr_t)shm;
  float*wsf=(float*)(shm+LDS_WS)+wid*64;
  const bf16*ksrc=Kh+(long)lane*KP+wid*8;
  const bf16*vsrc=Vh+(long)(16*(wid&3)+(lane>>2))*KP+(wid>>2)*32+(lane&3)*8;
  const unsigned kdst=lds0+LDS_K+wid*1024, vdst=lds0+LDS_V+wid*1024;
  #define DMA_K(t,slot) glds16(ksrc+(long)(t)*KVBLK*KP,(unsigned)__builtin_amdgcn_readfirstlane(kdst+(slot)))
  #define DMA_V(t,slot) glds16(vsrc+(long)(t)*KVBLK*KP,(unsigned)__builtin_amdgcn_readfirstlane(vdst+(slot)))
  const int vb0=(int)(lds0+LDS_V)+((lane>>4)&1)*32+(lane&3)*8+(4*hi+((lane&15)>>2))*64;
  const char*Kbase=shm+LDS_K; bf16x8 kf[8];
  const lds_cptr shm3=(lds_cptr)shm; const lds_cptr kp0=shm3+LDS_K+hi*1024+r32*16; const lds_cptr vp0=shm3+LDS_V+((lane>>4)&1)*32+(lane&3)*8+(4*hi+((lane&15)>>2))*64;
  DMA_K(0,0);DMA_V(0,0);DMA_K(1,SLOTB);
  bf16x8 qr[4];
  #pragma unroll
  for(int d0=0;d0<4;++d0)qr[d0]=*reinterpret_cast<const bf16x8*>(&Qw[(long)r32*QP+d0*16+hi*8]);
  float mhat=0.f,l_reg=0.f;f32x16 o[2];o[0]=f32x16{};o[1]=f32x16{};f32x16 negm=f32x16{};asm volatile("":"+v"(negm));
    #define CMASK(P0,P1,t) do{}while(0)
  bool resc=false;
  #define START(P0,P1) do{ const float rm=rowmax(P0,P1); resc=false; \
    { const float dl=rm; mhat=fadd_s(mhat,dl); \
      _Pragma("unroll") for(int r=0;r<16;++r){P0[r]=fsub_s(P0[r],dl);P1[r]=fsub_s(P1[r],dl);} \
      _Pragma("unroll") for(int r=0;r<16;++r)negm[r]=-mhat; asm volatile("":"+v"(negm)); } \
    _Pragma("unroll") for(int r=0;r<16;++r)P0[r]=__builtin_amdgcn_exp2f(P0[r]); }while(0)
  #define RESC() do{ if(resc){ asm volatile("s_waitcnt lgkmcnt(0)":::"memory"); \
      _Pragma("unroll") for(int d_=0;d_<2;++d_) _Pragma("unroll") for(int r=0;r<16;++r)o[d_][r]*=wsf[crow(r,hi)]; } }while(0)
  f32x16 pA0,pA1,pB0,pB1;
  int sl_prev=0,sl_cur=0,sl_next=SLOTB;
  #define ROT() do{sl_prev=sl_cur;sl_cur=sl_next;sl_next=(sl_next==(NSLOT-1)*SLOTB)?0:sl_next+SLOTB;}while(0)
  DMA_K(2,2*SLOTB);
  WAIT_BAR(3);
  qkt(pA0,pA1,Kbase,qr,negm,r32,hi);asm volatile("s_nop 15\n\ts_nop 7":"+v"(pA0),"+v"(pA1));CMASK(pA0,pA1,0);
  START(pA0,pA1);
  _Pragma("unroll") for(int r=0;r<16;++r)pA1[r]=__builtin_amdgcn_exp2f(pA1[r]);
  WAIT_BAR(0);
  DMA_K(3,0);DMA_V(1,SLOTB);
  ROT();
  kload8(kf,kp0+sl_cur);
  WAIT_BAR(2);
  s16x4 vlo[8],vhi[8]; u32x4 pw0,pw1,pw2,pw3;
  #define PKW(P,B) cvtpk_s(P[B],P[B+1])
  #define PAF(k) __builtin_bit_cast(bf16x8,pw##k)
  #define VFR(i) (bf16x8){vlo[i][0],vlo[i][1],vlo[i][2],vlo[i][3],vhi[i][0],vhi[i][1],vhi[i][2],vhi[i][3]}
  #define PIN(x) asm volatile("":"+v"(x))
  #define MX3(a,b,c) __builtin_fmaxf(__builtin_fmaxf((a),(b)),(c))
  #define GAPA(MF,A0,A1,A2,A3,W0,W1,PW) do{ MF; sacc+=A0; sacc+=A1; sacc+=A2; sacc+=A3; PIN(sacc); W0; W1; PIN(PW); SBAR(); }while(0)
  #define EX(v) __builtin_amdgcn_exp2f(v)
  #define GAPB(MF,X,B) do{ MF; X[B]=EX(X[B]); X[B+1]=EX(X[B+1]); X[B+2]=EX(X[B+2]); X[B+3]=EX(X[B+3]); PIN(X); SBAR(); }while(0)
  #define VRD(i) do{ vlo[i]=vtr(vp_+(((i)>>2)*4096+((i)&3)*1024)); vhi[i]=vtr(vp_+(((i)>>2)*4096+((i)&3)*1024+512)); }while(0)
  #define KRD(G,j) do{ if(G){ kload2(kf,kp0+sl_next,j); SBAR(); } }while(0)
  #define STEP(C0,C1,P0,P1,t,GK,GV,GL) do{ SBAR(); \
    const lds_cptr vp_=vp0+sl_prev; \
    VRD(0); SBAR(); float sacc=(P0[0]+P0[1]); \
    GAPA(C0=__builtin_amdgcn_mfma_f32_32x32x16_bf16(kf[0],qr[0],negm,0,0,0), P0[2],P0[3],P0[4],P0[5],     pw0[0]=PKW(P0,0), pw0[1]=PKW(P0,2), pw0); \
    VRD(4); SBAR(); GAPA(C1=__builtin_amdgcn_mfma_f32_32x32x16_bf16(kf[1],qr[0],negm,0,0,0), P0[6],P0[7],P0[8],P0[9],     pw0[2]=PKW(P0,4), pw0[3]=PKW(P0,6), pw0); \
    VRD(1); SBAR(); GAPA(C0=__builtin_amdgcn_mfma_f32_32x32x16_bf16(kf[2],qr[1],C0,0,0,0),   P0[10],P0[11],P0[12],P0[13], pw1[0]=PKW(P0,8), pw1[1]=PKW(P0,10), pw1); \
    VRD(5); SBAR(); GAPA(C1=__builtin_amdgcn_mfma_f32_32x32x16_bf16(kf[3],qr[1],C1,0,0,0),   P0[14],P0[15],P1[0],P1[1],   pw1[2]=PKW(P0,12),pw1[3]=PKW(P0,14), pw1); \
    VRD(2); SBAR(); GAPA(C0=__builtin_amdgcn_mfma_f32_32x32x16_bf16(kf[4],qr[2],C0,0,0,0),   P1[2],P1[3],P1[4],P1[5],     pw2[0]=PKW(P1,0), pw2[1]=PKW(P1,2), pw2); \
    VRD(6); SBAR(); GAPA(C1=__builtin_amdgcn_mfma_f32_32x32x16_bf16(kf[5],qr[2],C1,0,0,0),   P1[6],P1[7],P1[8],P1[9],     pw2[2]=PKW(P1,4), pw2[3]=PKW(P1,6), pw2); \
    VRD(3); SBAR(); GAPA(C0=__builtin_amdgcn_mfma_f32_32x32x16_bf16(kf[6],qr[3],C0,0,0,0),   P1[10],P1[11],P1[12],P1[13], pw3[0]=PKW(P1,8), pw3[1]=PKW(P1,10), pw3); \
    VRD(7); SBAR(); GAPA(C1=__builtin_amdgcn_mfma_f32_32x32x16_bf16(kf[7],qr[3],C1,0,0,0),   P1[14],P1[15],0.f,0.f,       pw3[2]=PKW(P1,12),pw3[3]=PKW(P1,14), pw3); \
    l_reg+=sacc; \
    if(GK){DMA_K((t)+3,sl_cur);} if(GV){DMA_V((t)+1,sl_next);} \
    CMASK(C0,C1,t); \
    { float a=MX3(C0[0],C0[1],C1[0]),b=MX3(C0[2],C0[3],C1[1]); a=MX3(a,C1[2],C1[3]); \
      _Pragma("unroll") for(int r=4;r<16;r+=4){a=MX3(a,C0[r],C0[r+1]);b=MX3(b,C0[r+2],C0[r+3]);a=MX3(a,C1[r],C1[r+1]);b=MX3(b,C1[r+2],C1[r+3]);} \
      float rm=__builtin_fmaxf(a,b); { auto rr=__builtin_amdgcn_permlane32_swap(__float_as_uint(rm),__float_as_uint(rm),false,false); rm=__builtin_fmaxf(__uint_as_float(rr[0]),__uint_as_float(rr[1])); } \
      resc=false; \
      if(__builtin_expect(__any(rm>(float)THRL),0)){ const float dl=__builtin_fmaxf(rm,0.f); mhat+=dl; \
        _Pragma("unroll") for(int r=0;r<16;++r){C0[r]-=dl;C1[r]-=dl;} \
        _Pragma("unroll") for(int r=0;r<16;++r)negm[r]=-mhat; asm volatile("":"+v"(negm)); \
        const float f=__builtin_amdgcn_exp2f(-dl); l_reg*=f; if(hi==0)wsf[r32]=f; resc=true; } } \
    SBAR(); \
    GAPB(o[0]=__builtin_amdgcn_mfma_f32_32x32x16_bf16(PAF(0),VFR(0),o[0],0,0,0), C0,0); \
    GAPB(o[1]=__builtin_amdgcn_mfma_f32_32x32x16_bf16(PAF(0),VFR(4),o[1],0,0,0), C0,4); \
    KRD(GL,0); GAPB(o[0]=__builtin_amdgcn_mfma_f32_32x32x16_bf16(PAF(1),VFR(1),o[0],0,0,0), C0,8); \
    KRD(GL,1); GAPB(o[1]=__builtin_amdgcn_mfma_f32_32x32x16_bf16(PAF(1),VFR(5),o[1],0,0,0), C0,12); \
    KRD(GL,2); GAPB(o[0]=__builtin_amdgcn_mfma_f32_32x32x16_bf16(PAF(2),VFR(2),o[0],0,0,0), C1,0); \
    KRD(GL,3); GAPB(o[1]=__builtin_amdgcn_mfma_f32_32x32x16_bf16(PAF(2),VFR(6),o[1],0,0,0), C1,4); \
    GAPB(o[0]=__builtin_amdgcn_mfma_f32_32x32x16_bf16(PAF(3),VFR(3),o[0],0,0,0), C1,8); \
    GAPB(o[1]=__builtin_amdgcn_mfma_f32_32x32x16_bf16(PAF(3),VFR(7),o[1],0,0,0), C1,12); \
    }while(0)
  int t=1;
  #undef CMASK
  #define CMASK(P0,P1,t) do{}while(0)
  for(;t+5<NT;t+=2){
    STEP(pB0,pB1,pA0,pA1,t,true,true,true);     WAIT_BAR(2); RESC(); ROT();
    STEP(pA0,pA1,pB0,pB1,t+1,true,true,true);   WAIT_BAR(2); RESC(); ROT();
  }
  #undef CMASK
  #define CMASK(P0,P1,t) do{}while(0)
  #define ENDW(tt) do{ if((tt)+3<NT){WAIT_BAR(2);} else if((tt)+2<NT){WAIT_BAR(1);} else {WAIT_BAR(0);} }while(0)
  for(;t+1<NT;t+=2){
    STEP(pB0,pB1,pA0,pA1,t,(t+3<NT),(t+1<NT),(t+1<NT));       ENDW(t);   RESC(); ROT();
    STEP(pA0,pA1,pB0,pB1,t+1,(t+4<NT),(t+2<NT),(t+2<NT));     ENDW(t+1); RESC(); ROT();
  }
  STEP(pB0,pB1,pA0,pA1,NT-1,false,false,false); RESC();
  { float sacc=pB0[0]+pB0[1]; _Pragma("unroll") for(int r=2;r<16;++r)sacc+=pB0[r]; _Pragma("unroll") for(int r=0;r<16;++r)sacc+=pB1[r]; l_reg+=sacc;
    pw0=(u32x4){PKW(pB0,0),PKW(pB0,2),PKW(pB0,4),PKW(pB0,6)};pw1=(u32x4){PKW(pB0,8),PKW(pB0,10),PKW(pB0,12),PKW(pB0,14)};pw2=(u32x4){PKW(pB1,0),PKW(pB1,2),PKW(pB1,4),PKW(pB1,6)};pw3=(u32x4){PKW(pB1,8),PKW(pB1,10),PKW(pB1,12),PKW(pB1,14)};
    SBAR(); pv(o,vb0+sl_cur,PAF(0),PAF(1),PAF(2),PAF(3)); }
  #undef PKW
  #undef PAF
  #undef VFR
  #undef PIN
  #undef MX3
  #undef GAPA
  #undef GAPB
  #undef EX
  #undef VRD
  #undef KRD
  #undef STEP
  #undef ENDW
  {auto rr=__builtin_amdgcn_permlane32_swap(__float_as_uint(l_reg),__float_as_uint(l_reg),false,false);l_reg=__uint_as_float(rr[0])+__uint_as_float(rr[1]);}
  if(hi==0)wsf[32+r32]=l_reg;asm volatile("s_waitcnt lgkmcnt(0)":::"memory");
  float rli[16];
  #pragma unroll
  for(int r=0;r<16;++r)rli[r]=__builtin_amdgcn_rcpf(wsf[32+crow(r,hi)]);
  bf16*Ow=O+(rowbase+q0+wid*QBLK)*QP+h*D;
  { bf16*stg=(bf16*)(shm+LDS_OST)+wid*2048;
    #pragma unroll
    for(int r=0;r<16;++r){const int orow=crow(r,hi);
      #pragma unroll
      for(int d0=0;d0<2;++d0)stg[orow*64+d0*32+r32]=__float2bfloat16(o[d0][r]*rli[r]);}
    asm volatile("s_waitcnt lgkmcnt(0)":::"memory");
    #pragma unroll
    for(int i=0;i<4;++i){const int row=i*8+(lane>>3),ch=lane&7; const u32x4 v=*(const u32x4*)(stg+row*64+ch*8); ATTN_STORE16(Ow+(long)row*QP+ch*8,v);} }
  asm volatile("s_waitcnt lgkmcnt(0)\n\ts_barrier":::"memory");
  #undef DMA_K
  #undef DMA_V
  #undef CMASK
  #undef START
  #undef RESC
  #undef ROT
}
constexpr int ATTN_LDS_BYTES=LDS_BYTES;
struct AttnTensors { const bf16* Q; const bf16* K; const bf16* V; bf16* O; };
template<int THRL=8> __device__ __forceinline__ void attn_phase(char*lds,const AttnTensors&T,int vcu,int G){
  for(int i=0;;++i){
    int u;
    if(G==256){ if(i>=6)break; u=(i<4)?(4*vcu+i):(1024+2*vcu+(i-4)); }
    else{ u=vcu+i*G; if(u>=1536)break; }
    long rowbase; int h,qb,NT;
    if(u<1024){ const int bh=u>>5; qb=u&31; rowbase=(long)(bh>>3)*8192; h=bh&7; NT=128; }
    else { const int v=u-1024; const int bh=v>>4; qb=v&15; rowbase=32768+(long)(bh>>3)*4096; h=bh&7; NT=64; }
    attn_unit<THRL>(rowbase,h,qb,NT,T.Q,T.K,T.V,T.O,lds);
  }
}
#undef SBAR
#undef WAIT_BAR
}
#ifndef PH_MASK
#define PH_MASK 0x3ff
#endif
#define PH(k) if constexpr ((PH_MASK >> (k)) & 1)
constexpr int NWAVES = 8;
constexpr int RING_BYTES = 131072, LDS_BYTES = 147456;

#define LAS __attribute__((address_space(3)))
typedef unsigned short bf16;
typedef unsigned v4u __attribute__((ext_vector_type(4)));
typedef float f32x4 __attribute__((ext_vector_type(4)));
#define LDS_WAIT() asm volatile("s_waitcnt lgkmcnt(0)" ::: "memory")
__device__ __forceinline__ unsigned f2bf(float f) { unsigned u = __builtin_bit_cast(unsigned, f); return (u + 0x7fffu + ((u >> 16) & 1u)) >> 16; }
__device__ __forceinline__ unsigned pk2(float lo, float hi) { return f2bf(lo) | (f2bf(hi) << 16); }
__device__ __forceinline__ float wave_sum(float v) {
#pragma unroll
    for (int o = 1; o < 64; o <<= 1) v += __shfl_xor(v, o);
    return v;
}
__device__ __forceinline__ void transpose_item(const float* W, int ldw, int src_col0, int k0, bf16* WT, int K, int dst_row0, LAS float* scr, int lane, const float* gk = nullptr) {
    float tv[32];
    const float* wp = W + (size_t)(k0 + (lane >> 5)) * ldw + src_col0 + (lane & 31);
#pragma unroll
    for (int i = 0; i < 32; ++i) tv[i] = wp[(size_t)(2 * i) * ldw];
#pragma unroll
    for (int i = 0; i < 32; ++i) { const int kk = 2 * i + (lane >> 5); scr[kk * 33 + (lane & 31)] = gk ? tv[i] * gk[k0 + kk] : tv[i]; }
    LDS_WAIT(); asm volatile("" ::: "memory");
    const int c = lane & 7;
#pragma unroll
    for (int j = 0; j < 4; ++j) { const int n = (lane >> 3) + 8 * j; const LAS float* s = scr + (8 * c) * 33 + n;
        v4u o; o.x = pk2(s[0 * 33], s[1 * 33]); o.y = pk2(s[2 * 33], s[3 * 33]); o.z = pk2(s[4 * 33], s[5 * 33]); o.w = pk2(s[6 * 33], s[7 * 33]);
        *(v4u*)(WT + (size_t)(dst_row0 + n) * K + k0 + 8 * c) = o; }
    LDS_WAIT(); asm volatile("" ::: "memory");
}

typedef __attribute__((address_space(1))) unsigned gu32;
#define RLX_AGENT __ATOMIC_RELAXED, __HIP_MEMORY_SCOPE_AGENT
#define LDS_WAIT() asm volatile("s_waitcnt lgkmcnt(0)" ::: "memory")
#define VM_WAIT() asm volatile("s_waitcnt vmcnt(0)" ::: "memory")
#define XB_TMO      128
#define XB_XCNT(j)  (256  + 64 * (j))
#define XB_XSUB(j)  (1280 + 64 * (j))
#define XB_XGEN(j)  (2304 + 64 * (j))
#define XB_TOP      3328
#define XB_TOPGEN   3392
#define XCD_BAR_WORDS 3456
#define XB_SPIN_CAP (1u << 18)

__device__ __forceinline__ unsigned xb_ld(unsigned* p)              { return __hip_atomic_load(p, __ATOMIC_RELAXED, __HIP_MEMORY_SCOPE_AGENT); }
__device__ __forceinline__ unsigned xb_add(unsigned* p, unsigned v) { return __hip_atomic_fetch_add(p, v, __ATOMIC_RELAXED, __HIP_MEMORY_SCOPE_AGENT); }
__device__ __forceinline__ unsigned xb_xcc_id() { return (unsigned)__builtin_amdgcn_s_getreg((3 << 11) | 20) & 0xFu; }
#define XB_SPIN(cond, bar) do { unsigned _sp = 0; while (cond) { __builtin_amdgcn_s_sleep(1); \
    if ((++_sp & 255u) == 0u) { if (xb_ld(&(bar)[XB_TMO])) break; if (_sp > XB_SPIN_CAP) { atomicAdd(&(bar)[XB_TMO], 1u); break; } } } } while (0)

struct XcdBarrier {
    unsigned* bar; unsigned x;
    volatile LAS unsigned* st;
};

__device__ __forceinline__ XcdBarrier xcd_barrier_post(unsigned* bar, volatile LAS unsigned* st) {
    XcdBarrier b; b.bar = bar; b.x = xb_xcc_id(); b.st = st;
    if (threadIdx.x == 0) (void)xb_add(&bar[XB_XCNT(b.x)], 1u);
    return b;
}
__device__ __forceinline__ void xcd_barrier_complete(unsigned* bar, unsigned x, unsigned& nloc, unsigned& nx) {
    const unsigned G = gridDim.x * gridDim.y * gridDim.z;
    unsigned sum, cnt, mine, sp = 0u;
    for (;;) {
        sum = 0u; cnt = 0u; mine = 0u;
#pragma unroll
        for (unsigned j = 0; j < 16; ++j) { const unsigned c = xb_ld(&bar[XB_XCNT(j)]); sum += c; cnt += (c > 0u) ? 1u : 0u; mine = (j == x) ? c : mine; }
        if (sum == G) break;
        __builtin_amdgcn_s_sleep(1);
        if ((++sp & 255u) == 0u) { if (xb_ld(&bar[XB_TMO])) break; if (sp > XB_SPIN_CAP) { atomicAdd(&bar[XB_TMO], 1u); break; } }
    }
    nloc = mine > 0u ? mine : 1u; nx = cnt > 0u ? cnt : 1u;
}

__device__ __forceinline__ void xcd_barrier(const XcdBarrier& b) {
    asm volatile("s_waitcnt vmcnt(0)" ::: "memory");
    __syncthreads();
    if (threadIdx.x == 0) {
        unsigned* bar = b.bar;
        __builtin_amdgcn_s_waitcnt(0);
        unsigned nloc = b.st[0], nx = b.st[1];
        if (nloc == 0u) { xcd_barrier_complete(bar, b.x, nloc, nx); b.st[0] = nloc; b.st[1] = nx; }
        const unsigned old = xb_add(&bar[XB_XSUB(b.x)], 1u);
        const unsigned gen = old / nloc;
        if (old + 1u == (gen + 1u) * nloc) {
            __builtin_amdgcn_fence(__ATOMIC_RELEASE, "agent");
            asm volatile("s_waitcnt vmcnt(0)" ::: "memory");
            const unsigned og = xb_add(&bar[XB_TOP], 1u);
            const unsigned tg = og / nx;
            if (og + 1u == (tg + 1u) * nx) xb_add(&bar[XB_TOPGEN], 1u);
            else XB_SPIN(xb_ld(&bar[XB_TOPGEN]) == tg, bar);
            __builtin_amdgcn_fence(__ATOMIC_ACQUIRE, "agent");
            xb_add(&bar[XB_XGEN(b.x)], 1u);
            asm volatile("s_waitcnt vmcnt(0)" ::: "memory");
        } else {
            XB_SPIN(xb_ld(&bar[XB_XGEN(b.x)]) == gen, bar);
            __builtin_amdgcn_fence(__ATOMIC_ACQUIRE, "agent");
            asm volatile("s_waitcnt vmcnt(0)" ::: "memory");
        }
    }
    __syncthreads();
}

template <int W> __device__ __forceinline__ void pool_item(const bf16* Zb, bf16* PL, int row, int ch) {
    constexpr int left = W / 2;
    const int T = row < MP ? 8192 : 4096, t = row < MP ? (row & 8191) : ((row - MP) & 4095);
    const bf16* zp = Zb + (size_t)(row - t) * 512 + ch * 8;
    v4u q[W];
#pragma unroll
    for (int k = 0; k < W; ++k) { int tt = t - left + k; tt = tt < 0 ? 0 : (tt > T - 1 ? T - 1 : tt); q[k] = *(const v4u*)(zp + (size_t)tt * 512); }
    float a[8];
#pragma unroll
    for (int e = 0; e < 8; ++e) a[e] = 0.f;
#pragma unroll
    for (int k = 0; k < W; ++k) { const int tt = t - left + k; const float wv = (tt >= 0 && tt < T) ? 1.f : 0.f;
        a[0] += wv * pg8::bf_lo(q[k].x); a[1] += wv * pg8::bf_hi(q[k].x); a[2] += wv * pg8::bf_lo(q[k].y); a[3] += wv * pg8::bf_hi(q[k].y);
        a[4] += wv * pg8::bf_lo(q[k].z); a[5] += wv * pg8::bf_hi(q[k].z); a[6] += wv * pg8::bf_lo(q[k].w); a[7] += wv * pg8::bf_hi(q[k].w); }
    const int lo = (t - left) > 0 ? (t - left) : 0, hi = (t + W - 1 - left) < (T - 1) ? (t + W - 1 - left) : (T - 1);
    const float ic = 1.0f / (float)(hi - lo + 1); const v4u s = q[left];
    v4u o; o.x = pk2(a[0] * ic - pg8::bf_lo(s.x), a[1] * ic - pg8::bf_hi(s.x)); o.y = pk2(a[2] * ic - pg8::bf_lo(s.y), a[3] * ic - pg8::bf_hi(s.y));
    o.z = pk2(a[4] * ic - pg8::bf_lo(s.z), a[5] * ic - pg8::bf_hi(s.z)); o.w = pk2(a[6] * ic - pg8::bf_lo(s.w), a[7] * ic - pg8::bf_hi(s.w));
    *(v4u*)(PL + (size_t)row * 512 + ch * 8) = o;
}
struct Args { const float* in[25]; float* out; unsigned char* ws; };
static_assert(sizeof(Args) == 27 * 8, "Args has no padding");

__device__ __forceinline__ void gateup_items(int r, const float* Wg, const float* Wu, bf16* WT, LAS float* scr, int lane, const float* gk) {
    const int kb = r / 176, G = r % 176, tile = G >> 3, w = G & 7;
    transpose_item((w < 4) ? Wg : Wu, DFF, tile * 128 + (w & 3) * 32, kb * 64, WT, 1024, G * 32, scr, lane, gk);
}

__global__ void __launch_bounds__(NWAVES * 64, 2) fwd_mega(Args args) {
    extern __shared__ __attribute__((aligned(16))) unsigned char lds[];
    cg::grid_group grid = cg::this_grid();
    const int tid = threadIdx.x, lane = tid & 63, wave = __builtin_amdgcn_readfirstlane(tid >> 6);
    const int G = gridDim.x, bx = blockIdx.x, vcu = (G % 8 == 0) ? (bx % 8) * (G / 8) + bx / 8 : bx;
    unsigned char* ws = args.ws;
    LAS unsigned char* ldsp = (LAS unsigned char*)lds;
    const float* x_p = args.in[0]; const float* x_s = args.in[1]; const float* p_p = args.in[2]; const float* p_s = args.in[3];
    float* out = args.out;
    float* SS = (float*)(ws + WS_SS); float* SSE = (float*)(ws + WS_SSE);
    bf16* W1 = (bf16*)(ws + WS_W1); bf16* WD1 = (bf16*)(ws + WS_WD1); bf16* WIN = (bf16*)(ws + WS_WIN); bf16* WUA = (bf16*)(ws + WS_WUA); bf16* WPC = (bf16*)(ws + WS_WPC);
    bf16* WOUT = (bf16*)(ws + WS_WOUT); bf16* W2 = (bf16*)(ws + WS_W2); bf16* WD2 = (bf16*)(ws + WS_WD2); bf16* WPG = (bf16*)(ws + WS_WPG); bf16* WPP = (bf16*)(ws + WS_WPP);
    bf16* HB = (bf16*)(ws + WS_HB); bf16* ACT = (bf16*)(ws + WS_ACT); bf16* QO = (bf16*)(ws + WS_QO); bf16* Zb = (bf16*)(ws + WS_Z); bf16* PL = (bf16*)(ws + WS_PL);
    bf16* MX = (bf16*)(ws + WS_MX); bf16* KB = (bf16*)(ws + WS_K); bf16* VB = (bf16*)(ws + WS_V); bf16* PB = (bf16*)(ws + WS_PB); bf16* SGB = (bf16*)(ws + WS_SGB); bf16* EB = (bf16*)(ws + WS_E);
    volatile LAS unsigned* bst = (volatile LAS unsigned*)(ldsp + 139264);
    if (tid < 2) bst[tid] = 0u;
    __syncthreads();
    const XcdBarrier xbar = xcd_barrier_post((unsigned*)ws, bst);
    const int gw = vcu * NWAVES + wave, NGW = G * NWAVES;
    const int gt = bx * (NWAVES * 64) + tid, NGT = G * NWAVES * 64;

    PH(0) {
        LAS float* scr = (LAS float*)(ldsp + wave * 16384);
        constexpr int I1 = 16 * 176, I2 = 44 * 32, I3 = 16 * 104, I4 = 8 * 32, I6 = 16 * 32, I10 = 4 * 32;
        constexpr int NITEMS = 2 * I1 + 2 * I2 + I3 + I4 + 2 * I6 + I10;
        for (int it = gw; it < NITEMS; it += NGW) {
            int r = it;
            if (r < I1) { gateup_items(r, args.in[5], args.in[6], W1, scr, lane, nullptr); continue; } r -= I1;
            if (r < I1) { gateup_items(r, args.in[18], args.in[19], W2, scr, lane, args.in[17]); continue; } r -= I1;
            if (r < I2) { transpose_item(args.in[7], 1024, (r % 32) * 32, (r / 32) * 64, WD1, DFF, (r % 32) * 32, scr, lane); continue; } r -= I2;
            if (r < I2) { transpose_item(args.in[20], 1024, (r % 32) * 32, (r / 32) * 64, WD2, DFF, (r % 32) * 32, scr, lane); continue; } r -= I2;
            if (r < I3) { const int kb = r / 104, Gp = r % 104; const int c0 = Gp < 24 ? ((Gp >> 3) * 256 + (Gp & 3) * 64 + ((Gp >> 2) & 1) * 32) : Gp * 32;
                transpose_item(args.in[9], INW, c0, kb * 64, WIN, 1024, Gp * 32, scr, lane, args.in[8]); continue; } r -= I3;
            if (r < I4) { transpose_item(args.in[12], 1024, (r % 32) * 32, (r / 32) * 64, WUA, 512, (r % 32) * 32, scr, lane); continue; } r -= I4;
            if (r < I6) { transpose_item(args.in[16], 1024, (r % 32) * 32, (r / 32) * 64, WOUT, 1024, (r % 32) * 32, scr, lane); continue; } r -= I6;
            if (r < I6) { transpose_item(args.in[22], 1024, (r % 32) * 32, (r / 32) * 64, WPG, 1024, (r % 32) * 32, scr, lane, args.in[21]); continue; } r -= I6;
            transpose_item(args.in[23], 1024, (r % 32) * 32, (r / 32) * 64, WPP, PLE, (r % 32) * 32, scr, lane);
        }
        if (gt < 128) ((float*)(ws + WS_GQK))[gt] = gt < 64 ? args.in[10][gt] : args.in[11][gt - 64];
        { const float* pw = args.in[13]; const float* psc = args.in[14]; const float* wup = args.in[15];
          for (int idx = gt; idx < 128 * 1024; idx += NGT) { const int d = idx & 1023, c0 = (idx >> 10) * 4, g0 = c0 & ~127; float a0 = 0.f, a1 = 0.f, a2 = 0.f, a3 = 0.f;
              const float* pr = pw + (size_t)c0 * 128; const float* bp = wup + (size_t)g0 * 1024 + d;
#pragma unroll 16
              for (int j = 0; j < 128; ++j) { const float b = bp[(size_t)j * 1024] * psc[g0 + j]; a0 += pr[j] * b; a1 += pr[128 + j] * b; a2 += pr[256 + j] * b; a3 += pr[384 + j] * b; }
              *(unsigned long long*)(WPC + (size_t)d * 512 + c0) = (unsigned long long)pk2(a0, a1) | ((unsigned long long)pk2(a2, a3) << 32); } }
        { const float* g1 = args.in[4]; f32x4 gv[4];
#pragma unroll
          for (int j = 0; j < 4; ++j) gv[j] = ((const f32x4*)g1)[lane + 64 * j];
          for (int m0 = gw * 4; m0 < MTOT; m0 += NGW * 4) { const float* xr = m0 < MP ? x_p + (size_t)m0 * 1024 : x_s + (size_t)(m0 - MP) * 1024;
              f32x4 v[4][4]; float s[4];
#pragma unroll
              for (int r = 0; r < 4; ++r)
#pragma unroll
                  for (int j = 0; j < 4; ++j) v[r][j] = ((const f32x4*)(xr + r * 1024))[lane + 64 * j];
#pragma unroll
              for (int r = 0; r < 4; ++r) { s[r] = 0.f;
#pragma unroll
                  for (int j = 0; j < 4; ++j) s[r] += (v[r][j].x * v[r][j].x + v[r][j].y * v[r][j].y) + (v[r][j].z * v[r][j].z + v[r][j].w * v[r][j].w); }
#pragma unroll
              for (int r = 0; r < 4; ++r) { const float rstd = rsqrtf(wave_sum(s[r]) * (1.f / 1024.f) + EPSN);
                  unsigned long long* o8 = (unsigned long long*)(HB + (size_t)(m0 + r) * 1024) + lane;
#pragma unroll
                  for (int j = 0; j < 4; ++j) { const f32x4 y = v[r][j] * rstd * gv[j]; o8[64 * j] = (unsigned long long)pk2(y.x, y.y) | ((unsigned long long)pk2(y.z, y.w) << 32); } } } }
    }
    grid.sync();

    PH(1) { pg8::Gemm g{HB, W1, MTOT, 2 * DFF, 1024, 0, 0}; pg8::StaticOrder S; S.init(MTOT, 2 * DFF, G, bx);
      pg8::EpiGateUp<false> E{ACT, DFF, nullptr};
      pg8::gemm_phase<pg8::EpiGateUp<false>, pg8::StaticOrder, true, true>(ldsp, g, S, E); }
    xcd_barrier(xbar);
    PH(2) { pg8::Gemm g{ACT, WD1, MTOT, 1024, DFF, 0, 0}; pg8::StaticOrder S; S.init(MTOT, 1024, G, bx);
      pg8::EpiResid<true> E{x_p, x_s, HB, SS, 0.5f};
      pg8::gemm_phase<pg8::EpiResid<true>, pg8::StaticOrder, true, true>(ldsp, g, S, E); }
    xcd_barrier(xbar);
    PH(3) { pg8::Gemm g{HB, WIN, MTOT, INW, 1024, 0, 0}; pg8::StaticOrder S; S.init(MTOT, INW, G, bx);
      pg8::EpiWin E{SS, (const float*)(ws + WS_GQK), ws, attn_body::C2};
      pg8::gemm_phase<pg8::EpiWin, pg8::StaticOrder, true, true>(ldsp, g, S, E); }
    xcd_barrier(xbar);
    PH(4) {
      for (int wi = gw; wi < MTOT; wi += NGW) { const int grp = wi & 3, row = (wi >> 2) * 4 + (lane >> 4), ch = grp * 16 + (lane & 15);
          if (grp == 0) pool_item<2>(Zb, PL, row, ch); else if (grp == 1) pool_item<4>(Zb, PL, row, ch); else if (grp == 2) pool_item<8>(Zb, PL, row, ch); else pool_item<16>(Zb, PL, row, ch); }
      asm volatile("s_waitcnt vmcnt(0)" ::: "memory"); __syncthreads();
      const attn_body::AttnTensors AT{(const attn_body::bf16*)QO, (const attn_body::bf16*)KB, (const attn_body::bf16*)VB, (attn_body::bf16*)QO};
      attn_body::attn_phase<8>((char*)lds, AT, vcu, G); }
    xcd_barrier(xbar);
    PH(5) { for (int idx = gt; idx < MTOT * 32; idx += NGT) { const int row = idx >> 5, ch = idx & 31; const float* pr = (row < MP ? p_p + (size_t)row * PLE : p_s + (size_t)(row - MP) * PLE) + ch * 8;
          const f32x4 a = *(const f32x4*)pr, b = *(const f32x4*)(pr + 4); v4u o; o.x = pk2(a.x, a.y); o.y = pk2(a.z, a.w); o.z = pk2(b.x, b.y); o.w = pk2(b.z, b.w);
          *(v4u*)(PB + (size_t)row * PLE + ch * 8) = o; }
      asm volatile("s_waitcnt vmcnt(0)" ::: "memory"); __syncthreads();
      pg8::SegOrder S; S.init(MTOT, 1024, G, bx);
      { pg8::Gemm g{QO, WUA, MTOT, 1024, 512, (long)((const char*)PL - (const char*)QO), (long)((const char*)WPC - (const char*)WUA)}; pg8::EpiGateMix E{MX, SGB}; pg8::gemm_phase<pg8::EpiGateMix, pg8::SegOrder, true, true>(ldsp, g, S, E); } }
    xcd_barrier(xbar);
    PH(6) { pg8::StaticOrder S; S.init(MTOT, 1024, G, bx);
      { pg8::Gemm g{MX, WOUT, MTOT, 1024, 1024, 0, 0}; pg8::EpiResid<false> E{nullptr, nullptr, HB, SS, 1.0f}; pg8::gemm_phase<pg8::EpiResid<false>, pg8::StaticOrder, true, true>(ldsp, g, S, E); }
 }
    asm volatile("s_waitcnt vmcnt(0)" ::: "memory"); __syncthreads();
    PH(6) { pg8::Gemm g{PB, WPP, MTOT, 1024, PLE, 0, 0}; pg8::StaticOrder S; S.init(MTOT, 1024, G, bx); pg8::EpiE E{EB, SSE};
      pg8::gemm_phase<pg8::EpiE, pg8::StaticOrder, true, true>(ldsp, g, S, E); }
    xcd_barrier(xbar);
    PH(7) { pg8::Gemm g{HB, W2, MTOT, 2 * DFF, 1024, 0, 0}; pg8::StaticOrder S; S.init(MTOT, 2 * DFF, G, bx);
      pg8::EpiGateUp<true> E{ACT, DFF, SS};
      pg8::gemm_phase<pg8::EpiGateUp<true>, pg8::StaticOrder, true, true>(ldsp, g, S, E); }
    xcd_barrier(xbar);
    PH(8) { pg8::Gemm g{ACT, WD2, MTOT, 1024, DFF, 0, 0}; pg8::StaticOrder S; S.init(MTOT, 1024, G, bx);
      pg8::EpiResid<false> E{nullptr, nullptr, HB, SS, 0.5f};
      pg8::gemm_phase<pg8::EpiResid<false>, pg8::StaticOrder, true, true>(ldsp, g, S, E); }
    xcd_barrier(xbar);
    PH(9) { pg8::Gemm g{HB, WPG, MTOT, 1024, 1024, 0, 0}; pg8::StaticOrder S; S.init(MTOT, 1024, G, bx);
      pg8::EpiFinal E{out, HB, EB, SS, SSE, args.in[24]};
      pg8::gemm_phase<pg8::EpiFinal, pg8::StaticOrder, true, true>(ldsp, g, S, E); }
}

extern "C" void kernel_launch(void* const* d_in, const int* in_sizes, int n_in, void* d_out, int out_size, void* d_ws, size_t ws_size, hipStream_t stream) {
    static int grid = 0;
    if (grid == 0) {
        if (n_in != 25 || out_size != MTOT * 1024 || ws_size < WS_END) { fprintf(stderr, "kernel_launch: unexpected problem (n_in %d, out %d, ws %zu); nothing launched\n", n_in, out_size, ws_size); grid = -1; return; }
        int dev = 0, cus = 0, per_cu = 0;
        if (hipGetDevice(&dev) != hipSuccess || hipDeviceGetAttribute(&cus, hipDeviceAttributeMultiprocessorCount, dev) != hipSuccess) { grid = -1; return; }
        if (hipFuncSetAttribute((const void*)fwd_mega, hipFuncAttributeMaxDynamicSharedMemorySize, LDS_BYTES) != hipSuccess) { fprintf(stderr, "kernel_launch: hipFuncSetAttribute failed\n"); grid = -1; return; }
        if (hipOccupancyMaxActiveBlocksPerMultiprocessor(&per_cu, (const void*)fwd_mega, NWAVES * 64, LDS_BYTES) != hipSuccess || per_cu < 1) { fprintf(stderr, "kernel_launch: occupancy query says %d blocks per CU\n", per_cu); (void)hipGetLastError(); }
        grid = cus;
    }
    if (grid < 0) return;
    if (hipMemsetAsync(d_ws, 0, 16384, stream) != hipSuccess) { fprintf(stderr, "kernel_launch: memset failed\n"); return; }
    Args a{};
    for (int i = 0; i < 25; ++i) a.in[i] = (const float*)d_in[i];
    a.out = (float*)d_out; a.ws = (unsigned char*)d_ws;
    void* kargs[] = {&a};
    const hipError_t e = hipLaunchCooperativeKernel((const void*)fwd_mega, dim3(grid), dim3(NWAVES * 64), kargs, LDS_BYTES, stream);
    if (e != hipSuccess) fprintf(stderr, "kernel_launch: cooperative launch failed: %s (grid %d)\n", hipGetErrorString(e), grid);
}
```

```cpp
#include <hip/hip_runtime.h>
#include <hip/hip_cooperative_groups.h>
#include <hip/hip_bf16.h>
#include <cstdio>
#include <cstdint>
#include <cmath>
namespace cg = cooperative_groups;

constexpr int DMODEL = 1024, MP = 4 * 8192, MS = 4 * 4096, MTOT = MP + MS;
constexpr int DFF = 2816, INW = 3328, PLE = 256;
constexpr float EPSN = 1e-6f;
constexpr size_t HK = 512u * 1024u;
constexpr size_t WS_GQK = 1 * HK;
constexpr size_t WS_SS = 2 * HK, WS_SSE = 8 * HK;
constexpr size_t WS_W1 = 16 * HK, WS_WD1 = 38 * HK, WS_WIN = 49 * HK, WS_WUA = 62 * HK, WS_WPC = 64 * HK, WS_WOUT = 66 * HK, WS_W2 = 70 * HK, WS_WD2 = 92 * HK, WS_WPG = 103 * HK, WS_WPP = 107 * HK;
constexpr size_t WS_HB = 112 * HK;
constexpr size_t WS_ACT = 304 * HK;
constexpr size_t WS_QO = WS_ACT, WS_Z = WS_ACT + 96 * HK, WS_PL = WS_ACT + 192 * HK, WS_MX = WS_ACT + 288 * HK, WS_K = WS_ACT + 480 * HK, WS_V = WS_ACT + 504 * HK, WS_PB = WS_K;
constexpr size_t WS_SGB = 832 * HK, WS_E = WS_SGB, WS_END = 1024 * HK;
static_assert(WS_WPP + 1024 * 256 * 2 <= WS_HB && WS_HB + (size_t)MTOT * 1024 * 2 <= WS_ACT && WS_ACT + (size_t)MTOT * DFF * 2 <= WS_SGB && WS_V + (size_t)MTOT * 128 * 2 <= WS_SGB && WS_SGB + (size_t)MTOT * 1024 * 2 <= WS_END, "d_ws map");
static_assert(WS_W1 + 5632 * 1024 * 2 <= WS_WD1 && WS_WD1 + 1024 * 2816 * 2 <= WS_WIN && WS_WIN + 3328 * 1024 * 2 <= WS_WUA && WS_W2 + 5632 * 1024 * 2 <= WS_WD2 && WS_WD2 + 1024 * 2816 * 2 <= WS_WPG && WS_WPG + 1024 * 1024 * 2 <= WS_WPP, "weights map");


namespace pg8 {
#define PG8_LAS __attribute__((address_space(3)))
typedef unsigned short bf16_t;
typedef short bf16x8 __attribute__((ext_vector_type(8)));
typedef float f32x4 __attribute__((ext_vector_type(4)));
typedef unsigned u32x4 __attribute__((ext_vector_type(4)));
#ifndef PG8_PFD
#define PG8_PFD 3
#endif
constexpr int PFD = PG8_PFD;
constexpr int BM = 256, BK = 64, HALF = 128, HTB = HALF * BK * 2  , STAGE_BYTES = 8 * HTB, NXCD = 8, WGM = 8;

__host__ __device__ __forceinline__ int lds_byte(int r, int c) { const int st = (r >> 4) * 2 + (c >> 5), rr = r & 15, cc = c & 31, ob = rr * 64 + cc * 2; return st * 1024 + (ob ^ (((ob >> 9) & 1) << 5)); }
__host__ __device__ __forceinline__ void stage_rc(int b, int& R, int& C) { const int st = b / 1024, sb = b % 1024, swz = sb ^ (((sb >> 9) & 1) << 5); R = (st >> 1) * 16 + swz / 64; C = (st & 1) * 32 + (swz % 64) / 2; }
__host__ __device__ __forceinline__ int perm32(int rho) { const int n = rho >> 4, i = rho & 15; return 8 * (i >> 2) + 4 * n + (i & 3); }

struct Unit { int pm, pn, seg; };
struct Gemm { const bf16_t* A; const bf16_t* Bt; int M, N, K; long dA, dB; };

struct StaticOrder {
    int nM, nN, nwg, G, c, rev;
    __host__ __device__ void init(int M, int N, int G_, int c_, int rev_ = 0) { nM = M / BM; nN = N / BM; nwg = nM * nN; G = G_; c = c_; rev = rev_; }
    __host__ __device__ bool next(int i, Unit& u) const {
        const int nr = (nwg - c + G - 1) / G; if (i >= nr) return false;
        const long L = (long)(rev ? nr - 1 - i : i) * G + c;
        int wgid = (int)L; { const int q = nwg / NXCD, r = nwg % NXCD, xcd = wgid % NXCD, off = wgid / NXCD; wgid = (xcd < r ? xcd * (q + 1) : r * (q + 1) + (xcd - r) * q) + off; }
        const int nig = WGM * nN, gid = wgid / nig, fm = gid * WGM, gsz = (nM - fm) < WGM ? (nM - fm) : WGM;
        u.pm = fm + ((wgid % nig) % gsz); u.pn = (wgid % nig) / gsz; u.seg = 0; return true;
    }
    __device__ __forceinline__ void a_ready(const Unit&) const {}
    __device__ __forceinline__ void done(const Unit&) const {}
};
struct SegOrder : StaticOrder {
    __host__ __device__ bool next(int i, Unit& u) const { const bool ok = StaticOrder::next(i >> 1, u); u.seg = i & 1; return ok; }
};
__device__ __forceinline__ unsigned cvt_pk_bf16(float lo, float hi) { unsigned r; asm volatile("v_cvt_pk_bf16_f32 %0, %1, %2" : "=v"(r) : "v"(lo), "v"(hi)); return r; }
typedef unsigned u32x2 __attribute__((ext_vector_type(2)));
__device__ __forceinline__ float bf_lo(unsigned w) { return __uint_as_float(w << 16); }
__device__ __forceinline__ float bf_hi(unsigned w) { return __uint_as_float(w & 0xffff0000u); }
__device__ __forceinline__ float sigm(float x) { return __builtin_amdgcn_rcpf(1.0f + __builtin_amdgcn_exp2f(-1.4426950408889634f * x)); }
__device__ __forceinline__ float row_rstd(const float* ss, int row) {
    const f32x4* p = (const f32x4*)(ss + (size_t)row * 16);
    const f32x4 a = p[0], b = p[1], c = p[2], d = p[3];
    const float s = (((a.x + a.y) + (a.z + a.w)) + ((b.x + b.y) + (b.z + b.w))) + (((c.x + c.y) + (c.z + c.w)) + ((d.x + d.y) + (d.z + d.w)));
    return rsqrtf(s * (1.0f / 1024.0f) + EPSN);
}

__device__ __forceinline__ void load_rstd8(const float* ss, int row0, int fq, float (&rs)[2][4]) {
    f32x4 pv[2][4];
#pragma unroll
    for (int ai = 0; ai < 2; ++ai)
#pragma unroll
        for (int m = 0; m < 4; ++m) pv[ai][m] = *(const f32x4*)(ss + (size_t)(row0 + ai * HALF + m * 16) * 16 + 4 * fq);
#pragma unroll
    for (int ai = 0; ai < 2; ++ai)
#pragma unroll
        for (int m = 0; m < 4; ++m) { float s = (pv[ai][m].x + pv[ai][m].y) + (pv[ai][m].z + pv[ai][m].w); s += __shfl_xor(s, 16); s += __shfl_xor(s, 32); rs[ai][m] = rsqrtf(s * (1.0f / 1024.0f) + EPSN); }
}

template <bool ROWSCALE> struct EpiGateUp {
    static constexpr bool PERM = true, AFTER_DRAIN = false, SEG = false; static constexpr int NST = ROWSCALE ? 12 : 6;
    bf16_t* O; int ldc; const float* ss;
    __device__ __forceinline__ void operator()(const f32x4 (&acc)[2][2][4][2], const Unit& u, int wr, int wc, int fr, int fq) const {
        const int row0 = u.pm * BM + wr * 64 + fr, col0 = u.pn * HALF + wc * 32 + 8 * fq;
        float rs[2][4];
        if (ROWSCALE) load_rstd8(ss, row0, fq, rs);
#pragma unroll
        for (int ai = 0; ai < 2; ++ai)
#pragma unroll
            for (int m = 0; m < 4; ++m) { const int row = row0 + ai * HALF + m * 16; const float r = ROWSCALE ? rs[ai][m] : 1.0f;
                typedef float f32x2 __attribute__((ext_vector_type(2)));
                const float nk = -1.4426950408889634f * r, r2 = r * r; unsigned wv[4];
#pragma unroll
                for (int n = 0; n < 2; ++n)
#pragma unroll
                    for (int e = 0; e < 4; e += 2) { const f32x2 g = (f32x2){acc[ai][0][m][n][e], acc[ai][0][m][n][e + 1]}, up = (f32x2){acc[ai][1][m][n][e], acc[ai][1][m][n][e + 1]};
                        const f32x2 t = g * nk; f32x2 ex; ex.x = __builtin_amdgcn_exp2f(t.x); ex.y = __builtin_amdgcn_exp2f(t.y);
                        const f32x2 d = ex + 1.0f; f32x2 q; q.x = __builtin_amdgcn_rcpf(d.x); q.y = __builtin_amdgcn_rcpf(d.y);
                        f32x2 o = (g * up) * q; if (ROWSCALE) o = o * r2;
                        wv[n * 2 + (e >> 1)] = cvt_pk_bf16(o.x, o.y); }
                u32x4 w; w.x = wv[0]; w.y = wv[1]; w.z = wv[2]; w.w = wv[3];
                *(u32x4*)(O + (size_t)row * ldc + col0) = w; }
    }
};

template <bool F32BASE> struct EpiResid {
    static constexpr bool PERM = true, AFTER_DRAIN = false, SEG = false; static constexpr int NST = F32BASE ? 40 : 30;
    const float* base0; const float* base1; bf16_t* hb; float* ss; float alpha;
    __device__ __forceinline__ void operator()(const f32x4 (&acc)[2][2][4][2], const Unit& u, int wr, int wc, int fr, int fq) const {
        const int row0 = u.pm * BM + wr * 64 + fr, col0 = u.pn * BM + wc * 32 + 8 * fq;
#pragma unroll
        for (int ai = 0; ai < 2; ++ai) {
            f32x4 b[4][2][2];
#pragma unroll
            for (int m = 0; m < 4; ++m) { const int row = row0 + ai * HALF + m * 16;
#pragma unroll
                for (int bj = 0; bj < 2; ++bj) {
                    if (F32BASE) { const float* bp = (row < MP ? base0 + (size_t)row * DMODEL : base1 + (size_t)(row - MP) * DMODEL) + col0 + bj * HALF; b[m][bj][0] = *(const f32x4*)bp; b[m][bj][1] = *(const f32x4*)(bp + 4); }
                    else { const u32x4 w = *(const u32x4*)(hb + (size_t)row * DMODEL + col0 + bj * HALF); b[m][bj][0] = __builtin_bit_cast(f32x4, w); } } }
            asm volatile("" ::: "memory");
#pragma unroll
            for (int m = 0; m < 4; ++m) { const int row = row0 + ai * HALF + m * 16; const size_t off = (size_t)row * DMODEL + col0; float s = 0.f;
#pragma unroll
                for (int bj = 0; bj < 2; ++bj) { const f32x4 c0 = acc[ai][bj][m][0], c1 = acc[ai][bj][m][1]; f32x4 b0, b1;
                    if (F32BASE) { b0 = b[m][bj][0]; b1 = b[m][bj][1]; }
                    else { const u32x4 w = __builtin_bit_cast(u32x4, b[m][bj][0]); b0 = (f32x4){bf_lo(w.x), bf_hi(w.x), bf_lo(w.y), bf_hi(w.y)}; b1 = (f32x4){bf_lo(w.z), bf_hi(w.z), bf_lo(w.w), bf_hi(w.w)}; }
                    const f32x4 v0 = b0 + c0 * alpha, v1 = b1 + c1 * alpha;
                    s += ((v0.x * v0.x + v0.y * v0.y) + (v0.z * v0.z + v0.w * v0.w)) + ((v1.x * v1.x + v1.y * v1.y) + (v1.z * v1.z + v1.w * v1.w));
                    u32x4 o; o.x = cvt_pk_bf16(v0.x, v0.y); o.y = cvt_pk_bf16(v0.z, v0.w); o.z = cvt_pk_bf16(v1.x, v1.y); o.w = cvt_pk_bf16(v1.z, v1.w);
                    *(u32x4*)(hb + off + bj * HALF) = o; }
                s += __shfl_xor(s, 16); s += __shfl_xor(s, 32);
                if (fq == 0) ss[(size_t)row * 16 + u.pn * 4 + wc] = s; }
            asm volatile("" ::: "memory"); }
    }
};

struct EpiWin {
    static constexpr bool PERM = false, AFTER_DRAIN = false, SEG = false; static constexpr int NST = 30;
    const float* ss; const float* gqk; unsigned char* ws; float qscale;
    __device__ __forceinline__ void operator()(const f32x4 (&acc)[2][2][4][2], const Unit& u, int wr, int wc, int fr, int fq) const {
        const int row0 = u.pm * BM + wr * 64 + fr;
        const int pn = u.pn;
        const bool is_rope = (pn < 2) || (pn == 2 && wc < 2);
        float rs[2][4];
        load_rstd8(ss, row0, fq, rs);
        if (is_rope) {
            const float* g = gqk + ((pn < 2) ? 0 : 64); const float osc = (pn < 2) ? qscale : 1.0f;
            bf16_t* dst = (bf16_t*)(ws + ((pn < 2) ? (WS_QO + (size_t)(pn * 4 + wc) * 128) : (WS_K + (size_t)wc * 128))); const int ld = (pn < 2) ? 512 : 128;
            f32x4 gv[2][2]; float inv[4];
#pragma unroll
            for (int bj = 0; bj < 2; ++bj)
#pragma unroll
                for (int n = 0; n < 2; ++n) gv[bj][n] = *(const f32x4*)(g + bj * 32 + n * 16 + 4 * fq);
#pragma unroll
            for (int e = 0; e < 4; ++e) inv[e] = __builtin_amdgcn_exp2f(-(float)(4 * fq + e) * 0.8304820237218406f);
#pragma unroll
            for (int m = 0; m < 4; ++m)
#pragma unroll
                for (int ai = 0; ai < 2; ++ai) { const int row = row0 + ai * HALF + m * 16;
                    int t = row < MP ? (row & 8191) : ((row - MP) & 4095); asm volatile("" : "+v"(t));
                    float s = 0.f;
#pragma unroll
                    for (int bj = 0; bj < 2; ++bj)
#pragma unroll
                        for (int n = 0; n < 2; ++n) { const f32x4 a = acc[ai][bj][m][n]; s += (a.x * a.x + a.y * a.y) + (a.z * a.z + a.w * a.w); }
                    s += __shfl_xor(s, 16); s += __shfl_xor(s, 32);
                    const float rr = rs[ai][m];
                    s *= rr * rr;
                    const float r = rsqrtf(s * (1.0f / 64.0f) + EPSN) * rr * osc;
#pragma unroll
                    for (int bj = 0; bj < 2; ++bj) { const float pos = (float)(bj == 0 ? (t >> 6) : (t & 63));
                        const f32x4 x1 = acc[ai][bj][m][0] * r * gv[bj][0], x2 = acc[ai][bj][m][1] * r * gv[bj][1]; f32x4 o1, o2;
#pragma unroll
                        for (int e = 0; e < 4; ++e) { const float ang = pos * inv[e]; const float c = __cosf(ang), sn = __sinf(ang); o1[e] = x1[e] * c - x2[e] * sn; o2[e] = x2[e] * c + x1[e] * sn; }
                        u32x2 w1, w2; w1.x = cvt_pk_bf16(o1.x, o1.y); w1.y = cvt_pk_bf16(o1.z, o1.w); w2.x = cvt_pk_bf16(o2.x, o2.y); w2.y = cvt_pk_bf16(o2.z, o2.w);
                        bf16_t* p = dst + (size_t)row * ld + bj * 32 + 4 * fq; *(u32x2*)p = w1; *(u32x2*)(p + 16) = w2; }
                    __builtin_amdgcn_sched_barrier(0); }
        } else if (pn == 2) {
            bf16_t* dst = (bf16_t*)(ws + WS_V) + (wc - 2) * 64 + 4 * fq;
#pragma unroll
            for (int ai = 0; ai < 2; ++ai)
#pragma unroll
                for (int m = 0; m < 4; ++m) { const int row = row0 + ai * HALF + m * 16; const float r = rs[ai][m];
#pragma unroll
                    for (int bj = 0; bj < 2; ++bj)
#pragma unroll
                        for (int n = 0; n < 2; ++n) { const f32x4 v = acc[ai][bj][m][n] * r; u32x2 w; w.x = cvt_pk_bf16(v.x, v.y); w.y = cvt_pk_bf16(v.z, v.w); *(u32x2*)(dst + (size_t)row * 128 + bj * 32 + n * 16) = w; } }
        } else {
            const bool sg = pn >= 5; const int ld = sg ? 1024 : 512; const int ct = pn < 5 ? pn - 3 : (pn < 9 ? pn - 5 : pn - 9);
            bf16_t* dst = (bf16_t*)(ws + (pn < 5 ? WS_Z : (pn < 9 ? WS_MX : WS_SGB))) + ct * 256 + wc * 32 + 4 * fq;
#pragma unroll
            for (int ai = 0; ai < 2; ++ai)
#pragma unroll
                for (int m = 0; m < 4; ++m) { const int row = row0 + ai * HALF + m * 16; const float r = rs[ai][m];
#pragma unroll
                    for (int bj = 0; bj < 2; ++bj)
#pragma unroll
                        for (int n = 0; n < 2; ++n) { f32x4 v = acc[ai][bj][m][n] * r; if (sg) { v.x = sigm(v.x); v.y = sigm(v.y); v.z = sigm(v.z); v.w = sigm(v.w); }
                            u32x2 w; w.x = cvt_pk_bf16(v.x, v.y); w.y = cvt_pk_bf16(v.z, v.w); *(u32x2*)(dst + (size_t)row * ld + bj * HALF + n * 16) = w; } }
        }
    }
};

struct EpiGateMix {
    static constexpr bool PERM = true, AFTER_DRAIN = false, SEG = true; static constexpr int NST = 24;
    bf16_t* Mx; const bf16_t* SGB;
    __device__ __forceinline__ void operator()(f32x4 (&acc)[2][2][4][2], const Unit& u, int wr, int wc, int fr, int fq) const {
        const int row0 = u.pm * BM + wr * 64 + fr, col0 = u.pn * BM + wc * 32 + 8 * fq;
#pragma unroll
        for (int ai = 0; ai < 2; ++ai) {
            u32x4 gw[4][2], aw[4][2];
#pragma unroll
            for (int m = 0; m < 4; ++m)
#pragma unroll
                for (int bj = 0; bj < 2; ++bj) { const size_t off = (size_t)(row0 + ai * HALF + m * 16) * DMODEL + col0 + bj * HALF; gw[m][bj] = *(const u32x4*)(SGB + off); if (u.seg == 0) aw[m][bj] = *(const u32x4*)(Mx + off); }
            asm volatile("" ::: "memory");
#pragma unroll
            for (int m = 0; m < 4; ++m)
#pragma unroll
                for (int bj = 0; bj < 2; ++bj) { const size_t off = (size_t)(row0 + ai * HALF + m * 16) * DMODEL + col0 + bj * HALF; const u32x4 g = gw[m][bj];
                    const f32x4 g0 = (f32x4){bf_lo(g.x), bf_hi(g.x), bf_lo(g.y), bf_hi(g.y)}, g1 = (f32x4){bf_lo(g.z), bf_hi(g.z), bf_lo(g.w), bf_hi(g.w)};
                    if (u.seg == 0) { const u32x4 a = aw[m][bj];
                        const f32x4 a0 = (f32x4){bf_lo(a.x), bf_hi(a.x), bf_lo(a.y), bf_hi(a.y)}, a1 = (f32x4){bf_lo(a.z), bf_hi(a.z), bf_lo(a.w), bf_hi(a.w)};
#pragma unroll
                        for (int e = 0; e < 4; ++e) { acc[ai][bj][m][0][e] *= a0[e] * __builtin_amdgcn_rcpf(g0[e]); acc[ai][bj][m][1][e] *= a1[e] * __builtin_amdgcn_rcpf(g1[e]); } }
                    else { const f32x4 v0 = acc[ai][bj][m][0] * g0, v1 = acc[ai][bj][m][1] * g1;
                        u32x4 w; w.x = cvt_pk_bf16(v0.x, v0.y); w.y = cvt_pk_bf16(v0.z, v0.w); w.z = cvt_pk_bf16(v1.x, v1.y); w.w = cvt_pk_bf16(v1.z, v1.w);
                        *(u32x4*)(Mx + off) = w; } }
            asm volatile("" ::: "memory"); }
    }
};

struct EpiE {
    static constexpr bool PERM = true, AFTER_DRAIN = false, SEG = false; static constexpr int NST = 16;
    bf16_t* E; float* ss;
    __device__ __forceinline__ void operator()(const f32x4 (&acc)[2][2][4][2], const Unit& u, int wr, int wc, int fr, int fq) const {
        const int row0 = u.pm * BM + wr * 64 + fr, col0 = u.pn * BM + wc * 32 + 8 * fq;
#pragma unroll
        for (int ai = 0; ai < 2; ++ai)
#pragma unroll
            for (int m = 0; m < 4; ++m) { const int row = row0 + ai * HALF + m * 16; float s = 0.f;
#pragma unroll
                for (int bj = 0; bj < 2; ++bj) { const f32x4 c0 = acc[ai][bj][m][0], c1 = acc[ai][bj][m][1];
                    s += ((c0.x * c0.x + c0.y * c0.y) + (c0.z * c0.z + c0.w * c0.w)) + ((c1.x * c1.x + c1.y * c1.y) + (c1.z * c1.z + c1.w * c1.w));
                    u32x4 w; w.x = cvt_pk_bf16(c0.x, c0.y); w.y = cvt_pk_bf16(c0.z, c0.w); w.z = cvt_pk_bf16(c1.x, c1.y); w.w = cvt_pk_bf16(c1.z, c1.w);
                    *(u32x4*)(E + (size_t)row * DMODEL + col0 + bj * HALF) = w; }
                s += __shfl_xor(s, 16); s += __shfl_xor(s, 32);
                if (fq == 0) ss[(size_t)row * 16 + u.pn * 4 + wc] = s; }
    }
};

struct EpiFinal {
    static constexpr bool PERM = true, AFTER_DRAIN = false, SEG = false; static constexpr int NST = 40;
    float* out; const bf16_t* hb; const bf16_t* E; const float* ss; const float* sse; const float* gpost;
    __device__ __forceinline__ void operator()(const f32x4 (&acc)[2][2][4][2], const Unit& u, int wr, int wc, int fr, int fq) const {
        const int row0 = u.pm * BM + wr * 64 + fr, col0 = u.pn * BM + wc * 32 + 8 * fq;
        f32x4 gv[2][2]; float rs[2][4], re[2][4];
#pragma unroll
        for (int bj = 0; bj < 2; ++bj)
#pragma unroll
            for (int n = 0; n < 2; ++n) gv[bj][n] = *(const f32x4*)(gpost + col0 + bj * HALF + n * 4);
        load_rstd8(ss, row0, fq, rs); load_rstd8(sse, row0, fq, re);
#pragma unroll
        for (int ai = 0; ai < 2; ++ai)
#pragma unroll
        for (int mp = 0; mp < 2; ++mp) {
            u32x4 hw[2][2], ew[2][2];
#pragma unroll
            for (int mm = 0; mm < 2; ++mm)
#pragma unroll
                for (int bj = 0; bj < 2; ++bj) { const size_t off = (size_t)(row0 + ai * HALF + (2 * mp + mm) * 16) * DMODEL + col0 + bj * HALF; hw[mm][bj] = *(const u32x4*)(hb + off); ew[mm][bj] = *(const u32x4*)(E + off); }
            asm volatile("" ::: "memory");
#pragma unroll
            for (int mm = 0; mm < 2; ++mm) { const int m = 2 * mp + mm; const float r = rs[ai][m], q = re[ai][m];
#pragma unroll
                for (int bj = 0; bj < 2; ++bj) { const size_t off = (size_t)(row0 + ai * HALF + m * 16) * DMODEL + col0 + bj * HALF; const u32x4 h = hw[mm][bj], ee = ew[mm][bj];
                    const f32x4 h0 = (f32x4){bf_lo(h.x), bf_hi(h.x), bf_lo(h.y), bf_hi(h.y)}, h1 = (f32x4){bf_lo(h.z), bf_hi(h.z), bf_lo(h.w), bf_hi(h.w)};
                    const f32x4 e0 = (f32x4){bf_lo(ee.x), bf_hi(ee.x), bf_lo(ee.y), bf_hi(ee.y)} * q * gv[bj][0], e1 = (f32x4){bf_lo(ee.z), bf_hi(ee.z), bf_lo(ee.w), bf_hi(ee.w)} * q * gv[bj][1];
                    const f32x4 a0 = acc[ai][bj][m][0] * r, a1 = acc[ai][bj][m][1] * r; f32x4 y0, y1;
#pragma unroll
                    for (int e = 0; e < 4; ++e) { y0[e] = h0[e] + sigm(a0[e]) * e0[e]; y1[e] = h1[e] + sigm(a1[e]) * e1[e]; }
                    *(f32x4*)(out + off) = y0; *(f32x4*)(out + off + 4) = y1; } }
            asm volatile("" ::: "memory"); }
    }
};

template <class Epi, class Sched, bool ALIGN_EPI = false, bool SP2 = false>
__device__ __forceinline__ void gemm_phase(PG8_LAS unsigned char* lds, const Gemm g, const Sched& S, const Epi& E) {
    int tid = threadIdx.x; asm volatile("" : "+v"(tid));
    const int wid = __builtin_amdgcn_readfirstlane(tid >> 6), lane = tid & 63, wr = wid >> 2, wc = wid & 3, fr = lane & 15, fq = lane >> 4;
    const int K = g.K, nt = K / BK;
    unsigned voffA[2], voffB[2];
#pragma unroll
    for (int i = 0; i < 2; ++i) { int R, C; stage_rc(tid * 16 + i * 8192, R, C); const int Rb = Epi::PERM ? ((R & ~31) + perm32(R & 31)) : R;
        voffA[i] = (unsigned)(R * K + C) * 2u; voffB[i] = (unsigned)(Rb * K + C) * 2u; }
    const size_t kstep = (size_t)(BK * 2);
    const size_t hstep = (size_t)HALF * K * 2;
    const size_t tstep = 2 * hstep;
    const unsigned ldsw = (unsigned)wid * 1024u;
    const int aoff = lds_byte(wr * 64 + fr, fq * 8), boff = lds_byte(wc * 32 + fr, fq * 8);
#define PG8_SA(b, h) (((b) * 2 + (h)) * HTB)
#define PG8_SB(b, h) ((4 + (b) * 2 + (h)) * HTB)
#ifndef PG8_B_AUX
#define PG8_B_AUX 0
#endif
#define PG8_STAGE_X(bufoff, gbase, voff, AUX) do { _Pragma("unroll") for (int _i = 0; _i < 2; ++_i) \
        __builtin_amdgcn_global_load_lds((const unsigned*)((const char*)(gbase) + (voff)[_i]), (PG8_LAS unsigned*)(lds + (bufoff) + ldsw + _i * 8192), 16, 0, AUX); } while (0)
#define PG8_STAGE(bufoff, gbase, voff) PG8_STAGE_X(bufoff, gbase, voff, 0)
#define PG8_LDA(dst, b, h) do { _Pragma("unroll") for (int m = 0; m < 4; ++m) _Pragma("unroll") for (int k = 0; k < 2; ++k) dst[m][k] = *(const PG8_LAS bf16x8*)(lds + PG8_SA(b, h) + aoff + m * 2048 + k * 1024); } while (0)
#define PG8_LDB(dst, b, h) do { _Pragma("unroll") for (int n = 0; n < 2; ++n) _Pragma("unroll") for (int k = 0; k < 2; ++k) dst[n][k] = *(const PG8_LAS bf16x8*)(lds + PG8_SB(b, h) + boff + n * 2048 + k * 1024); } while (0)
#define PG8_MMA(ai, bj, At, Bt) do { __builtin_amdgcn_s_setprio(1); _Pragma("unroll") for (int m = 0; m < 4; ++m) _Pragma("unroll") for (int n = 0; n < 2; ++n) _Pragma("unroll") for (int k = 0; k < 2; ++k) \
        acc[ai][bj][m][n] = __builtin_amdgcn_mfma_f32_16x16x32_bf16(Bt[n][k], At[m][k], acc[ai][bj][m][n], 0, 0, 0); __builtin_amdgcn_s_setprio(0); } while (0)
#define PG8_WAIT_V(n) asm volatile("s_waitcnt vmcnt(" #n ")" ::: "memory")
#define PG8_WAIT_L(n) asm volatile("s_waitcnt lgkmcnt(" #n ")" ::: "memory")
#define PG8_WAIT_VN(n) asm volatile("s_waitcnt vmcnt(%0)" :: "n"(n) : "memory")
#define PG8_BAR __builtin_amdgcn_s_barrier()
#define PG8_SCHED __builtin_amdgcn_sched_barrier(0)
    Unit cur, nxt; int ui = 0;
    if (!S.next(0, cur)) return;
    f32x4 acc[2][2][4][2];
#pragma unroll
    for (int a = 0; a < 2; ++a)
#pragma unroll
        for (int b = 0; b < 2; ++b)
#pragma unroll
            for (int m = 0; m < 4; ++m)
#pragma unroll
                for (int n = 0; n < 2; ++n) acc[a][b][m][n] = (f32x4){0.f, 0.f, 0.f, 0.f};
    bf16x8 At[4][2], B0[2][2], B1[2][2];
    const char* cA = (const char*)g.A + (size_t)cur.pm * tstep + (size_t)cur.seg * g.dA; const char* cB = (const char*)g.Bt + (size_t)cur.pn * tstep + (size_t)cur.seg * g.dB;
    S.a_ready(cur);
    if constexpr (SP2) {
        PG8_STAGE_X(PG8_SB(0, 0), cB, voffB, PG8_B_AUX); PG8_STAGE_X(PG8_SB(0, 1), cB + hstep, voffB, PG8_B_AUX); PG8_STAGE(PG8_SA(0, 0), cA, voffA); PG8_STAGE(PG8_SA(0, 1), cA + hstep, voffA);
        if (wr == 1) PG8_BAR;
        PG8_WAIT_V(2); PG8_BAR;
        PG8_STAGE_X(PG8_SB(1, 0), cB + kstep, voffB, PG8_B_AUX); PG8_STAGE(PG8_SA(1, 0), cA + kstep, voffA); PG8_STAGE_X(PG8_SB(1, 1), cB + hstep + kstep, voffB, PG8_B_AUX);
        PG8_WAIT_V(6); PG8_BAR;
    } else {
        PG8_STAGE_X(PG8_SB(0, 0), cB, voffB, PG8_B_AUX); PG8_STAGE(PG8_SA(0, 0), cA, voffA); PG8_STAGE_X(PG8_SB(0, 1), cB + hstep, voffB, PG8_B_AUX); PG8_STAGE(PG8_SA(0, 1), cA + hstep, voffA);
        if (wr == 1) PG8_BAR;
        PG8_WAIT_V(4); PG8_BAR;
        PG8_STAGE_X(PG8_SB(1, 0), cB + kstep, voffB, PG8_B_AUX); PG8_STAGE(PG8_SA(1, 0), cA + kstep, voffA); PG8_STAGE_X(PG8_SB(1, 1), cB + hstep + kstep, voffB, PG8_B_AUX);
        PG8_WAIT_V(6); PG8_BAR;
    }
    for (;;) {
        const bool has_next = S.next(ui + 1, nxt);
        const char* nA = has_next ? (const char*)g.A + (size_t)nxt.pm * tstep + (size_t)nxt.seg * g.dA : cA; const char* nB = has_next ? (const char*)g.Bt + (size_t)nxt.pn * tstep + (size_t)nxt.seg * g.dB : cB;
#pragma unroll 1
        for (int t = 0; t < nt; t += 2) {
            const bool last = (t == nt - 2);
            const char* a1 = cA + (size_t)(t + 1) * kstep;
            const char* a2 = last ? nA : cA + (size_t)(t + 2) * kstep; const char* b2 = last ? nB : cB + (size_t)(t + 2) * kstep;
            const char* a3 = a2 + kstep; const char* b3 = b2 + kstep;
            if (last && has_next) S.a_ready(nxt);
            if constexpr (SP2) {
            const bool after_epi = (t == 0) && (ui > 0);
            PG8_LDB(B0, 0, 0); PG8_LDB(B1, 0, 1); PG8_SCHED; PG8_LDA(At, 0, 0); PG8_STAGE(PG8_SA(1, 1), a1 + hstep, voffA);
            if (after_epi) { PG8_WAIT_VN(8 + Epi::NST); } else { PG8_WAIT_V(8); } PG8_WAIT_L(0); PG8_BAR; PG8_MMA(0, 0, At, B0); PG8_MMA(0, 1, At, B1); PG8_BAR; PG8_SCHED;
            PG8_LDA(At, 0, 1); PG8_STAGE_X(PG8_SB(0, 0), b2, voffB, PG8_B_AUX); PG8_STAGE_X(PG8_SB(0, 1), b2 + hstep, voffB, PG8_B_AUX); PG8_STAGE(PG8_SA(0, 0), a2, voffA);
            if (after_epi) { PG8_WAIT_VN(8 + Epi::NST); } else { PG8_WAIT_V(8); } PG8_WAIT_L(0); PG8_BAR; PG8_MMA(1, 0, At, B0); PG8_MMA(1, 1, At, B1); PG8_BAR; PG8_SCHED;
            PG8_LDB(B0, 1, 0); PG8_LDB(B1, 1, 1); PG8_SCHED; PG8_LDA(At, 1, 0); PG8_STAGE(PG8_SA(0, 1), a2 + hstep, voffA);
            PG8_WAIT_V(8); PG8_WAIT_L(0); PG8_BAR; PG8_MMA(0, 0, At, B0); PG8_MMA(0, 1, At, B1); PG8_BAR; PG8_SCHED;
            PG8_LDA(At, 1, 1); PG8_STAGE_X(PG8_SB(1, 0), b3, voffB, PG8_B_AUX); PG8_STAGE_X(PG8_SB(1, 1), b3 + hstep, voffB, PG8_B_AUX); PG8_STAGE(PG8_SA(1, 0), a3, voffA);
            PG8_WAIT_V(8); PG8_WAIT_L(0); PG8_BAR; PG8_MMA(1, 0, At, B0); PG8_MMA(1, 1, At, B1); PG8_BAR; PG8_SCHED;
            } else {
            PG8_LDB(B0, 0, 0); PG8_SCHED; PG8_LDA(At, 0, 0); PG8_STAGE(PG8_SA(1, 1), a1 + hstep, voffA);
            PG8_WAIT_L(8); PG8_BAR; PG8_WAIT_L(0); PG8_MMA(0, 0, At, B0); PG8_BAR; PG8_SCHED;
            PG8_LDB(B1, 0, 1); PG8_STAGE_X(PG8_SB(0, 0), b2, voffB, PG8_B_AUX);
            PG8_BAR; PG8_WAIT_L(0); PG8_MMA(0, 1, At, B1); PG8_BAR;
            PG8_LDA(At, 0, 1); PG8_STAGE(PG8_SA(0, 0), a2, voffA);
            PG8_BAR; PG8_WAIT_L(0); PG8_MMA(1, 0, At, B0); PG8_BAR; PG8_SCHED;
            PG8_STAGE_X(PG8_SB(0, 1), b2 + hstep, voffB, PG8_B_AUX);
            PG8_WAIT_V(6); PG8_BAR; PG8_MMA(1, 1, At, B1); PG8_BAR;
            PG8_LDB(B0, 1, 0); PG8_SCHED; PG8_LDA(At, 1, 0); PG8_STAGE(PG8_SA(0, 1), a2 + hstep, voffA);
            PG8_WAIT_L(8); PG8_BAR; PG8_WAIT_L(0); PG8_MMA(0, 0, At, B0); PG8_BAR; PG8_SCHED;
            PG8_LDB(B1, 1, 1); PG8_STAGE_X(PG8_SB(1, 0), b3, voffB, PG8_B_AUX);
            PG8_BAR; PG8_WAIT_L(0); PG8_MMA(0, 1, At, B1); PG8_BAR;
            PG8_LDA(At, 1, 1); PG8_STAGE(PG8_SA(1, 0), a3, voffA);
            PG8_BAR; PG8_WAIT_L(0); PG8_MMA(1, 0, At, B0); PG8_BAR; PG8_SCHED;
            PG8_STAGE_X(PG8_SB(1, 1), b3 + hstep, voffB, PG8_B_AUX);
            PG8_WAIT_V(6); PG8_BAR; PG8_MMA(1, 1, At, B1); PG8_BAR;
            }
        }
        if constexpr (ALIGN_EPI) { if (wr == 0) PG8_BAR; }
        if constexpr (!Epi::AFTER_DRAIN) { E(acc, cur, wr, wc, fr, fq); S.done(cur); }
        if (!has_next) break;
        if (!(Epi::SEG && cur.seg == 0))
#pragma unroll
        for (int a = 0; a < 2; ++a)
#pragma unroll
            for (int b = 0; b < 2; ++b)
#pragma unroll
                for (int m = 0; m < 4; ++m)
#pragma unroll
                    for (int n = 0; n < 2; ++n) acc[a][b][m][n] = (f32x4){0.f, 0.f, 0.f, 0.f};
        cur = nxt; cA = nA; cB = nB; ++ui;
        if constexpr (ALIGN_EPI) { if (wr == 1) PG8_BAR; }
    }
    PG8_WAIT_V(0);
    if constexpr (!ALIGN_EPI) { if (wr == 0) PG8_BAR; }
    PG8_BAR;
    if constexpr (Epi::AFTER_DRAIN) { E.fused(acc, cur, wr, wc, fr, fq, lds, wid, lane); S.done(cur); }
#undef PG8_SA
#undef PG8_SB
#undef PG8_STAGE
#undef PG8_STAGE_X
#undef PG8_LDA
#undef PG8_LDB
#undef PG8_MMA
#undef PG8_WAIT_V
#undef PG8_WAIT_L
#undef PG8_WAIT_VN
#undef PG8_BAR
#undef PG8_SCHED
}
}
#include <hip/hip_bf16.h>
#include <cmath>
namespace attn_body {
using bf16=__hip_bfloat16;
using bf16x8=__attribute__((ext_vector_type(8)))short;
using s16x4=__attribute__((ext_vector_type(4)))short;
using f32x16=__attribute__((ext_vector_type(16)))float;
using u32x4=__attribute__((ext_vector_type(4)))unsigned;
constexpr int D=64,QP=512,KP=128;
constexpr int NW=8,QBLK=32,QB=QBLK*NW,KVBLK=64;
constexpr int ATTN_UNIT_ROWS=QB;
__device__ __forceinline__ int crow(int r,int hi){return (r&3)+8*(r>>2)+4*hi;}
#define SBAR() __builtin_amdgcn_sched_barrier(0)
__device__ __forceinline__ void cmask(f32x16&p0,f32x16&p1,int jb,int qrel,int hi){
  const float NEG=-INFINITY; int kb=64*jb+4*hi;
  #pragma unroll
  for(int r=0;r<16;++r){int kv=kb+(r&3)+8*(r>>2); if(kv>qrel)p0[r]=NEG; if(kv+32>qrel)p1[r]=NEG;}
}

constexpr int NSLOT=3, SLOTB=8192;
constexpr int LDS_K=0, LDS_V=NSLOT*SLOTB, LDS_WS=2*NSLOT*SLOTB, LDS_OST=LDS_WS+NW*64*4, LDS_BYTES=LDS_OST+NW*4096;
constexpr float C2=0.125f*1.4426950408889634f;
__device__ __forceinline__ void glds16(const void*gsrc,unsigned lds_dst){unsigned keep;
  asm volatile("s_mov_b32 %0, m0\n\ts_mov_b32 m0, %2\n\ts_nop 0\n\tglobal_load_lds_dwordx4 %1, off\n\ts_mov_b32 m0, %0":"=&s"(keep):"v"(gsrc),"s"(lds_dst):"memory");}
__device__ __forceinline__ float max3f(float a,float b,float c){float r;asm("v_max3_f32 %0, %1, %2, %3":"=v"(r):"v"(a),"v"(b),"v"(c));return r;}
__device__ __forceinline__ float max2f(float a,float b){float r;asm("v_max_f32_e32 %0, %1, %2":"=v"(r):"v"(a),"v"(b));return r;}
__device__ __forceinline__ float fadd_s(float a,float b){float r;asm("v_add_f32_e32 %0, %1, %2":"=v"(r):"v"(a),"v"(b));return r;}
__device__ __forceinline__ float fsub_s(float a,float b){float r;asm("v_sub_f32_e32 %0, %1, %2":"=v"(r):"v"(a),"v"(b));return r;}
typedef float f32x2_t __attribute__((ext_vector_type(2))); typedef __bf16 bf16x2_t __attribute__((ext_vector_type(2)));
__device__ __forceinline__ unsigned cvtpk_s(float lo,float hi){f32x2_t v={lo,hi};bf16x2_t b=__builtin_convertvector(v,bf16x2_t);return __builtin_bit_cast(unsigned,b);}
#define WAIT_BAR(N) asm volatile("s_waitcnt vmcnt(" #N ") lgkmcnt(0)\n\ts_barrier":::"memory")

__device__ __forceinline__ void qkt(f32x16&p0,f32x16&p1,const char*Kslot,const bf16x8*qr,const f32x16&negm,int r32,int hi){
  const char*kb=Kslot+hi*1024+r32*16;
  #pragma unroll
  for(int d0=0;d0<4;++d0){
    const bf16x8 b0=*reinterpret_cast<const bf16x8*>(kb+d0*2048);
    const bf16x8 b1=*reinterpret_cast<const bf16x8*>(kb+d0*2048+512);
    if(d0==0){p0=__builtin_amdgcn_mfma_f32_32x32x16_bf16(b0,qr[0],negm,0,0,0);p1=__builtin_amdgcn_mfma_f32_32x32x16_bf16(b1,qr[0],negm,0,0,0);}
    else{p0=__builtin_amdgcn_mfma_f32_32x32x16_bf16(b0,qr[d0],p0,0,0,0);p1=__builtin_amdgcn_mfma_f32_32x32x16_bf16(b1,qr[d0],p1,0,0,0);}}
}
typedef __attribute__((address_space(3))) const char* lds_cptr;
typedef short v4i16_t __attribute__((ext_vector_type(4)));
__device__ __forceinline__ void kload8(bf16x8*kf,lds_cptr kp){
  kf[0]=*(const __attribute__((address_space(3))) bf16x8*)(kp);      kf[1]=*(const __attribute__((address_space(3))) bf16x8*)(kp+512);
  kf[2]=*(const __attribute__((address_space(3))) bf16x8*)(kp+2048); kf[3]=*(const __attribute__((address_space(3))) bf16x8*)(kp+2560);
  kf[4]=*(const __attribute__((address_space(3))) bf16x8*)(kp+4096); kf[5]=*(const __attribute__((address_space(3))) bf16x8*)(kp+4608);
  kf[6]=*(const __attribute__((address_space(3))) bf16x8*)(kp+6144); kf[7]=*(const __attribute__((address_space(3))) bf16x8*)(kp+6656);
}
__device__ __forceinline__ void kload2(bf16x8*kf,lds_cptr kp,int j){ kf[2*j]=*(const __attribute__((address_space(3))) bf16x8*)(kp+j*2048); kf[2*j+1]=*(const __attribute__((address_space(3))) bf16x8*)(kp+j*2048+512); }
__device__ __forceinline__ s16x4 vtr(lds_cptr p){ return __builtin_bit_cast(s16x4,__builtin_amdgcn_ds_read_tr16_b64_v4i16((__attribute__((address_space(3))) v4i16_t*)p)); }
__device__ __forceinline__ float rowmax(const f32x16&p0,const f32x16&p1){
  float a=max3f(p0[0],p0[1],p1[0]),b=max3f(p0[2],p0[3],p1[1]);a=max3f(a,p1[2],p1[3]);
  #pragma unroll
  for(int r=4;r<16;r+=4){a=max3f(a,p0[r],p0[r+1]);b=max3f(b,p0[r+2],p0[r+3]);a=max3f(a,p1[r],p1[r+1]);b=max3f(b,p1[r+2],p1[r+3]);}
  const float m=max2f(a,b);
  auto rr=__builtin_amdgcn_permlane32_swap(__float_as_uint(m),__float_as_uint(m),false,false);
  return max2f(__uint_as_float(rr[0]),__uint_as_float(rr[1]));
}
__device__ __forceinline__ void pv(f32x16*o,int vb,bf16x8 pa0,bf16x8 pa1,bf16x8 pa2,bf16x8 pa3){
  #pragma unroll
  for(int d0=0;d0<2;++d0){s16x4 lo[4],hi[4];
    #pragma unroll
    for(int ks=0;ks<4;++ks){
      asm volatile("ds_read_b64_tr_b16 %0,%1 offset:%c2":"=&v"(lo[ks]):"v"(vb),"i"(d0*4096+ks*1024):"memory");
      asm volatile("ds_read_b64_tr_b16 %0,%1 offset:%c2":"=&v"(hi[ks]):"v"(vb),"i"(d0*4096+ks*1024+512):"memory");}
    asm volatile("s_waitcnt lgkmcnt(0)":::"memory");SBAR();
    #define PK(k) (bf16x8){lo[k][0],lo[k][1],lo[k][2],lo[k][3],hi[k][0],hi[k][1],hi[k][2],hi[k][3]}
    o[d0]=__builtin_amdgcn_mfma_f32_32x32x16_bf16(pa0,PK(0),o[d0],0,0,0);
    o[d0]=__builtin_amdgcn_mfma_f32_32x32x16_bf16(pa1,PK(1),o[d0],0,0,0);
    o[d0]=__builtin_amdgcn_mfma_f32_32x32x16_bf16(pa2,PK(2),o[d0],0,0,0);
    o[d0]=__builtin_amdgcn_mfma_f32_32x32x16_bf16(pa3,PK(3),o[d0],0,0,0);
    #undef PK
  }
}

#ifndef ATTN_STORE16
#define ATTN_STORE16(p,v) (*(u32x4*)(p)=(v))
#endif
template<int THRL> __device__ __forceinline__ void attn_unit(long rowbase,int h,int qb,int NT,const bf16*Q,const bf16*__restrict__ K,const bf16*__restrict__ V,bf16*O,char*shm){
  int tid=threadIdx.x; asm volatile("":"+v"(tid)); const int lane=tid&63,r32=lane&31,hi=lane>>5; const int wid=__builtin_amdgcn_readfirstlane(tid>>6);
  const int q0=qb*QB;
  const bf16*Qw=Q+(rowbase+q0+wid*QBLK)*QP+h*D;
  const bf16*Kh=K+rowbase*KP+(h>>2)*D,*Vh=V+rowbase*KP+(h>>2)*D;
  const unsigned lds0=(unsigned)(uintptr_t)shm;
  float*wsf=(float*)(shm+LDS_WS)+wid*64;
  const bf16*ksrc=Kh+(long)lane*KP+wid*8;
  const bf16*vsrc=Vh+(long)(16*(wid&3)+(lane>>2))*KP+(wid>>2)*32+(lane&3)*8;
  const unsigned kdst=lds0+LDS_K+wid*1024, vdst=lds0+LDS_V+wid*1024;
  #define DMA_K(t,slot) glds16(ksrc+(long)(t)*KVBLK*KP,(unsigned)__builtin_amdgcn_readfirstlane(kdst+(slot)))
  #define DMA_V(t,slot) glds16(vsrc+(long)(t)*KVBLK*KP,(unsigned)__builtin_amdgcn_readfirstlane(vdst+(slot)))
  const int vb0=(int)(lds0+LDS_V)+((lane>>4)&1)*32+(lane&3)*8+(4*hi+((lane&15)>>2))*64;
  const char*Kbase=shm+LDS_K; bf16x8 kf[8];
  const lds_cptr shm3=(lds_cptr)shm; const lds_cptr kp0=shm3+LDS_K+hi*1024+r32*16; const lds_cptr vp0=shm3+LDS_V+((lane>>4)&1)*32+(lane&3)*8+(4*hi+((lane&15)>>2))*64;
  DMA_K(0,0);DMA_V(0,0);DMA_K(1,SLOTB);
  bf16x8 qr[4];
  #pragma unroll
  for(int d0=0;d0<4;++d0)qr[d0]=*reinterpret_cast<const bf16x8*>(&Qw[(long)r32*QP+d0*16+hi*8]);
  float mhat=0.f,l_reg=0.f;f32x16 o[2];o[0]=f32x16{};o[1]=f32x16{};f32x16 negm=f32x16{};asm volatile("":"+v"(negm));
    #define CMASK(P0,P1,t) do{}while(0)
  bool resc=false;
  #define START(P0,P1) do{ const float rm=rowmax(P0,P1); resc=false; \
    { const float dl=rm; mhat=fadd_s(mhat,dl); \
      _Pragma("unroll") for(int r=0;r<16;++r){P0[r]=fsub_s(P0[r],dl);P1[r]=fsub_s(P1[r],dl);} \
      _Pragma("unroll") for(int r=0;r<16;++r)negm[r]=-mhat; asm volatile("":"+v"(negm)); } \
    _Pragma("unroll") for(int r=0;r<16;++r)P0[r]=__builtin_amdgcn_exp2f(P0[r]); }while(0)
  #define RESC() do{ if(resc){ asm volatile("s_waitcnt lgkmcnt(0)":::"memory"); \
      _Pragma("unroll") for(int d_=0;d_<2;++d_) _Pragma("unroll") for(int r=0;r<16;++r)o[d_][r]*=wsf[crow(r,hi)]; } }while(0)
  f32x16 pA0,pA1,pB0,pB1;
  int sl_prev=0,sl_cur=0,sl_next=SLOTB;
  #define ROT() do{sl_prev=sl_cur;sl_cur=sl_next;sl_next=(sl_next==(NSLOT-1)*SLOTB)?0:sl_next+SLOTB;}while(0)
  DMA_K(2,2*SLOTB);
  WAIT_BAR(3);
  qkt(pA0,pA1,Kbase,qr,negm,r32,hi);asm volatile("s_nop 15\n\ts_nop 7":"+v"(pA0),"+v"(pA1));CMASK(pA0,pA1,0);
  START(pA0,pA1);
  _Pragma("unroll") for(int r=0;r<16;++r)pA1[r]=__builtin_amdgcn_exp2f(pA1[r]);
  WAIT_BAR(0);
  DMA_K(3,0);DMA_V(1,SLOTB);
  ROT();
  kload8(kf,kp0+sl_cur);
  WAIT_BAR(2);
  s16x4 vlo[8],vhi[8]; u32x4 pw0,pw1,pw2,pw3;
  #define PKW(P,B) cvtpk_s(P[B],P[B+1])
  #define PAF(k) __builtin_bit_cast(bf16x8,pw##k)
  #define VFR(i) (bf16x8){vlo[i][0],vlo[i][1],vlo[i][2],vlo[i][3],vhi[i][0],vhi[i][1],vhi[i][2],vhi[i][3]}
  #define PIN(x) asm volatile("":"+v"(x))
  #define MX3(a,b,c) __builtin_fmaxf(__builtin_fmaxf((a),(b)),(c))
  #define GAPA(MF,A0,A1,A2,A3,W0,W1,PW) do{ MF; sacc+=A0; sacc+=A1; sacc+=A2; sacc+=A3; PIN(sacc); W0; W1; PIN(PW); SBAR(); }while(0)
  #define EX(v) __builtin_amdgcn_exp2f(v)
  #define GAPB(MF,X,B) do{ MF; X[B]=EX(X[B]); X[B+1]=EX(X[B+1]); X[B+2]=EX(X[B+2]); X[B+3]=EX(X[B+3]); PIN(X); SBAR(); }while(0)
  #define VRD(i) do{ vlo[i]=vtr(vp_+(((i)>>2)*4096+((i)&3)*1024)); vhi[i]=vtr(vp_+(((i)>>2)*4096+((i)&3)*1024+512)); }while(0)
  #define KRD(G,j) do{ if(G){ kload2(kf,kp0+sl_next,j); SBAR(); } }while(0)
  #define STEP(C0,C1,P0,P1,t,GK,GV,GL) do{ SBAR(); \
    const lds_cptr vp_=vp0+sl_prev; \
    VRD(0); SBAR(); float sacc=(P0[0]+P0[1]); \
    GAPA(C0=__builtin_amdgcn_mfma_f32_32x32x16_bf16(kf[0],qr[0],negm,0,0,0), P0[2],P0[3],P0[4],P0[5],     pw0[0]=PKW(P0,0), pw0[1]=PKW(P0,2), pw0); \
    VRD(4); SBAR(); GAPA(C1=__builtin_amdgcn_mfma_f32_32x32x16_bf16(kf[1],qr[0],negm,0,0,0), P0[6],P0[7],P0[8],P0[9],     pw0[2]=PKW(P0,4), pw0[3]=PKW(P0,6), pw0); \
    VRD(1); SBAR(); GAPA(C0=__builtin_amdgcn_mfma_f32_32x32x16_bf16(kf[2],qr[1],C0,0,0,0),   P0[10],P0[11],P0[12],P0[13], pw1[0]=PKW(P0,8), pw1[1]=PKW(P0,10), pw1); \
    VRD(5); SBAR(); GAPA(C1=__builtin_amdgcn_mfma_f32_32x32x16_bf16(kf[3],qr[1],C1,0,0,0),   P0[14],P0[15],P1[0],P1[1],   pw1[2]=PKW(P0,12),pw1[3]=PKW(P0,14), pw1); \
    VRD(2); SBAR(); GAPA(C0=__builtin_amdgcn_mfma_f32_32x32x16_bf16(kf[4],qr[2],C0,0,0,0),   P1[2],P1[3],P1[4],P1[5],     pw2[0]=PKW(P1,0), pw2[1]=PKW(P1,2), pw2); \
    VRD(6); SBAR(); GAPA(C1=__builtin_amdgcn_mfma_f32_32x32x16_bf16(kf[5],qr[2],C1,0,0,0),   P1[6],P1[7],P1[8],P1[9],     pw2[2]=PKW(P1,4), pw2[3]=PKW(P1,6), pw2); \
    VRD(3); SBAR(); GAPA(C0=__builtin_amdgcn_mfma_f32_32x32x16_bf16(kf[6],qr[3],C0,0,0,0),   P1[10],P1[11],P1[12],P1[13], pw3[0]=PKW(P1,8), pw3[1]=PKW(P1,10), pw3); \
    VRD(7); SBAR(); GAPA(C1=__builtin_amdgcn_mfma_f32_32x32x16_bf16(kf[7],qr[3],C1,0,0,0),   P1[14],P1[15],0.f,0.f,       pw3[2]=PKW(P1,12),pw3[3]=PKW(P1,14), pw3); \
    l_reg+=sacc; \
    if(GK){DMA_K((t)+3,sl_cur);} if(GV){DMA_V((t)+1,sl_next);} \
    CMASK(C0,C1,t); \
    { float a=MX3(C0[0],C0[1],C1[0]),b=MX3(C0[2],C0[3],C1[1]); a=MX3(a,C1[2],C1[3]); \
      _Pragma("unroll") for(int r=4;r<16;r+=4){a=MX3(a,C0[r],C0[r+1]);b=MX3(b,C0[r+2],C0[r+3]);a=MX3(a,C1[r],C1[r+1]);b=MX3(b,C1[r+2],C1[r+3]);} \
      float rm=__builtin_fmaxf(a,b); { auto rr=__builtin_amdgcn_permlane32_swap(__float_as_uint(rm),__float_as_uint(rm),false,false); rm=__builtin_fmaxf(__uint_as_float(rr[0]),__uint_as_float(rr[1])); } \
      resc=false; \
      if(__builtin_expect(__any(rm>(float)THRL),0)){ const float dl=__builtin_fmaxf(rm,0.f); mhat+=dl; \
        _Pragma("unroll") for(int r=0;r<16;++r){C0[r]-=dl;C1[r]-=dl;} \
        _Pragma("unroll") for(int r=0;r<16;++r)negm[r]=-mhat; asm volatile("":"+v"(negm)); \
        const float f=__builtin_amdgcn_exp2f(-dl); l_reg*=f; if(hi==0)wsf[r32]=f; resc=true; } } \
    SBAR(); \
    GAPB(o[0]=__builtin_amdgcn_mfma_f32_32x32x16_bf16(PAF(0),VFR(0),o[0],0,0,0), C0,0); \
    GAPB(o[1]=__builtin_amdgcn_mfma_f32_32x32x16_bf16(PAF(0),VFR(4),o[1],0,0,0), C0,4); \
    KRD(GL,0); GAPB(o[0]=__builtin_amdgcn_mfma_f32_32x32x16_bf16(PAF(1),VFR(1),o[0],0,0,0), C0,8); \
    KRD(GL,1); GAPB(o[1]=__builtin_amdgcn_mfma_f32_32x32x16_bf16(PAF(1),VFR(5),o[1],0,0,0), C0,12); \
    KRD(GL,2); GAPB(o[0]=__builtin_amdgcn_mfma_f32_32x32x16_bf16(PAF(2),VFR(2),o[0],0,0,0), C1,0); \
    KRD(GL,3); GAPB(o[1]=__builtin_amdgcn_mfma_f32_32x32x16_bf16(PAF(2),VFR(6),o[1],0,0,0), C1,4); \
    GAPB(o[0]=__builtin_amdgcn_mfma_f32_32x32x16_bf16(PAF(3),VFR(3),o[0],0,0,0), C1,8); \
    GAPB(o[1]=__builtin_amdgcn_mfma_f32_32x32x16_bf16(PAF(3),VFR(7),o[1],0,0,0), C1,12); \
    }while(0)
  int t=1;
  #undef CMASK
  #define CMASK(P0,P1,t) do{}while(0)
  for(;t+5<NT;t+=2){
    STEP(pB0,pB1,pA0,pA1,t,true,true,true);     WAIT_BAR(2); RESC(); ROT();
    STEP(pA0,pA1,pB0,pB1,t+1,true,true,true);   WAIT_BAR(2); RESC(); ROT();
  }
  #undef CMASK
  #define CMASK(P0,P1,t) do{}while(0)
  #define ENDW(tt) do{ if((tt)+3<NT){WAIT_BAR(2);} else if((tt)+2<NT){WAIT_BAR(1);} else {WAIT_BAR(0);} }while(0)
  for(;t+1<NT;t+=2){
    STEP(pB0,pB1,pA0,pA1,t,(t+3<NT),(t+1<NT),(t+1<NT));       ENDW(t);   RESC(); ROT();
    STEP(pA0,pA1,pB0,pB1,t+1,(t+4<NT),(t+2<NT),(t+2<NT));     ENDW(t+1); RESC(); ROT();
  }
  STEP(pB0,pB1,pA0,pA1,NT-1,false,false,false); RESC();
  { float sacc=pB0[0]+pB0[1]; _Pragma("unroll") for(int r=2;r<16;++r)sacc+=pB0[r]; _Pragma("unroll") for(int r=0;r<16;++r)sacc+=pB1[r]; l_reg+=sacc;
    pw0=(u32x4){PKW(pB0,0),PKW(pB0,2),PKW(pB0,4),PKW(pB0,6)};pw1=(u32x4){PKW(pB0,8),PKW(pB0,10),PKW(pB0,12),PKW(pB0,14)};pw2=(u32x4){PKW(pB1,0),PKW(pB1,2),PKW(pB1,4),PKW(pB1,6)};pw3=(u32x4){PKW(pB1,8),PKW(pB1,10),PKW(pB1,12),PKW(pB1,14)};
    SBAR(); pv(o,vb0+sl_cur,PAF(0),PAF(1),PAF(2),PAF(3)); }
  #undef PKW
  #undef PAF
  #undef VFR
  #undef PIN
  #undef MX3
  #undef GAPA
  #undef GAPB
  #undef EX
  #undef VRD
  #undef KRD
  #undef STEP
  #undef ENDW
  {auto rr=__builtin_amdgcn_permlane32_swap(__float_as_uint(l_reg),__float_as_uint(l_reg),false,false);l_reg=__uint_as_float(rr[0])+__uint_as_float(rr[1]);}
  if(hi==0)wsf[32+r32]=l_reg;asm volatile("s_waitcnt lgkmcnt(0)":::"memory");
  float rli[16];
  #pragma unroll
  for(int r=0;r<16;++r)rli[r]=__builtin_amdgcn_rcpf(wsf[32+crow(r,hi)]);
  bf16*Ow=O+(rowbase+q0+wid*QBLK)*QP+h*D;
  { bf16*stg=(bf16*)(shm+LDS_OST)+wid*2048;
    #pragma unroll
    for(int r=0;r<16;++r){const int orow=crow(r,hi);
      #pragma unroll
      for(int d0=0;d0<2;++d0)stg[orow*64+d0*32+r32]=__float2bfloat16(o[d0][r]*rli[r]);}
    asm volatile("s_waitcnt lgkmcnt(0)":::"memory");
    #pragma unroll
    for(int i=0;i<4;++i){const int row=i*8+(lane>>3),ch=lane&7; const u32x4 v=*(const u32x4*)(stg+row*64+ch*8); ATTN_STORE16(Ow+(long)row*QP+ch*8,v);} }
  asm volatile("s_waitcnt lgkmcnt(0)\n\ts_barrier":::"memory");
  #undef DMA_K
  #undef DMA_V
  #undef CMASK
  #undef START
  #undef RESC
  #undef ROT
}
constexpr int ATTN_LDS_BYTES=LDS_BYTES;
struct AttnTensors { const bf16* Q; const bf16* K; const bf16* V; bf16* O; };
template<int THRL=8> __device__ __forceinline__ void attn_phase(char*lds,const AttnTensors&T,int vcu,int G){
  for(int i=0;;++i){
    int u;
    if(G==256){ if(i>=6)break; u=(i<4)?(4*vcu+i):(1024+2*vcu+(i-4)); }
    else{ u=vcu+i*G; if(u>=1536)break; }
    long rowbase; int h,qb,NT;
    if(u<1024){ const int bh=u>>5; qb=u&31; rowbase=(long)(bh>>3)*8192; h=bh&7; NT=128; }
    else { const int v=u-1024; const int bh=v>>4; qb=v&15; rowbase=32768+(long)(bh>>3)*4096; h=bh&7; NT=64; }
    attn_unit<THRL>(rowbase,h,qb,NT,T.Q,T.K,T.V,T.O,lds);
  }
}
#undef SBAR
#undef WAIT_BAR
}
#ifndef PH_MASK
#define PH_MASK 0x3ff
#endif
#define PH(k) if constexpr ((PH_MASK >> (k)) & 1)
constexpr int NWAVES = 8;
constexpr int RING_BYTES = 131072, LDS_BYTES = 147456;

#define LAS __attribute__((address_space(3)))
typedef unsigned short bf16;
typedef unsigned v4u __attribute__((ext_vector_type(4)));
typedef float f32x4 __attribute__((ext_vector_type(4)));
#define LDS_WAIT() asm volatile("s_waitcnt lgkmcnt(0)" ::: "memory")
__device__ __forceinline__ unsigned f2bf(float f) { unsigned u = __builtin_bit_cast(unsigned, f); return (u + 0x7fffu + ((u >> 16) & 1u)) >> 16; }
__device__ __forceinline__ unsigned pk2(float lo, float hi) { return f2bf(lo) | (f2bf(hi) << 16); }
__device__ __forceinline__ float wave_sum(float v) {
#pragma unroll
    for (int o = 1; o < 64; o <<= 1) v += __shfl_xor(v, o);
    return v;
}
__device__ __forceinline__ void transpose_item(const float* W, int ldw, int src_col0, int k0, bf16* WT, int K, int dst_row0, LAS float* scr, int lane, const float* gk = nullptr) {
    float tv[32];
    const float* wp = W + (size_t)(k0 + (lane >> 5)) * ldw + src_col0 + (lane & 31);
#pragma unroll
    for (int i = 0; i < 32; ++i) tv[i] = wp[(size_t)(2 * i) * ldw];
#pragma unroll
    for (int i = 0; i < 32; ++i) { const int kk = 2 * i + (lane >> 5); scr[kk * 33 + (lane & 31)] = gk ? tv[i] * gk[k0 + kk] : tv[i]; }
    LDS_WAIT(); asm volatile("" ::: "memory");
    const int c = lane & 7;
#pragma unroll
    for (int j = 0; j < 4; ++j) { const int n = (lane >> 3) + 8 * j; const LAS float* s = scr + (8 * c) * 33 + n;
        v4u o; o.x = pk2(s[0 * 33], s[1 * 33]); o.y = pk2(s[2 * 33], s[3 * 33]); o.z = pk2(s[4 * 33], s[5 * 33]); o.w = pk2(s[6 * 33], s[7 * 33]);
        *(v4u*)(WT + (size_t)(dst_row0 + n) * K + k0 + 8 * c) = o; }
    LDS_WAIT(); asm volatile("" ::: "memory");
}

typedef __attribute__((address_space(1))) unsigned gu32;
#define RLX_AGENT __ATOMIC_RELAXED, __HIP_MEMORY_SCOPE_AGENT
#define LDS_WAIT() asm volatile("s_waitcnt lgkmcnt(0)" ::: "memory")
#define VM_WAIT() asm volatile("s_waitcnt vmcnt(0)" ::: "memory")
#define XB_TMO      128
#define XB_XCNT(j)  (256  + 64 * (j))
#define XB_XSUB(j)  (1280 + 64 * (j))
#define XB_XGEN(j)  (2304 + 64 * (j))
#define XB_TOP      3328
#define XB_TOPGEN   3392
#define XCD_BAR_WORDS 3456
#define XB_SPIN_CAP (1u << 18)

__device__ __forceinline__ unsigned xb_ld(unsigned* p)              { return __hip_atomic_load(p, __ATOMIC_RELAXED, __HIP_MEMORY_SCOPE_AGENT); }
__device__ __forceinline__ unsigned xb_add(unsigned* p, unsigned v) { return __hip_atomic_fetch_add(p, v, __ATOMIC_RELAXED, __HIP_MEMORY_SCOPE_AGENT); }
__device__ __forceinline__ unsigned xb_xcc_id() { return (unsigned)__builtin_amdgcn_s_getreg((3 << 11) | 20) & 0xFu; }
#define XB_SPIN(cond, bar) do { unsigned _sp = 0; while (cond) { __builtin_amdgcn_s_sleep(1); \
    if ((++_sp & 255u) == 0u) { if (xb_ld(&(bar)[XB_TMO])) break; if (_sp > XB_SPIN_CAP) { atomicAdd(&(bar)[XB_TMO], 1u); break; } } } } while (0)

struct XcdBarrier {
    unsigned* bar; unsigned x;
    volatile LAS unsigned* st;
};

__device__ __forceinline__ XcdBarrier xcd_barrier_post(unsigned* bar, volatile LAS unsigned* st) {
    XcdBarrier b; b.bar = bar; b.x = xb_xcc_id(); b.st = st;
    if (threadIdx.x == 0) (void)xb_add(&bar[XB_XCNT(b.x)], 1u);
    return b;
}
__device__ __forceinline__ void xcd_barrier_complete(unsigned* bar, unsigned x, unsigned& nloc, unsigned& nx) {
    const unsigned G = gridDim.x * gridDim.y * gridDim.z;
    unsigned sum, cnt, mine, sp = 0u;
    for (;;) {
        sum = 0u; cnt = 0u; mine = 0u;
#pragma unroll
        for (unsigned j = 0; j < 16; ++j) { const unsigned c = xb_ld(&bar[XB_XCNT(j)]); sum += c; cnt += (c > 0u) ? 1u : 0u; mine = (j == x) ? c : mine; }
        if (sum == G) break;
        __builtin_amdgcn_s_sleep(1);
        if ((++sp & 255u) == 0u) { if (xb_ld(&bar[XB_TMO])) break; if (sp > XB_SPIN_CAP) { atomicAdd(&bar[XB_TMO], 1u); break; } }
    }
    nloc = mine > 0u ? mine : 1u; nx = cnt > 0u ? cnt : 1u;
}

__device__ __forceinline__ void xcd_barrier(const XcdBarrier& b) {
    asm volatile("s_waitcnt vmcnt(0)" ::: "memory");
    __syncthreads();
    if (threadIdx.x == 0) {
        unsigned* bar = b.bar;
        __builtin_amdgcn_s_waitcnt(0);
        unsigned nloc = b.st[0], nx = b.st[1];
        if (nloc == 0u) { xcd_barrier_complete(bar, b.x, nloc, nx); b.st[0] = nloc; b.st[1] = nx; }
        const unsigned old = xb_add(&bar[XB_XSUB(b.x)], 1u);
        const unsigned gen = old / nloc;
        if (old + 1u == (gen + 1u) * nloc) {
            __builtin_amdgcn_fence(__ATOMIC_RELEASE, "agent");
            asm volatile("s_waitcnt vmcnt(0)" ::: "memory");
            const unsigned og = xb_add(&bar[XB_TOP], 1u);
            const unsigned tg = og / nx;
            if (og + 1u == (tg + 1u) * nx) xb_add(&bar[XB_TOPGEN], 1u);
            else XB_SPIN(xb_ld(&bar[XB_TOPGEN]) == tg, bar);
            __builtin_amdgcn_fence(__ATOMIC_ACQUIRE, "agent");
            xb_add(&bar[XB_XGEN(b.x)], 1u);
            asm volatile("s_waitcnt vmcnt(0)" ::: "memory");
        } else {
            XB_SPIN(xb_ld(&bar[XB_XGEN(b.x)]) == gen, bar);
            __builtin_amdgcn_fence(__ATOMIC_ACQUIRE, "agent");
            asm volatile("s_waitcnt vmcnt(0)" ::: "memory");
        }
    }
    __syncthreads();
}

template <int W> __device__ __forceinline__ void pool_item(const bf16* Zb, bf16* PL, int row, int ch) {
    constexpr int left = W / 2;
    const int T = row < MP ? 8192 : 4096, t = row < MP ? (row & 8191) : ((row - MP) & 4095);
    const bf16* zp = Zb + (size_t)(row - t) * 512 + ch * 8;
    v4u q[W];
#pragma unroll
    for (int k = 0; k < W; ++k) { int tt = t - left + k; tt = tt < 0 ? 0 : (tt > T - 1 ? T - 1 : tt); q[k] = *(const v4u*)(zp + (size_t)tt * 512); }
    float a[8];
#pragma unroll
    for (int e = 0; e < 8; ++e) a[e] = 0.f;
#pragma unroll
    for (int k = 0; k < W; ++k) { const int tt = t - left + k; const float wv = (tt >= 0 && tt < T) ? 1.f : 0.f;
        a[0] += wv * pg8::bf_lo(q[k].x); a[1] += wv * pg8::bf_hi(q[k].x); a[2] += wv * pg8::bf_lo(q[k].y); a[3] += wv * pg8::bf_hi(q[k].y);
        a[4] += wv * pg8::bf_lo(q[k].z); a[5] += wv * pg8::bf_hi(q[k].z); a[6] += wv * pg8::bf_lo(q[k].w); a[7] += wv * pg8::bf_hi(q[k].w); }
    const int lo = (t - left) > 0 ? (t - left) : 0, hi = (t + W - 1 - left) < (T - 1) ? (t + W - 1 - left) : (T - 1);
    const float ic = 1.0f / (float)(hi - lo + 1); const v4u s = q[left];
    v4u o; o.x = pk2(a[0] * ic - pg8::bf_lo(s.x), a[1] * ic - pg8::bf_hi(s.x)); o.y = pk2(a[2] * ic - pg8::bf_lo(s.y), a[3] * ic - pg8::bf_hi(s.y));
    o.z = pk2(a[4] * ic - pg8::bf_lo(s.z), a[5] * ic - pg8::bf_hi(s.z)); o.w = pk2(a[6] * ic - pg8::bf_lo(s.w), a[7] * ic - pg8::bf_hi(s.w));
    *(v4u*)(PL + (size_t)row * 512 + ch * 8) = o;
}
struct Args { const float* in[25]; float* out; unsigned char* ws; };
static_assert(sizeof(Args) == 27 * 8, "Args has no padding");

__device__ __forceinline__ void gateup_items(int r, const float* Wg, const float* Wu, bf16* WT, LAS float* scr, int lane, const float* gk) {
    const int kb = r / 176, G = r % 176, tile = G >> 3, w = G & 7;
    transpose_item((w < 4) ? Wg : Wu, DFF, tile * 128 + (w & 3) * 32, kb * 64, WT, 1024, G * 32, scr, lane, gk);
}

constexpr int CV_I1 = 16 * 176, CV_I2 = 44 * 32, CV_I3 = 16 * 104, CV_I4 = 8 * 32, CV_I6 = 16 * 32, CV_I10 = 4 * 32;
constexpr int CV_NITEMS = 2 * CV_I1 + 2 * CV_I2 + CV_I3 + CV_I4 + 2 * CV_I6 + CV_I10;
__device__ __forceinline__ void convert_items(const Args& args, unsigned char* ws, LAS float* scr, int lane, int it_begin, int it_end, int skip_begin, int skip_len, int w, int nw) {
    bf16* W1 = (bf16*)(ws + WS_W1); bf16* WD1 = (bf16*)(ws + WS_WD1); bf16* WIN = (bf16*)(ws + WS_WIN); bf16* WUA = (bf16*)(ws + WS_WUA);
    bf16* WOUT = (bf16*)(ws + WS_WOUT); bf16* W2 = (bf16*)(ws + WS_W2); bf16* WD2 = (bf16*)(ws + WS_WD2); bf16* WPG = (bf16*)(ws + WS_WPG); bf16* WPP = (bf16*)(ws + WS_WPP);
    for (int it = it_begin + w; it < it_end; it += nw) {
        int r = it >= skip_begin ? it + skip_len : it;
        if (r < CV_I1) { gateup_items(r, args.in[5], args.in[6], W1, scr, lane, nullptr); continue; } r -= CV_I1;
        if (r < CV_I1) { gateup_items(r, args.in[18], args.in[19], W2, scr, lane, args.in[17]); continue; } r -= CV_I1;
        if (r < CV_I2) { transpose_item(args.in[7], 1024, (r % 32) * 32, (r / 32) * 64, WD1, DFF, (r % 32) * 32, scr, lane); continue; } r -= CV_I2;
        if (r < CV_I2) { transpose_item(args.in[20], 1024, (r % 32) * 32, (r / 32) * 64, WD2, DFF, (r % 32) * 32, scr, lane); continue; } r -= CV_I2;
        if (r < CV_I3) { const int kb = r / 104, Gp = r % 104; const int c0 = Gp < 24 ? ((Gp >> 3) * 256 + (Gp & 3) * 64 + ((Gp >> 2) & 1) * 32) : Gp * 32;
            transpose_item(args.in[9], INW, c0, kb * 64, WIN, 1024, Gp * 32, scr, lane, args.in[8]); continue; } r -= CV_I3;
        if (r < CV_I4) { transpose_item(args.in[12], 1024, (r % 32) * 32, (r / 32) * 64, WUA, 512, (r % 32) * 32, scr, lane); continue; } r -= CV_I4;
        if (r < CV_I6) { transpose_item(args.in[16], 1024, (r % 32) * 32, (r / 32) * 64, WOUT, 1024, (r % 32) * 32, scr, lane); continue; } r -= CV_I6;
        if (r < CV_I6) { transpose_item(args.in[22], 1024, (r % 32) * 32, (r / 32) * 64, WPG, 1024, (r % 32) * 32, scr, lane, args.in[21]); continue; } r -= CV_I6;
        transpose_item(args.in[23], 1024, (r % 32) * 32, (r / 32) * 64, WPP, PLE, (r % 32) * 32, scr, lane);
    }
}

__global__ void __launch_bounds__(NWAVES * 64, 2) fwd_mega(Args args) {
    extern __shared__ __attribute__((aligned(16))) unsigned char lds[];
    cg::grid_group grid = cg::this_grid();
    const int tid = threadIdx.x, lane = tid & 63, wave = __builtin_amdgcn_readfirstlane(tid >> 6);
    const int G = gridDim.x, bx = blockIdx.x, vcu = (G % 8 == 0) ? (bx % 8) * (G / 8) + bx / 8 : bx;
    unsigned char* ws = args.ws;
    LAS unsigned char* ldsp = (LAS unsigned char*)lds;
    const float* x_p = args.in[0]; const float* x_s = args.in[1]; const float* p_p = args.in[2]; const float* p_s = args.in[3];
    float* out = args.out;
    float* SS = (float*)(ws + WS_SS); float* SSE = (float*)(ws + WS_SSE);
    bf16* W1 = (bf16*)(ws + WS_W1); bf16* WD1 = (bf16*)(ws + WS_WD1); bf16* WIN = (bf16*)(ws + WS_WIN); bf16* WUA = (bf16*)(ws + WS_WUA); bf16* WPC = (bf16*)(ws + WS_WPC);
    bf16* WOUT = (bf16*)(ws + WS_WOUT); bf16* W2 = (bf16*)(ws + WS_W2); bf16* WD2 = (bf16*)(ws + WS_WD2); bf16* WPG = (bf16*)(ws + WS_WPG); bf16* WPP = (bf16*)(ws + WS_WPP);
    bf16* HB = (bf16*)(ws + WS_HB); bf16* ACT = (bf16*)(ws + WS_ACT); bf16* QO = (bf16*)(ws + WS_QO); bf16* Zb = (bf16*)(ws + WS_Z); bf16* PL = (bf16*)(ws + WS_PL);
    bf16* MX = (bf16*)(ws + WS_MX); bf16* KB = (bf16*)(ws + WS_K); bf16* VB = (bf16*)(ws + WS_V); bf16* PB = (bf16*)(ws + WS_PB); bf16* SGB = (bf16*)(ws + WS_SGB); bf16* EB = (bf16*)(ws + WS_E);
    volatile LAS unsigned* bst = (volatile LAS unsigned*)(ldsp + 139264);
    if (tid < 2) bst[tid] = 0u;
    __syncthreads();
    const XcdBarrier xbar = xcd_barrier_post((unsigned*)ws, bst);
    const int gw = vcu * NWAVES + wave, NGW = G * NWAVES;
    const int gt = bx * (NWAVES * 64) + tid, NGT = G * NWAVES * 64;

    PH(0) {
        LAS float* scr = (LAS float*)(ldsp + wave * 16384);
        const bool defer = (G == 256);
        if (defer) convert_items(args, ws, scr, lane, 0, CV_NITEMS - CV_I1, CV_I1, CV_I1, gw, NGW); else convert_items(args, ws, scr, lane, 0, CV_NITEMS, CV_NITEMS, 0, gw, NGW);
        if (gt < 128) ((float*)(ws + WS_GQK))[gt] = gt < 64 ? args.in[10][gt] : args.in[11][gt - 64];
        { const float* pw = args.in[13]; const float* psc = args.in[14]; const float* wup = args.in[15];
          for (int idx = gt; idx < 128 * 1024; idx += NGT) { const int d = idx & 1023, c0 = (idx >> 10) * 4, g0 = c0 & ~127; float a0 = 0.f, a1 = 0.f, a2 = 0.f, a3 = 0.f;
              const float* pr = pw + (size_t)c0 * 128; const float* bp = wup + (size_t)g0 * 1024 + d;
#pragma unroll 16
              for (int j = 0; j < 128; ++j) { const float b = bp[(size_t)j * 1024] * psc[g0 + j]; a0 += pr[j] * b; a1 += pr[128 + j] * b; a2 += pr[256 + j] * b; a3 += pr[384 + j] * b; }
              *(unsigned long long*)(WPC + (size_t)d * 512 + c0) = (unsigned long long)pk2(a0, a1) | ((unsigned long long)pk2(a2, a3) << 32); } }
        { const float* g1 = args.in[4]; f32x4 gv[4];
#pragma unroll
          for (int j = 0; j < 4; ++j) gv[j] = ((const f32x4*)g1)[lane + 64 * j];
          for (int m0 = gw * 4; m0 < MTOT; m0 += NGW * 4) { const float* xr = m0 < MP ? x_p + (size_t)m0 * 1024 : x_s + (size_t)(m0 - MP) * 1024;
              f32x4 v[4][4]; float s[4];
#pragma unroll
              for (int r = 0; r < 4; ++r)
#pragma unroll
                  for (int j = 0; j < 4; ++j) v[r][j] = ((const f32x4*)(xr + r * 1024))[lane + 64 * j];
#pragma unroll
              for (int r = 0; r < 4; ++r) { s[r] = 0.f;
#pragma unroll
                  for (int j = 0; j < 4; ++j) s[r] += (v[r][j].x * v[r][j].x + v[r][j].y * v[r][j].y) + (v[r][j].z * v[r][j].z + v[r][j].w * v[r][j].w); }
#pragma unroll
              for (int r = 0; r < 4; ++r) { const float rstd = rsqrtf(wave_sum(s[r]) * (1.f / 1024.f) + EPSN);
                  unsigned long long* o8 = (unsigned long long*)(HB + (size_t)(m0 + r) * 1024) + lane;
#pragma unroll
                  for (int j = 0; j < 4; ++j) { const f32x4 y = v[r][j] * rstd * gv[j]; o8[64 * j] = (unsigned long long)pk2(y.x, y.y) | ((unsigned long long)pk2(y.z, y.w) << 32); } } } }
    }
    grid.sync();

    PH(1) { pg8::Gemm g{HB, W1, MTOT, 2 * DFF, 1024, 0, 0}; pg8::StaticOrder S; S.init(MTOT, 2 * DFF, G, bx);
      pg8::EpiGateUp<false> E{ACT, DFF, nullptr};
      pg8::gemm_phase<pg8::EpiGateUp<false>, pg8::StaticOrder, true, true>(ldsp, g, S, E); }
    if (G == 256 && bx >= 128) {
        asm volatile("s_waitcnt vmcnt(0)" ::: "memory"); __syncthreads();
        LAS float* scr = (LAS float*)(ldsp + wave * 16384);
        convert_items(args, ws, scr, lane, CV_I1, 2 * CV_I1, CV_NITEMS, 0, (bx - 128) * NWAVES + wave, 128 * NWAVES);
    }
    xcd_barrier(xbar);
    PH(2) { pg8::Gemm g{ACT, WD1, MTOT, 1024, DFF, 0, 0}; pg8::StaticOrder S; S.init(MTOT, 1024, G, bx, 1);
      pg8::EpiResid<true> E{x_p, x_s, HB, SS, 0.5f};
      pg8::gemm_phase<pg8::EpiResid<true>, pg8::StaticOrder, true, true>(ldsp, g, S, E); }
    xcd_barrier(xbar);
    PH(3) { pg8::Gemm g{HB, WIN, MTOT, INW, 1024, 0, 0}; pg8::StaticOrder S; S.init(MTOT, INW, G, bx);
      pg8::EpiWin E{SS, (const float*)(ws + WS_GQK), ws, attn_body::C2};
      pg8::gemm_phase<pg8::EpiWin, pg8::StaticOrder, true, true>(ldsp, g, S, E); }
    xcd_barrier(xbar);
    PH(4) {
      for (int wi = gw; wi < MTOT; wi += NGW) { const int grp = wi & 3, row = (wi >> 2) * 4 + (lane >> 4), ch = grp * 16 + (lane & 15);
          if (grp == 0) pool_item<2>(Zb, PL, row, ch); else if (grp == 1) pool_item<4>(Zb, PL, row, ch); else if (grp == 2) pool_item<8>(Zb, PL, row, ch); else pool_item<16>(Zb, PL, row, ch); }
      asm volatile("s_waitcnt vmcnt(0)" ::: "memory"); __syncthreads();
      const attn_body::AttnTensors AT{(const attn_body::bf16*)QO, (const attn_body::bf16*)KB, (const attn_body::bf16*)VB, (attn_body::bf16*)QO};
      attn_body::attn_phase<8>((char*)lds, AT, vcu, G); }
    xcd_barrier(xbar);
    PH(5) { for (int idx = gt; idx < MTOT * 32; idx += NGT) { const int row = idx >> 5, ch = idx & 31; const float* pr = (row < MP ? p_p + (size_t)row * PLE : p_s + (size_t)(row - MP) * PLE) + ch * 8;
          const f32x4 a = *(const f32x4*)pr, b = *(const f32x4*)(pr + 4); v4u o; o.x = pk2(a.x, a.y); o.y = pk2(a.z, a.w); o.z = pk2(b.x, b.y); o.w = pk2(b.z, b.w);
          *(v4u*)(PB + (size_t)row * PLE + ch * 8) = o; }
      asm volatile("s_waitcnt vmcnt(0)" ::: "memory"); __syncthreads();
      pg8::SegOrder S; S.init(MTOT, 1024, G, bx);
      { pg8::Gemm g{QO, WUA, MTOT, 1024, 512, (long)((const char*)PL - (const char*)QO), (long)((const char*)WPC - (const char*)WUA)}; pg8::EpiGateMix E{MX, SGB}; pg8::gemm_phase<pg8::EpiGateMix, pg8::SegOrder, true, true>(ldsp, g, S, E); } }
    xcd_barrier(xbar);
    PH(6) { pg8::StaticOrder S; S.init(MTOT, 1024, G, bx);
      { pg8::Gemm g{MX, WOUT, MTOT, 1024, 1024, 0, 0}; pg8::EpiResid<false> E{nullptr, nullptr, HB, SS, 1.0f}; pg8::gemm_phase<pg8::EpiResid<false>, pg8::StaticOrder, true, true>(ldsp, g, S, E); }
 }
    asm volatile("s_waitcnt vmcnt(0)" ::: "memory"); __syncthreads();
    PH(6) { pg8::Gemm g{PB, WPP, MTOT, 1024, PLE, 0, 0}; pg8::StaticOrder S; S.init(MTOT, 1024, G, bx); pg8::EpiE E{EB, SSE};
      pg8::gemm_phase<pg8::EpiE, pg8::StaticOrder, true, true>(ldsp, g, S, E); }
    xcd_barrier(xbar);
    PH(7) { pg8::Gemm g{HB, W2, MTOT, 2 * DFF, 1024, 0, 0}; pg8::StaticOrder S; S.init(MTOT, 2 * DFF, G, bx);
      pg8::EpiGateUp<true> E{ACT, DFF, SS};
      pg8::gemm_phase<pg8::EpiGateUp<true>, pg8::StaticOrder, true, true>(ldsp, g, S, E); }
    xcd_barrier(xbar);
    PH(8) { pg8::Gemm g{ACT, WD2, MTOT, 1024, DFF, 0, 0}; pg8::StaticOrder S; S.init(MTOT, 1024, G, bx, 1);
      pg8::EpiResid<false> E{nullptr, nullptr, HB, SS, 0.5f};
      pg8::gemm_phase<pg8::EpiResid<false>, pg8::StaticOrder, true, true>(ldsp, g, S, E); }
    xcd_barrier(xbar);
    PH(9) { pg8::Gemm g{HB, WPG, MTOT, 1024, 1024, 0, 0}; pg8::StaticOrder S; S.init(MTOT, 1024, G, bx);
      pg8::EpiFinal E{out, HB, EB, SS, SSE, args.in[24]};
      pg8::gemm_phase<pg8::EpiFinal, pg8::StaticOrder, true, true>(ldsp, g, S, E); }
}

extern "C" void kernel_launch(void* const* d_in, const int* in_sizes, int n_in, void* d_out, int out_size, void* d_ws, size_t ws_size, hipStream_t stream) {
    static int grid = 0;
    if (grid == 0) {
        if (n_in != 25 || out_size != MTOT * 1024 || ws_size < WS_END) { fprintf(stderr, "kernel_launch: unexpected problem (n_in %d, out %d, ws %zu); nothing launched\n", n_in, out_size, ws_size); grid = -1; return; }
        int dev = 0, cus = 0, per_cu = 0;
        if (hipGetDevice(&dev) != hipSuccess || hipDeviceGetAttribute(&cus, hipDeviceAttributeMultiprocessorCount, dev) != hipSuccess) { grid = -1; return; }
        if (hipFuncSetAttribute((const void*)fwd_mega, hipFuncAttributeMaxDynamicSharedMemorySize, LDS_BYTES) != hipSuccess) { fprintf(stderr, "kernel_launch: hipFuncSetAttribute failed\n"); grid = -1; return; }
        if (hipOccupancyMaxActiveBlocksPerMultiprocessor(&per_cu, (const void*)fwd_mega, NWAVES * 64, LDS_BYTES) != hipSuccess || per_cu < 1) { fprintf(stderr, "kernel_launch: occupancy query says %d blocks per CU\n", per_cu); (void)hipGetLastError(); }
        grid = cus;
    }
    if (grid < 0) return;
    if (hipMemsetAsync(d_ws, 0, 16384, stream) != hipSuccess) { fprintf(stderr, "kernel_launch: memset failed\n"); return; }
    Args a{};
    for (int i = 0; i < 25; ++i) a.in[i] = (const float*)d_in[i];
    a.out = (float*)d_out; a.ws = (unsigned char*)d_ws;
    void* kargs[] = {&a};
    const hipError_t e = hipLaunchCooperativeKernel((const void*)fwd_mega, dim3(grid), dim3(NWAVES * 64), kargs, LDS_BYTES, stream);
    if (e != hipSuccess) fprintf(stderr, "kernel_launch: cooperative launch failed: %s (grid %d)\n", hipGetErrorString(e), grid);
}
```

```cpp
#include <hip/hip_runtime.h>
#include <hip/hip_cooperative_groups.h>
#include <hip/hip_bf16.h>
#include <cstdio>
#include <cstdint>
#include <cmath>
namespace cg = cooperative_groups;

constexpr int DMODEL = 1024, MP = 4 * 8192, MS = 4 * 4096, MTOT = MP + MS;
constexpr int DFF = 2816, INW = 3328, PLE = 256;
constexpr float EPSN = 1e-6f;
constexpr size_t HK = 512u * 1024u;
constexpr size_t WS_GQK = 1 * HK;
constexpr size_t WS_SS = 2 * HK, WS_SSE = 8 * HK;
constexpr size_t WS_W1 = 16 * HK, WS_WD1 = 38 * HK, WS_WIN = 49 * HK, WS_WUA = 62 * HK, WS_WPC = 64 * HK, WS_WOUT = 66 * HK, WS_W2 = 70 * HK, WS_WD2 = 92 * HK, WS_WPG = 103 * HK, WS_WPP = 107 * HK;
constexpr size_t WS_HB = 112 * HK;
constexpr size_t WS_ACT = 304 * HK;
constexpr size_t WS_QO = WS_ACT, WS_Z = WS_ACT + 96 * HK, WS_PL = WS_ACT + 192 * HK, WS_MX = WS_ACT + 288 * HK, WS_K = WS_ACT + 480 * HK, WS_V = WS_ACT + 504 * HK, WS_PB = WS_K;
constexpr size_t WS_SGB = 832 * HK, WS_E = WS_SGB, WS_END = 1024 * HK;
static_assert(WS_WPP + 1024 * 256 * 2 <= WS_HB && WS_HB + (size_t)MTOT * 1024 * 2 <= WS_ACT && WS_ACT + (size_t)MTOT * DFF * 2 <= WS_SGB && WS_V + (size_t)MTOT * 128 * 2 <= WS_SGB && WS_SGB + (size_t)MTOT * 1024 * 2 <= WS_END, "d_ws map");
static_assert(WS_W1 + 5632 * 1024 * 2 <= WS_WD1 && WS_WD1 + 1024 * 2816 * 2 <= WS_WIN && WS_WIN + 3328 * 1024 * 2 <= WS_WUA && WS_W2 + 5632 * 1024 * 2 <= WS_WD2 && WS_WD2 + 1024 * 2816 * 2 <= WS_WPG && WS_WPG + 1024 * 1024 * 2 <= WS_WPP, "weights map");


namespace pg8 {
#define PG8_LAS __attribute__((address_space(3)))
typedef unsigned short bf16_t;
typedef short bf16x8 __attribute__((ext_vector_type(8)));
typedef float f32x4 __attribute__((ext_vector_type(4)));
typedef unsigned u32x4 __attribute__((ext_vector_type(4)));
#ifndef PG8_PFD
#define PG8_PFD 3
#endif
constexpr int PFD = PG8_PFD;
constexpr int BM = 256, BK = 64, HALF = 128, HTB = HALF * BK * 2  , STAGE_BYTES = 8 * HTB, NXCD = 8, WGM = 8;

__host__ __device__ __forceinline__ int lds_byte(int r, int c) { const int st = (r >> 4) * 2 + (c >> 5), rr = r & 15, cc = c & 31, ob = rr * 64 + cc * 2; return st * 1024 + (ob ^ (((ob >> 9) & 1) << 5)); }
__host__ __device__ __forceinline__ void stage_rc(int b, int& R, int& C) { const int st = b / 1024, sb = b % 1024, swz = sb ^ (((sb >> 9) & 1) << 5); R = (st >> 1) * 16 + swz / 64; C = (st & 1) * 32 + (swz % 64) / 2; }
__host__ __device__ __forceinline__ int perm32(int rho) { const int n = rho >> 4, i = rho & 15; return 8 * (i >> 2) + 4 * n + (i & 3); }

struct Unit { int pm, pn, seg; };
struct Gemm { const bf16_t* A; const bf16_t* Bt; int M, N, K; long dA, dB; };

struct StaticOrder {
    int nM, nN, nwg, G, c, rev;
    __host__ __device__ void init(int M, int N, int G_, int c_, int rev_ = 0) { nM = M / BM; nN = N / BM; nwg = nM * nN; G = G_; c = c_; rev = rev_; }
    __host__ __device__ bool next(int i, Unit& u) const {
        const int nr = (nwg - c + G - 1) / G; if (i >= nr) return false;
        const long L = (long)(rev ? nr - 1 - i : i) * G + c;
        int wgid = (int)L; { const int q = nwg / NXCD, r = nwg % NXCD, xcd = wgid % NXCD, off = wgid / NXCD; wgid = (xcd < r ? xcd * (q + 1) : r * (q + 1) + (xcd - r) * q) + off; }
        const int nig = WGM * nN, gid = wgid / nig, fm = gid * WGM, gsz = (nM - fm) < WGM ? (nM - fm) : WGM;
        u.pm = fm + ((wgid % nig) % gsz); u.pn = (wgid % nig) / gsz; u.seg = 0; return true;
    }
    __device__ __forceinline__ void a_ready(const Unit&) const {}
    __device__ __forceinline__ void done(const Unit&) const {}
};
struct SegOrder : StaticOrder {
    __host__ __device__ bool next(int i, Unit& u) const { const bool ok = StaticOrder::next(i >> 1, u); u.seg = i & 1; return ok; }
};
__device__ __forceinline__ unsigned cvt_pk_bf16(float lo, float hi) { unsigned r; asm volatile("v_cvt_pk_bf16_f32 %0, %1, %2" : "=v"(r) : "v"(lo), "v"(hi)); return r; }
typedef unsigned u32x2 __attribute__((ext_vector_type(2)));
__device__ __forceinline__ float bf_lo(unsigned w) { return __uint_as_float(w << 16); }
__device__ __forceinline__ float bf_hi(unsigned w) { return __uint_as_float(w & 0xffff0000u); }
__device__ __forceinline__ float sigm(float x) { return __builtin_amdgcn_rcpf(1.0f + __builtin_amdgcn_exp2f(-1.4426950408889634f * x)); }
__device__ __forceinline__ float row_rstd(const float* ss, int row) {
    const f32x4* p = (const f32x4*)(ss + (size_t)row * 16);
    const f32x4 a = p[0], b = p[1], c = p[2], d = p[3];
    const float s = (((a.x + a.y) + (a.z + a.w)) + ((b.x + b.y) + (b.z + b.w))) + (((c.x + c.y) + (c.z + c.w)) + ((d.x + d.y) + (d.z + d.w)));
    return rsqrtf(s * (1.0f / 1024.0f) + EPSN);
}

__device__ __forceinline__ void load_rstd8(const float* ss, int row0, int fq, float (&rs)[2][4]) {
    f32x4 pv[2][4];
#pragma unroll
    for (int ai = 0; ai < 2; ++ai)
#pragma unroll
        for (int m = 0; m < 4; ++m) pv[ai][m] = *(const f32x4*)(ss + (size_t)(row0 + ai * HALF + m * 16) * 16 + 4 * fq);
#pragma unroll
    for (int ai = 0; ai < 2; ++ai)
#pragma unroll
        for (int m = 0; m < 4; ++m) { float s = (pv[ai][m].x + pv[ai][m].y) + (pv[ai][m].z + pv[ai][m].w); s += __shfl_xor(s, 16); s += __shfl_xor(s, 32); rs[ai][m] = rsqrtf(s * (1.0f / 1024.0f) + EPSN); }
}

template <bool ROWSCALE> struct EpiGateUp {
    static constexpr bool PERM = true, AFTER_DRAIN = false, SEG = false; static constexpr int NST = ROWSCALE ? 12 : 6;
    bf16_t* O; int ldc; const float* ss;
    __device__ __forceinline__ void operator()(const f32x4 (&acc)[2][2][4][2], const Unit& u, int wr, int wc, int fr, int fq) const {
        const int row0 = u.pm * BM + wr * 64 + fr, col0 = u.pn * HALF + wc * 32 + 8 * fq;
        float rs[2][4];
        if (ROWSCALE) load_rstd8(ss, row0, fq, rs);
#pragma unroll
        for (int ai = 0; ai < 2; ++ai)
#pragma unroll
            for (int m = 0; m < 4; ++m) { const int row = row0 + ai * HALF + m * 16; const float r = ROWSCALE ? rs[ai][m] : 1.0f;
                typedef float f32x2 __attribute__((ext_vector_type(2)));
                const float nk = -1.4426950408889634f * r, r2 = r * r; unsigned wv[4];
#pragma unroll
                for (int n = 0; n < 2; ++n)
#pragma unroll
                    for (int e = 0; e < 4; e += 2) { const f32x2 g = (f32x2){acc[ai][0][m][n][e], acc[ai][0][m][n][e + 1]}, up = (f32x2){acc[ai][1][m][n][e], acc[ai][1][m][n][e + 1]};
                        const f32x2 t = g * nk; f32x2 ex; ex.x = __builtin_amdgcn_exp2f(t.x); ex.y = __builtin_amdgcn_exp2f(t.y);
                        const f32x2 d = ex + 1.0f; f32x2 q; q.x = __builtin_amdgcn_rcpf(d.x); q.y = __builtin_amdgcn_rcpf(d.y);
                        f32x2 o = (g * up) * q; if (ROWSCALE) o = o * r2;
                        wv[n * 2 + (e >> 1)] = cvt_pk_bf16(o.x, o.y); }
                u32x4 w; w.x = wv[0]; w.y = wv[1]; w.z = wv[2]; w.w = wv[3];
                *(u32x4*)(O + (size_t)row * ldc + col0) = w; }
    }
};

template <bool F32BASE> struct EpiResid {
    static constexpr bool PERM = true, AFTER_DRAIN = false, SEG = false; static constexpr int NST = F32BASE ? 40 : 30;
    const float* base0; const float* base1; bf16_t* hb; float* ss; float alpha;
    __device__ __forceinline__ void operator()(const f32x4 (&acc)[2][2][4][2], const Unit& u, int wr, int wc, int fr, int fq) const {
        const int row0 = u.pm * BM + wr * 64 + fr, col0 = u.pn * BM + wc * 32 + 8 * fq;
#pragma unroll
        for (int ai = 0; ai < 2; ++ai) {
            f32x4 b[4][2][2];
#pragma unroll
            for (int m = 0; m < 4; ++m) { const int row = row0 + ai * HALF + m * 16;
#pragma unroll
                for (int bj = 0; bj < 2; ++bj) {
                    if (F32BASE) { const float* bp = (row < MP ? base0 + (size_t)row * DMODEL : base1 + (size_t)(row - MP) * DMODEL) + col0 + bj * HALF; b[m][bj][0] = *(const f32x4*)bp; b[m][bj][1] = *(const f32x4*)(bp + 4); }
                    else { const u32x4 w = *(const u32x4*)(hb + (size_t)row * DMODEL + col0 + bj * HALF); b[m][bj][0] = __builtin_bit_cast(f32x4, w); } } }
            asm volatile("" ::: "memory");
#pragma unroll
            for (int m = 0; m < 4; ++m) { const int row = row0 + ai * HALF + m * 16; const size_t off = (size_t)row * DMODEL + col0; float s = 0.f;
#pragma unroll
                for (int bj = 0; bj < 2; ++bj) { const f32x4 c0 = acc[ai][bj][m][0], c1 = acc[ai][bj][m][1]; f32x4 b0, b1;
                    if (F32BASE) { b0 = b[m][bj][0]; b1 = b[m][bj][1]; }
                    else { const u32x4 w = __builtin_bit_cast(u32x4, b[m][bj][0]); b0 = (f32x4){bf_lo(w.x), bf_hi(w.x), bf_lo(w.y), bf_hi(w.y)}; b1 = (f32x4){bf_lo(w.z), bf_hi(w.z), bf_lo(w.w), bf_hi(w.w)}; }
                    const f32x4 v0 = b0 + c0 * alpha, v1 = b1 + c1 * alpha;
                    s += ((v0.x * v0.x + v0.y * v0.y) + (v0.z * v0.z + v0.w * v0.w)) + ((v1.x * v1.x + v1.y * v1.y) + (v1.z * v1.z + v1.w * v1.w));
                    u32x4 o; o.x = cvt_pk_bf16(v0.x, v0.y); o.y = cvt_pk_bf16(v0.z, v0.w); o.z = cvt_pk_bf16(v1.x, v1.y); o.w = cvt_pk_bf16(v1.z, v1.w);
                    *(u32x4*)(hb + off + bj * HALF) = o; }
                s += __shfl_xor(s, 16); s += __shfl_xor(s, 32);
                if (fq == 0) ss[(size_t)row * 16 + u.pn * 4 + wc] = s; }
            asm volatile("" ::: "memory"); }
    }
};

struct EpiWin {
    static constexpr bool PERM = false, AFTER_DRAIN = false, SEG = false; static constexpr int NST = 30;
    const float* ss; const float* gqk; unsigned char* ws; float qscale;
    __device__ __forceinline__ void operator()(const f32x4 (&acc)[2][2][4][2], const Unit& u, int wr, int wc, int fr, int fq) const {
        const int row0 = u.pm * BM + wr * 64 + fr;
        const int pn = u.pn;
        const bool is_rope = (pn < 2) || (pn == 2 && wc < 2);
        float rs[2][4];
        load_rstd8(ss, row0, fq, rs);
        if (is_rope) {
            const float* g = gqk + ((pn < 2) ? 0 : 64); const float osc = (pn < 2) ? qscale : 1.0f;
            bf16_t* dst = (bf16_t*)(ws + ((pn < 2) ? (WS_QO + (size_t)(pn * 4 + wc) * 128) : (WS_K + (size_t)wc * 128))); const int ld = (pn < 2) ? 512 : 128;
            f32x4 gv[2][2]; float inv[4];
#pragma unroll
            for (int bj = 0; bj < 2; ++bj)
#pragma unroll
                for (int n = 0; n < 2; ++n) gv[bj][n] = *(const f32x4*)(g + bj * 32 + n * 16 + 4 * fq);
#pragma unroll
            for (int e = 0; e < 4; ++e) inv[e] = __builtin_amdgcn_exp2f(-(float)(4 * fq + e) * 0.8304820237218406f);
#pragma unroll
            for (int m = 0; m < 4; ++m)
#pragma unroll
                for (int ai = 0; ai < 2; ++ai) { const int row = row0 + ai * HALF + m * 16;
                    int t = row < MP ? (row & 8191) : ((row - MP) & 4095); asm volatile("" : "+v"(t));
                    float s = 0.f;
#pragma unroll
                    for (int bj = 0; bj < 2; ++bj)
#pragma unroll
                        for (int n = 0; n < 2; ++n) { const f32x4 a = acc[ai][bj][m][n]; s += (a.x * a.x + a.y * a.y) + (a.z * a.z + a.w * a.w); }
                    s += __shfl_xor(s, 16); s += __shfl_xor(s, 32);
                    const float rr = rs[ai][m];
                    s *= rr * rr;
                    const float r = rsqrtf(s * (1.0f / 64.0f) + EPSN) * rr * osc;
#pragma unroll
                    for (int bj = 0; bj < 2; ++bj) { const float pos = (float)(bj == 0 ? (t >> 6) : (t & 63));
                        const f32x4 x1 = acc[ai][bj][m][0] * r * gv[bj][0], x2 = acc[ai][bj][m][1] * r * gv[bj][1]; f32x4 o1, o2;
#pragma unroll
                        for (int e = 0; e < 4; ++e) { const float ang = pos * inv[e]; const float c = __cosf(ang), sn = __sinf(ang); o1[e] = x1[e] * c - x2[e] * sn; o2[e] = x2[e] * c + x1[e] * sn; }
                        u32x2 w1, w2; w1.x = cvt_pk_bf16(o1.x, o1.y); w1.y = cvt_pk_bf16(o1.z, o1.w); w2.x = cvt_pk_bf16(o2.x, o2.y); w2.y = cvt_pk_bf16(o2.z, o2.w);
                        bf16_t* p = dst + (size_t)row * ld + bj * 32 + 4 * fq; *(u32x2*)p = w1; *(u32x2*)(p + 16) = w2; }
                    __builtin_amdgcn_sched_barrier(0); }
        } else if (pn == 2) {
            bf16_t* dst = (bf16_t*)(ws + WS_V) + (wc - 2) * 64 + 4 * fq;
#pragma unroll
            for (int ai = 0; ai < 2; ++ai)
#pragma unroll
                for (int m = 0; m < 4; ++m) { const int row = row0 + ai * HALF + m * 16; const float r = rs[ai][m];
#pragma unroll
                    for (int bj = 0; bj < 2; ++bj)
#pragma unroll
                        for (int n = 0; n < 2; ++n) { const f32x4 v = acc[ai][bj][m][n] * r; u32x2 w; w.x = cvt_pk_bf16(v.x, v.y); w.y = cvt_pk_bf16(v.z, v.w); *(u32x2*)(dst + (size_t)row * 128 + bj * 32 + n * 16) = w; } }
        } else {
            const bool sg = pn >= 5; const int ld = sg ? 1024 : 512; const int ct = pn < 5 ? pn - 3 : (pn < 9 ? pn - 5 : pn - 9);
            bf16_t* dst = (bf16_t*)(ws + (pn < 5 ? WS_Z : (pn < 9 ? WS_MX : WS_SGB))) + ct * 256 + wc * 32 + 4 * fq;
#pragma unroll
            for (int ai = 0; ai < 2; ++ai)
#pragma unroll
                for (int m = 0; m < 4; ++m) { const int row = row0 + ai * HALF + m * 16; const float r = rs[ai][m];
#pragma unroll
                    for (int bj = 0; bj < 2; ++bj)
#pragma unroll
                        for (int n = 0; n < 2; ++n) { f32x4 v = acc[ai][bj][m][n] * r; if (sg) { v.x = sigm(v.x); v.y = sigm(v.y); v.z = sigm(v.z); v.w = sigm(v.w); }
                            u32x2 w; w.x = cvt_pk_bf16(v.x, v.y); w.y = cvt_pk_bf16(v.z, v.w); *(u32x2*)(dst + (size_t)row * ld + bj * HALF + n * 16) = w; } }
        }
    }
};

struct EpiGateMix {
    static constexpr bool PERM = true, AFTER_DRAIN = false, SEG = true; static constexpr int NST = 24;
    bf16_t* Mx; const bf16_t* SGB;
    __device__ __forceinline__ void operator()(f32x4 (&acc)[2][2][4][2], const Unit& u, int wr, int wc, int fr, int fq) const {
        const int row0 = u.pm * BM + wr * 64 + fr, col0 = u.pn * BM + wc * 32 + 8 * fq;
#pragma unroll
        for (int ai = 0; ai < 2; ++ai) {
            u32x4 gw[4][2], aw[4][2];
#pragma unroll
            for (int m = 0; m < 4; ++m)
#pragma unroll
                for (int bj = 0; bj < 2; ++bj) { const size_t off = (size_t)(row0 + ai * HALF + m * 16) * DMODEL + col0 + bj * HALF; gw[m][bj] = *(const u32x4*)(SGB + off); if (u.seg == 0) aw[m][bj] = *(const u32x4*)(Mx + off); }
            asm volatile("" ::: "memory");
#pragma unroll
            for (int m = 0; m < 4; ++m)
#pragma unroll
                for (int bj = 0; bj < 2; ++bj) { const size_t off = (size_t)(row0 + ai * HALF + m * 16) * DMODEL + col0 + bj * HALF; const u32x4 g = gw[m][bj];
                    const f32x4 g0 = (f32x4){bf_lo(g.x), bf_hi(g.x), bf_lo(g.y), bf_hi(g.y)}, g1 = (f32x4){bf_lo(g.z), bf_hi(g.z), bf_lo(g.w), bf_hi(g.w)};
                    if (u.seg == 0) { const u32x4 a = aw[m][bj];
                        const f32x4 a0 = (f32x4){bf_lo(a.x), bf_hi(a.x), bf_lo(a.y), bf_hi(a.y)}, a1 = (f32x4){bf_lo(a.z), bf_hi(a.z), bf_lo(a.w), bf_hi(a.w)};
#pragma unroll
                        for (int e = 0; e < 4; ++e) { acc[ai][bj][m][0][e] *= a0[e] * __builtin_amdgcn_rcpf(g0[e]); acc[ai][bj][m][1][e] *= a1[e] * __builtin_amdgcn_rcpf(g1[e]); } }
                    else { const f32x4 v0 = acc[ai][bj][m][0] * g0, v1 = acc[ai][bj][m][1] * g1;
                        u32x4 w; w.x = cvt_pk_bf16(v0.x, v0.y); w.y = cvt_pk_bf16(v0.z, v0.w); w.z = cvt_pk_bf16(v1.x, v1.y); w.w = cvt_pk_bf16(v1.z, v1.w);
                        *(u32x4*)(Mx + off) = w; } }
            asm volatile("" ::: "memory"); }
    }
};

struct EpiE {
    static constexpr bool PERM = true, AFTER_DRAIN = false, SEG = false; static constexpr int NST = 16;
    bf16_t* E; float* ss;
    __device__ __forceinline__ void operator()(const f32x4 (&acc)[2][2][4][2], const Unit& u, int wr, int wc, int fr, int fq) const {
        const int row0 = u.pm * BM + wr * 64 + fr, col0 = u.pn * BM + wc * 32 + 8 * fq;
#pragma unroll
        for (int ai = 0; ai < 2; ++ai)
#pragma unroll
            for (int m = 0; m < 4; ++m) { const int row = row0 + ai * HALF + m * 16; float s = 0.f;
#pragma unroll
                for (int bj = 0; bj < 2; ++bj) { const f32x4 c0 = acc[ai][bj][m][0], c1 = acc[ai][bj][m][1];
                    s += ((c0.x * c0.x + c0.y * c0.y) + (c0.z * c0.z + c0.w * c0.w)) + ((c1.x * c1.x + c1.y * c1.y) + (c1.z * c1.z + c1.w * c1.w));
                    u32x4 w; w.x = cvt_pk_bf16(c0.x, c0.y); w.y = cvt_pk_bf16(c0.z, c0.w); w.z = cvt_pk_bf16(c1.x, c1.y); w.w = cvt_pk_bf16(c1.z, c1.w);
                    *(u32x4*)(E + (size_t)row * DMODEL + col0 + bj * HALF) = w; }
                s += __shfl_xor(s, 16); s += __shfl_xor(s, 32);
                if (fq == 0) ss[(size_t)row * 16 + u.pn * 4 + wc] = s; }
    }
};

struct EpiFinal {
    static constexpr bool PERM = true, AFTER_DRAIN = false, SEG = false; static constexpr int NST = 40;
    float* out; const bf16_t* hb; const bf16_t* E; const float* ss; const float* sse; const float* gpost;
    __device__ __forceinline__ void operator()(const f32x4 (&acc)[2][2][4][2], const Unit& u, int wr, int wc, int fr, int fq) const {
        const int row0 = u.pm * BM + wr * 64 + fr, col0 = u.pn * BM + wc * 32 + 8 * fq;
        f32x4 gv[2][2]; float rs[2][4], re[2][4];
#pragma unroll
        for (int bj = 0; bj < 2; ++bj)
#pragma unroll
            for (int n = 0; n < 2; ++n) gv[bj][n] = *(const f32x4*)(gpost + col0 + bj * HALF + n * 4);
        load_rstd8(ss, row0, fq, rs); load_rstd8(sse, row0, fq, re);
#pragma unroll
        for (int ai = 0; ai < 2; ++ai)
#pragma unroll
        for (int mp = 0; mp < 2; ++mp) {
            u32x4 hw[2][2], ew[2][2];
#pragma unroll
            for (int mm = 0; mm < 2; ++mm)
#pragma unroll
                for (int bj = 0; bj < 2; ++bj) { const size_t off = (size_t)(row0 + ai * HALF + (2 * mp + mm) * 16) * DMODEL + col0 + bj * HALF; hw[mm][bj] = *(const u32x4*)(hb + off); ew[mm][bj] = *(const u32x4*)(E + off); }
            asm volatile("" ::: "memory");
#pragma unroll
            for (int mm = 0; mm < 2; ++mm) { const int m = 2 * mp + mm; const float r = rs[ai][m], q = re[ai][m];
#pragma unroll
                for (int bj = 0; bj < 2; ++bj) { const size_t off = (size_t)(row0 + ai * HALF + m * 16) * DMODEL + col0 + bj * HALF; const u32x4 h = hw[mm][bj], ee = ew[mm][bj];
                    const f32x4 h0 = (f32x4){bf_lo(h.x), bf_hi(h.x), bf_lo(h.y), bf_hi(h.y)}, h1 = (f32x4){bf_lo(h.z), bf_hi(h.z), bf_lo(h.w), bf_hi(h.w)};
                    const f32x4 e0 = (f32x4){bf_lo(ee.x), bf_hi(ee.x), bf_lo(ee.y), bf_hi(ee.y)} * q * gv[bj][0], e1 = (f32x4){bf_lo(ee.z), bf_hi(ee.z), bf_lo(ee.w), bf_hi(ee.w)} * q * gv[bj][1];
                    const f32x4 a0 = acc[ai][bj][m][0] * r, a1 = acc[ai][bj][m][1] * r; f32x4 y0, y1;
#pragma unroll
                    for (int e = 0; e < 4; ++e) { y0[e] = h0[e] + sigm(a0[e]) * e0[e]; y1[e] = h1[e] + sigm(a1[e]) * e1[e]; }
                    *(f32x4*)(out + off) = y0; *(f32x4*)(out + off + 4) = y1; } }
            asm volatile("" ::: "memory"); }
    }
};

template <class Epi, class Sched, bool ALIGN_EPI = false, bool SP2 = false>
__device__ __forceinline__ void gemm_phase(PG8_LAS unsigned char* lds, const Gemm g, const Sched& S, const Epi& E) {
    int tid = threadIdx.x; asm volatile("" : "+v"(tid));
    const int wid = __builtin_amdgcn_readfirstlane(tid >> 6), lane = tid & 63, wr = wid >> 2, wc = wid & 3, fr = lane & 15, fq = lane >> 4;
    const int K = g.K, nt = K / BK;
    unsigned voffA[2], voffB[2];
#pragma unroll
    for (int i = 0; i < 2; ++i) { int R, C; stage_rc(tid * 16 + i * 8192, R, C); const int Rb = Epi::PERM ? ((R & ~31) + perm32(R & 31)) : R;
        voffA[i] = (unsigned)(R * K + C) * 2u; voffB[i] = (unsigned)(Rb * K + C) * 2u; }
    const size_t kstep = (size_t)(BK * 2);
    const size_t hstep = (size_t)HALF * K * 2;
    const size_t tstep = 2 * hstep;
    const unsigned ldsw = (unsigned)wid * 1024u;
    const unsigned ldsb = (unsigned)__builtin_amdgcn_readfirstlane((int)((unsigned)(uintptr_t)lds + ldsw));
    const int aoff = lds_byte(wr * 64 + fr, fq * 8), boff = lds_byte(wc * 32 + fr, fq * 8);
#define PG8_SA(b, h) (((b) * 2 + (h)) * HTB)
#define PG8_SB(b, h) ((4 + (b) * 2 + (h)) * HTB)
#ifndef PG8_B_AUX
#define PG8_B_AUX 0
#endif
#define PG8_STAGE_X(bufoff, gbase, voff, AUX) do { _Pragma("unroll") for (int _i = 0; _i < 2; ++_i) { unsigned keep_; \
        asm volatile("s_mov_b32 %0, m0\n\ts_mov_b32 m0, %1\n\ts_nop 0\n\tglobal_load_lds_dwordx4 %2, %3\n\ts_mov_b32 m0, %0" : "=&s"(keep_) : "s"(ldsb + (unsigned)((bufoff) + _i * 8192)), "v"((voff)[_i]), "s"((const char*)(gbase)) : "memory"); } } while (0)
#define PG8_STAGE(bufoff, gbase, voff) PG8_STAGE_X(bufoff, gbase, voff, 0)
#define PG8_LDA(dst, b, h) do { _Pragma("unroll") for (int m = 0; m < 4; ++m) _Pragma("unroll") for (int k = 0; k < 2; ++k) dst[m][k] = *(const PG8_LAS bf16x8*)(lds + PG8_SA(b, h) + aoff + m * 2048 + k * 1024); } while (0)
#define PG8_LDB(dst, b, h) do { _Pragma("unroll") for (int n = 0; n < 2; ++n) _Pragma("unroll") for (int k = 0; k < 2; ++k) dst[n][k] = *(const PG8_LAS bf16x8*)(lds + PG8_SB(b, h) + boff + n * 2048 + k * 1024); } while (0)
#define PG8_MMA(ai, bj, At, Bt) do { __builtin_amdgcn_s_setprio(1); _Pragma("unroll") for (int m = 0; m < 4; ++m) _Pragma("unroll") for (int n = 0; n < 2; ++n) _Pragma("unroll") for (int k = 0; k < 2; ++k) \
        acc[ai][bj][m][n] = __builtin_amdgcn_mfma_f32_16x16x32_bf16(Bt[n][k], At[m][k], acc[ai][bj][m][n], 0, 0, 0); __builtin_amdgcn_s_setprio(0); } while (0)
#define PG8_WAIT_V(n) asm volatile("s_waitcnt vmcnt(" #n ")" ::: "memory")
#define PG8_WAIT_L(n) asm volatile("s_waitcnt lgkmcnt(" #n ")" ::: "memory")
#define PG8_WAIT_VN(n) asm volatile("s_waitcnt vmcnt(%0)" :: "n"(n) : "memory")
#define PG8_BAR __builtin_amdgcn_s_barrier()
#define PG8_SCHED __builtin_amdgcn_sched_barrier(0)
    Unit cur, nxt; int ui = 0;
    if (!S.next(0, cur)) return;
    f32x4 acc[2][2][4][2];
#pragma unroll
    for (int a = 0; a < 2; ++a)
#pragma unroll
        for (int b = 0; b < 2; ++b)
#pragma unroll
            for (int m = 0; m < 4; ++m)
#pragma unroll
                for (int n = 0; n < 2; ++n) acc[a][b][m][n] = (f32x4){0.f, 0.f, 0.f, 0.f};
    bf16x8 At[4][2], B0[2][2], B1[2][2];
    const char* cA = (const char*)g.A + (size_t)cur.pm * tstep + (size_t)cur.seg * g.dA; const char* cB = (const char*)g.Bt + (size_t)cur.pn * tstep + (size_t)cur.seg * g.dB;
    S.a_ready(cur);
    if constexpr (SP2) {
        PG8_STAGE_X(PG8_SB(0, 0), cB, voffB, PG8_B_AUX); PG8_STAGE_X(PG8_SB(0, 1), cB + hstep, voffB, PG8_B_AUX); PG8_STAGE(PG8_SA(0, 0), cA, voffA); PG8_STAGE(PG8_SA(0, 1), cA + hstep, voffA);
        if (wr == 1) PG8_BAR;
        PG8_WAIT_V(2); PG8_BAR;
        PG8_STAGE_X(PG8_SB(1, 0), cB + kstep, voffB, PG8_B_AUX); PG8_STAGE(PG8_SA(1, 0), cA + kstep, voffA); PG8_STAGE_X(PG8_SB(1, 1), cB + hstep + kstep, voffB, PG8_B_AUX);
        PG8_WAIT_V(6); PG8_BAR;
    } else {
        PG8_STAGE_X(PG8_SB(0, 0), cB, voffB, PG8_B_AUX); PG8_STAGE(PG8_SA(0, 0), cA, voffA); PG8_STAGE_X(PG8_SB(0, 1), cB + hstep, voffB, PG8_B_AUX); PG8_STAGE(PG8_SA(0, 1), cA + hstep, voffA);
        if (wr == 1) PG8_BAR;
        PG8_WAIT_V(4); PG8_BAR;
        PG8_STAGE_X(PG8_SB(1, 0), cB + kstep, voffB, PG8_B_AUX); PG8_STAGE(PG8_SA(1, 0), cA + kstep, voffA); PG8_STAGE_X(PG8_SB(1, 1), cB + hstep + kstep, voffB, PG8_B_AUX);
        PG8_WAIT_V(6); PG8_BAR;
    }
    for (;;) {
        const bool has_next = S.next(ui + 1, nxt);
        const char* nA = has_next ? (const char*)g.A + (size_t)nxt.pm * tstep + (size_t)nxt.seg * g.dA : cA; const char* nB = has_next ? (const char*)g.Bt + (size_t)nxt.pn * tstep + (size_t)nxt.seg * g.dB : cB;
#pragma unroll 1
        for (int t = 0; t < nt; t += 2) {
            const bool last = (t == nt - 2);
            const char* a1 = cA + (size_t)(t + 1) * kstep;
            const char* a2 = last ? nA : cA + (size_t)(t + 2) * kstep; const char* b2 = last ? nB : cB + (size_t)(t + 2) * kstep;
            const char* a3 = a2 + kstep; const char* b3 = b2 + kstep;
            if (last && has_next) S.a_ready(nxt);
            if constexpr (SP2) {
            const bool after_epi = (t == 0) && (ui > 0);
            PG8_LDB(B0, 0, 0); PG8_LDB(B1, 0, 1); PG8_SCHED; PG8_LDA(At, 0, 0); PG8_STAGE(PG8_SA(1, 1), a1 + hstep, voffA);
            if (after_epi) { PG8_WAIT_VN(8 + Epi::NST); } else { PG8_WAIT_V(8); } PG8_WAIT_L(0); PG8_BAR; PG8_MMA(0, 0, At, B0); PG8_MMA(0, 1, At, B1); PG8_BAR; PG8_SCHED;
            PG8_LDA(At, 0, 1); PG8_STAGE_X(PG8_SB(0, 0), b2, voffB, PG8_B_AUX); PG8_STAGE_X(PG8_SB(0, 1), b2 + hstep, voffB, PG8_B_AUX); PG8_STAGE(PG8_SA(0, 0), a2, voffA);
            if (after_epi) { PG8_WAIT_VN(8 + Epi::NST); } else { PG8_WAIT_V(8); } PG8_WAIT_L(0); PG8_BAR; PG8_MMA(1, 0, At, B0); PG8_MMA(1, 1, At, B1); PG8_BAR; PG8_SCHED;
            PG8_LDB(B0, 1, 0); PG8_LDB(B1, 1, 1); PG8_SCHED; PG8_LDA(At, 1, 0); PG8_STAGE(PG8_SA(0, 1), a2 + hstep, voffA);
            PG8_WAIT_V(8); PG8_WAIT_L(0); PG8_BAR; PG8_MMA(0, 0, At, B0); PG8_MMA(0, 1, At, B1); PG8_BAR; PG8_SCHED;
            PG8_LDA(At, 1, 1); PG8_STAGE_X(PG8_SB(1, 0), b3, voffB, PG8_B_AUX); PG8_STAGE_X(PG8_SB(1, 1), b3 + hstep, voffB, PG8_B_AUX); PG8_STAGE(PG8_SA(1, 0), a3, voffA);
            PG8_WAIT_V(8); PG8_WAIT_L(0); PG8_BAR; PG8_MMA(1, 0, At, B0); PG8_MMA(1, 1, At, B1); PG8_BAR; PG8_SCHED;
            } else {
            PG8_LDB(B0, 0, 0); PG8_SCHED; PG8_LDA(At, 0, 0); PG8_STAGE(PG8_SA(1, 1), a1 + hstep, voffA);
            PG8_WAIT_L(8); PG8_BAR; PG8_WAIT_L(0); PG8_MMA(0, 0, At, B0); PG8_BAR; PG8_SCHED;
            PG8_LDB(B1, 0, 1); PG8_STAGE_X(PG8_SB(0, 0), b2, voffB, PG8_B_AUX);
            PG8_BAR; PG8_WAIT_L(0); PG8_MMA(0, 1, At, B1); PG8_BAR;
            PG8_LDA(At, 0, 1); PG8_STAGE(PG8_SA(0, 0), a2, voffA);
            PG8_BAR; PG8_WAIT_L(0); PG8_MMA(1, 0, At, B0); PG8_BAR; PG8_SCHED;
            PG8_STAGE_X(PG8_SB(0, 1), b2 + hstep, voffB, PG8_B_AUX);
            PG8_WAIT_V(6); PG8_BAR; PG8_MMA(1, 1, At, B1); PG8_BAR;
            PG8_LDB(B0, 1, 0); PG8_SCHED; PG8_LDA(At, 1, 0); PG8_STAGE(PG8_SA(0, 1), a2 + hstep, voffA);
            PG8_WAIT_L(8); PG8_BAR; PG8_WAIT_L(0); PG8_MMA(0, 0, At, B0); PG8_BAR; PG8_SCHED;
            PG8_LDB(B1, 1, 1); PG8_STAGE_X(PG8_SB(1, 0), b3, voffB, PG8_B_AUX);
            PG8_BAR; PG8_WAIT_L(0); PG8_MMA(0, 1, At, B1); PG8_BAR;
            PG8_LDA(At, 1, 1); PG8_STAGE(PG8_SA(1, 0), a3, voffA);
            PG8_BAR; PG8_WAIT_L(0); PG8_MMA(1, 0, At, B0); PG8_BAR; PG8_SCHED;
            PG8_STAGE_X(PG8_SB(1, 1), b3 + hstep, voffB, PG8_B_AUX);
            PG8_WAIT_V(6); PG8_BAR; PG8_MMA(1, 1, At, B1); PG8_BAR;
            }
        }
        if constexpr (ALIGN_EPI) { if (wr == 0) PG8_BAR; }
        if constexpr (!Epi::AFTER_DRAIN) { E(acc, cur, wr, wc, fr, fq); S.done(cur); }
        if (!has_next) break;
        if (!(Epi::SEG && cur.seg == 0))
#pragma unroll
        for (int a = 0; a < 2; ++a)
#pragma unroll
            for (int b = 0; b < 2; ++b)
#pragma unroll
                for (int m = 0; m < 4; ++m)
#pragma unroll
                    for (int n = 0; n < 2; ++n) acc[a][b][m][n] = (f32x4){0.f, 0.f, 0.f, 0.f};
        cur = nxt; cA = nA; cB = nB; ++ui;
        if constexpr (ALIGN_EPI) { if (wr == 1) PG8_BAR; }
    }
    PG8_WAIT_V(0);
    if constexpr (!ALIGN_EPI) { if (wr == 0) PG8_BAR; }
    PG8_BAR;
    if constexpr (Epi::AFTER_DRAIN) { E.fused(acc, cur, wr, wc, fr, fq, lds, wid, lane); S.done(cur); }
#undef PG8_SA
#undef PG8_SB
#undef PG8_STAGE
#undef PG8_STAGE_X
#undef PG8_LDA
#undef PG8_LDB
#undef PG8_MMA
#undef PG8_WAIT_V
#undef PG8_WAIT_L
#undef PG8_WAIT_VN
#undef PG8_BAR
#undef PG8_SCHED
}
}
#include <hip/hip_bf16.h>
#include <cmath>
namespace attn_body {
using bf16=__hip_bfloat16;
using bf16x8=__attribute__((ext_vector_type(8)))short;
using s16x4=__attribute__((ext_vector_type(4)))short;
using f32x16=__attribute__((ext_vector_type(16)))float;
using u32x4=__attribute__((ext_vector_type(4)))unsigned;
constexpr int D=64,QP=512,KP=128;
constexpr int NW=8,QBLK=32,QB=QBLK*NW,KVBLK=64;
constexpr int ATTN_UNIT_ROWS=QB;
__device__ __forceinline__ int crow(int r,int hi){return (r&3)+8*(r>>2)+4*hi;}
#define SBAR() __builtin_amdgcn_sched_barrier(0)
__device__ __forceinline__ void cmask(f32x16&p0,f32x16&p1,int jb,int qrel,int hi){
  const float NEG=-INFINITY; int kb=64*jb+4*hi;
  #pragma unroll
  for(int r=0;r<16;++r){int kv=kb+(r&3)+8*(r>>2); if(kv>qrel)p0[r]=NEG; if(kv+32>qrel)p1[r]=NEG;}
}

constexpr int NSLOT=3, SLOTB=8192;
constexpr int LDS_K=0, LDS_V=NSLOT*SLOTB, LDS_WS=2*NSLOT*SLOTB, LDS_OST=LDS_WS+NW*64*4, LDS_BYTES=LDS_OST+NW*4096;
constexpr float C2=0.125f*1.4426950408889634f;
__device__ __forceinline__ void glds16(const void*gsrc,unsigned lds_dst){unsigned keep;
  asm volatile("s_mov_b32 %0, m0\n\ts_mov_b32 m0, %2\n\ts_nop 0\n\tglobal_load_lds_dwordx4 %1, off\n\ts_mov_b32 m0, %0":"=&s"(keep):"v"(gsrc),"s"(lds_dst):"memory");}
__device__ __forceinline__ float max3f(float a,float b,float c){float r;asm("v_max3_f32 %0, %1, %2, %3":"=v"(r):"v"(a),"v"(b),"v"(c));return r;}
__device__ __forceinline__ float max2f(float a,float b){float r;asm("v_max_f32_e32 %0, %1, %2":"=v"(r):"v"(a),"v"(b));return r;}
__device__ __forceinline__ float fadd_s(float a,float b){float r;asm("v_add_f32_e32 %0, %1, %2":"=v"(r):"v"(a),"v"(b));return r;}
__device__ __forceinline__ float fsub_s(float a,float b){float r;asm("v_sub_f32_e32 %0, %1, %2":"=v"(r):"v"(a),"v"(b));return r;}
typedef float f32x2_t __attribute__((ext_vector_type(2))); typedef __bf16 bf16x2_t __attribute__((ext_vector_type(2)));
__device__ __forceinline__ unsigned cvtpk_s(float lo,float hi){f32x2_t v={lo,hi};bf16x2_t b=__builtin_convertvector(v,bf16x2_t);return __builtin_bit_cast(unsigned,b);}
#define WAIT_BAR(N) asm volatile("s_waitcnt vmcnt(" #N ") lgkmcnt(0)\n\ts_barrier":::"memory")

__device__ __forceinline__ void qkt(f32x16&p0,f32x16&p1,const char*Kslot,const bf16x8*qr,const f32x16&negm,int r32,int hi){
  const char*kb=Kslot+hi*1024+r32*16;
  #pragma unroll
  for(int d0=0;d0<4;++d0){
    const bf16x8 b0=*reinterpret_cast<const bf16x8*>(kb+d0*2048);
    const bf16x8 b1=*reinterpret_cast<const bf16x8*>(kb+d0*2048+512);
    if(d0==0){p0=__builtin_amdgcn_mfma_f32_32x32x16_bf16(b0,qr[0],negm,0,0,0);p1=__builtin_amdgcn_mfma_f32_32x32x16_bf16(b1,qr[0],negm,0,0,0);}
    else{p0=__builtin_amdgcn_mfma_f32_32x32x16_bf16(b0,qr[d0],p0,0,0,0);p1=__builtin_amdgcn_mfma_f32_32x32x16_bf16(b1,qr[d0],p1,0,0,0);}}
}
typedef __attribute__((address_space(3))) const char* lds_cptr;
typedef short v4i16_t __attribute__((ext_vector_type(4)));
__device__ __forceinline__ void kload8(bf16x8*kf,lds_cptr kp){
  kf[0]=*(const __attribute__((address_space(3))) bf16x8*)(kp);      kf[1]=*(const __attribute__((address_space(3))) bf16x8*)(kp+512);
  kf[2]=*(const __attribute__((address_space(3))) bf16x8*)(kp+2048); kf[3]=*(const __attribute__((address_space(3))) bf16x8*)(kp+2560);
  kf[4]=*(const __attribute__((address_space(3))) bf16x8*)(kp+4096); kf[5]=*(const __attribute__((address_space(3))) bf16x8*)(kp+4608);
  kf[6]=*(const __attribute__((address_space(3))) bf16x8*)(kp+6144); kf[7]=*(const __attribute__((address_space(3))) bf16x8*)(kp+6656);
}
__device__ __forceinline__ void kload2(bf16x8*kf,lds_cptr kp,int j){ kf[2*j]=*(const __attribute__((address_space(3))) bf16x8*)(kp+j*2048); kf[2*j+1]=*(const __attribute__((address_space(3))) bf16x8*)(kp+j*2048+512); }
__device__ __forceinline__ s16x4 vtr(lds_cptr p){ return __builtin_bit_cast(s16x4,__builtin_amdgcn_ds_read_tr16_b64_v4i16((__attribute__((address_space(3))) v4i16_t*)p)); }
__device__ __forceinline__ float rowmax(const f32x16&p0,const f32x16&p1){
  float a=max3f(p0[0],p0[1],p1[0]),b=max3f(p0[2],p0[3],p1[1]);a=max3f(a,p1[2],p1[3]);
  #pragma unroll
  for(int r=4;r<16;r+=4){a=max3f(a,p0[r],p0[r+1]);b=max3f(b,p0[r+2],p0[r+3]);a=max3f(a,p1[r],p1[r+1]);b=max3f(b,p1[r+2],p1[r+3]);}
  const float m=max2f(a,b);
  auto rr=__builtin_amdgcn_permlane32_swap(__float_as_uint(m),__float_as_uint(m),false,false);
  return max2f(__uint_as_float(rr[0]),__uint_as_float(rr[1]));
}
__device__ __forceinline__ void pv(f32x16*o,int vb,bf16x8 pa0,bf16x8 pa1,bf16x8 pa2,bf16x8 pa3){
  #pragma unroll
  for(int d0=0;d0<2;++d0){s16x4 lo[4],hi[4];
    #pragma unroll
    for(int ks=0;ks<4;++ks){
      asm volatile("ds_read_b64_tr_b16 %0,%1 offset:%c2":"=&v"(lo[ks]):"v"(vb),"i"(d0*4096+ks*1024):"memory");
      asm volatile("ds_read_b64_tr_b16 %0,%1 offset:%c2":"=&v"(hi[ks]):"v"(vb),"i"(d0*4096+ks*1024+512):"memory");}
    asm volatile("s_waitcnt lgkmcnt(0)":::"memory");SBAR();
    #define PK(k) (bf16x8){lo[k][0],lo[k][1],lo[k][2],lo[k][3],hi[k][0],hi[k][1],hi[k][2],hi[k][3]}
    o[d0]=__builtin_amdgcn_mfma_f32_32x32x16_bf16(pa0,PK(0),o[d0],0,0,0);
    o[d0]=__builtin_amdgcn_mfma_f32_32x32x16_bf16(pa1,PK(1),o[d0],0,0,0);
    o[d0]=__builtin_amdgcn_mfma_f32_32x32x16_bf16(pa2,PK(2),o[d0],0,0,0);
    o[d0]=__builtin_amdgcn_mfma_f32_32x32x16_bf16(pa3,PK(3),o[d0],0,0,0);
    #undef PK
  }
}

#ifndef ATTN_STORE16
#define ATTN_STORE16(p,v) (*(u32x4*)(p)=(v))
#endif
template<int THRL> __device__ __forceinline__ void attn_unit(long rowbase,int h,int qb,int NT,const bf16*Q,const bf16*__restrict__ K,const bf16*__restrict__ V,bf16*O,char*shm){
  int tid=threadIdx.x; asm volatile("":"+v"(tid)); const int lane=tid&63,r32=lane&31,hi=lane>>5; const int wid=__builtin_amdgcn_readfirstlane(tid>>6);
  const int q0=qb*QB;
  const bf16*Qw=Q+(rowbase+q0+wid*QBLK)*QP+h*D;
  const bf16*Kh=K+rowbase*KP+(h>>2)*D,*Vh=V+rowbase*KP+(h>>2)*D;
  const unsigned lds0=(unsigned)(uintptr_t)shm;
  float*wsf=(float*)(shm+LDS_WS)+wid*64;
  const bf16*ksrc=Kh+(long)lane*KP+wid*8;
  const bf16*vsrc=Vh+(long)(16*(wid&3)+(lane>>2))*KP+(wid>>2)*32+(lane&3)*8;
  const unsigned kdst=lds0+LDS_K+wid*1024, vdst=lds0+LDS_V+wid*1024;
  #define DMA_K(t,slot) glds16(ksrc+(long)(t)*KVBLK*KP,(unsigned)__builtin_amdgcn_readfirstlane(kdst+(slot)))
  #define DMA_V(t,slot) glds16(vsrc+(long)(t)*KVBLK*KP,(unsigned)__builtin_amdgcn_readfirstlane(vdst+(slot)))
  const int vb0=(int)(lds0+LDS_V)+((lane>>4)&1)*32+(lane&3)*8+(4*hi+((lane&15)>>2))*64;
  const char*Kbase=shm+LDS_K; bf16x8 kf[8];
  const lds_cptr shm3=(lds_cptr)shm; const lds_cptr kp0=shm3+LDS_K+hi*1024+r32*16; const lds_cptr vp0=shm3+LDS_V+((lane>>4)&1)*32+(lane&3)*8+(4*hi+((lane&15)>>2))*64;
  DMA_K(0,0);DMA_V(0,0);DMA_K(1,SLOTB);
  bf16x8 qr[4];
  #pragma unroll
  for(int d0=0;d0<4;++d0)qr[d0]=*reinterpret_cast<const bf16x8*>(&Qw[(long)r32*QP+d0*16+hi*8]);
  float mhat=0.f,l_reg=0.f;f32x16 o[2];o[0]=f32x16{};o[1]=f32x16{};f32x16 negm=f32x16{};asm volatile("":"+v"(negm));
    #define CMASK(P0,P1,t) do{}while(0)
  bool resc=false;
  #define START(P0,P1) do{ const float rm=rowmax(P0,P1); resc=false; \
    { const float dl=rm; mhat=fadd_s(mhat,dl); \
      _Pragma("unroll") for(int r=0;r<16;++r){P0[r]=fsub_s(P0[r],dl);P1[r]=fsub_s(P1[r],dl);} \
      _Pragma("unroll") for(int r=0;r<16;++r)negm[r]=-mhat; asm volatile("":"+v"(negm)); } \
    _Pragma("unroll") for(int r=0;r<16;++r)P0[r]=__builtin_amdgcn_exp2f(P0[r]); }while(0)
  #define RESC() do{ if(resc){ asm volatile("s_waitcnt lgkmcnt(0)":::"memory"); \
      _Pragma("unroll") for(int d_=0;d_<2;++d_) _Pragma("unroll") for(int r=0;r<16;++r)o[d_][r]*=wsf[crow(r,hi)]; } }while(0)
  f32x16 pA0,pA1,pB0,pB1;
  int sl_prev=0,sl_cur=0,sl_next=SLOTB;
  #define ROT() do{sl_prev=sl_cur;sl_cur=sl_next;sl_next=(sl_next==(NSLOT-1)*SLOTB)?0:sl_next+SLOTB;}while(0)
  DMA_K(2,2*SLOTB);
  WAIT_BAR(3);
  qkt(pA0,pA1,Kbase,qr,negm,r32,hi);asm volatile("s_nop 15\n\ts_nop 7":"+v"(pA0),"+v"(pA1));CMASK(pA0,pA1,0);
  START(pA0,pA1);
  _Pragma("unroll") for(int r=0;r<16;++r)pA1[r]=__builtin_amdgcn_exp2f(pA1[r]);
  WAIT_BAR(0);
  DMA_K(3,0);DMA_V(1,SLOTB);
  ROT();
  kload8(kf,kp0+sl_cur);
  WAIT_BAR(2);
  s16x4 vlo[8],vhi[8]; u32x4 pw0,pw1,pw2,pw3;
  #define PKW(P,B) cvtpk_s(P[B],P[B+1])
  #define PAF(k) __builtin_bit_cast(bf16x8,pw##k)
  #define VFR(i) (bf16x8){vlo[i][0],vlo[i][1],vlo[i][2],vlo[i][3],vhi[i][0],vhi[i][1],vhi[i][2],vhi[i][3]}
  #define PIN(x) asm volatile("":"+v"(x))
  #define MX3(a,b,c) __builtin_fmaxf(__builtin_fmaxf((a),(b)),(c))
  #define GAPA(MF,A0,A1,A2,A3,W0,W1,PW) do{ MF; sacc+=A0; sacc+=A1; sacc+=A2; sacc+=A3; PIN(sacc); W0; W1; PIN(PW); SBAR(); }while(0)
  #define EX(v) __builtin_amdgcn_exp2f(v)
  #define GAPB(MF,X,B) do{ MF; X[B]=EX(X[B]); X[B+1]=EX(X[B+1]); X[B+2]=EX(X[B+2]); X[B+3]=EX(X[B+3]); PIN(X); SBAR(); }while(0)
  #define VRD(i) do{ vlo[i]=vtr(vp_+(((i)>>2)*4096+((i)&3)*1024)); vhi[i]=vtr(vp_+(((i)>>2)*4096+((i)&3)*1024+512)); }while(0)
  #define KRD(G,j) do{ if(G){ kload2(kf,kp0+sl_next,j); SBAR(); } }while(0)
  #define STEP(C0,C1,P0,P1,t,GK,GV,GL) do{ SBAR(); \
    const lds_cptr vp_=vp0+sl_prev; \
    VRD(0); SBAR(); float sacc=(P0[0]+P0[1]); \
    GAPA(C0=__builtin_amdgcn_mfma_f32_32x32x16_bf16(kf[0],qr[0],negm,0,0,0), P0[2],P0[3],P0[4],P0[5],     pw0[0]=PKW(P0,0), pw0[1]=PKW(P0,2), pw0); \
    VRD(4); SBAR(); GAPA(C1=__builtin_amdgcn_mfma_f32_32x32x16_bf16(kf[1],qr[0],negm,0,0,0), P0[6],P0[7],P0[8],P0[9],     pw0[2]=PKW(P0,4), pw0[3]=PKW(P0,6), pw0); \
    VRD(1); SBAR(); GAPA(C0=__builtin_amdgcn_mfma_f32_32x32x16_bf16(kf[2],qr[1],C0,0,0,0),   P0[10],P0[11],P0[12],P0[13], pw1[0]=PKW(P0,8), pw1[1]=PKW(P0,10), pw1); \
    VRD(5); SBAR(); GAPA(C1=__builtin_amdgcn_mfma_f32_32x32x16_bf16(kf[3],qr[1],C1,0,0,0),   P0[14],P0[15],P1[0],P1[1],   pw1[2]=PKW(P0,12),pw1[3]=PKW(P0,14), pw1); \
    VRD(2); SBAR(); GAPA(C0=__builtin_amdgcn_mfma_f32_32x32x16_bf16(kf[4],qr[2],C0,0,0,0),   P1[2],P1[3],P1[4],P1[5],     pw2[0]=PKW(P1,0), pw2[1]=PKW(P1,2), pw2); \
    VRD(6); SBAR(); GAPA(C1=__builtin_amdgcn_mfma_f32_32x32x16_bf16(kf[5],qr[2],C1,0,0,0),   P1[6],P1[7],P1[8],P1[9],     pw2[2]=PKW(P1,4), pw2[3]=PKW(P1,6), pw2); \
    VRD(3); SBAR(); GAPA(C0=__builtin_amdgcn_mfma_f32_32x32x16_bf16(kf[6],qr[3],C0,0,0,0),   P1[10],P1[11],P1[12],P1[13], pw3[0]=PKW(P1,8), pw3[1]=PKW(P1,10), pw3); \
    VRD(7); SBAR(); GAPA(C1=__builtin_amdgcn_mfma_f32_32x32x16_bf16(kf[7],qr[3],C1,0,0,0),   P1[14],P1[15],0.f,0.f,       pw3[2]=PKW(P1,12),pw3[3]=PKW(P1,14), pw3); \
    l_reg+=sacc; \
    if(GK){DMA_K((t)+3,sl_cur);} if(GV){DMA_V((t)+1,sl_next);} \
    CMASK(C0,C1,t); \
    { float a=MX3(C0[0],C0[1],C1[0]),b=MX3(C0[2],C0[3],C1[1]); a=MX3(a,C1[2],C1[3]); \
      _Pragma("unroll") for(int r=4;r<16;r+=4){a=MX3(a,C0[r],C0[r+1]);b=MX3(b,C0[r+2],C0[r+3]);a=MX3(a,C1[r],C1[r+1]);b=MX3(b,C1[r+2],C1[r+3]);} \
      float rm=__builtin_fmaxf(a,b); { auto rr=__builtin_amdgcn_permlane32_swap(__float_as_uint(rm),__float_as_uint(rm),false,false); rm=__builtin_fmaxf(__uint_as_float(rr[0]),__uint_as_float(rr[1])); } \
      resc=false; \
      if(__builtin_expect(__any(rm>(float)THRL),0)){ const float dl=__builtin_fmaxf(rm,0.f); mhat+=dl; \
        _Pragma("unroll") for(int r=0;r<16;++r){C0[r]-=dl;C1[r]-=dl;} \
        _Pragma("unroll") for(int r=0;r<16;++r)negm[r]=-mhat; asm volatile("":"+v"(negm)); \
        const float f=__builtin_amdgcn_exp2f(-dl); l_reg*=f; if(hi==0)wsf[r32]=f; resc=true; } } \
    SBAR(); \
    GAPB(o[0]=__builtin_amdgcn_mfma_f32_32x32x16_bf16(PAF(0),VFR(0),o[0],0,0,0), C0,0); \
    GAPB(o[1]=__builtin_amdgcn_mfma_f32_32x32x16_bf16(PAF(0),VFR(4),o[1],0,0,0), C0,4); \
    KRD(GL,0); GAPB(o[0]=__builtin_amdgcn_mfma_f32_32x32x16_bf16(PAF(1),VFR(1),o[0],0,0,0), C0,8); \
    KRD(GL,1); GAPB(o[1]=__builtin_amdgcn_mfma_f32_32x32x16_bf16(PAF(1),VFR(5),o[1],0,0,0), C0,12); \
    KRD(GL,2); GAPB(o[0]=__builtin_amdgcn_mfma_f32_32x32x16_bf16(PAF(2),VFR(2),o[0],0,0,0), C1,0); \
    KRD(GL,3); GAPB(o[1]=__builtin_amdgcn_mfma_f32_32x32x16_bf16(PAF(2),VFR(6),o[1],0,0,0), C1,4); \
    GAPB(o[0]=__builtin_amdgcn_mfma_f32_32x32x16_bf16(PAF(3),VFR(3),o[0],0,0,0), C1,8); \
    GAPB(o[1]=__builtin_amdgcn_mfma_f32_32x32x16_bf16(PAF(3),VFR(7),o[1],0,0,0), C1,12); \
    }while(0)
  int t=1;
  #undef CMASK
  #define CMASK(P0,P1,t) do{}while(0)
  for(;t+5<NT;t+=2){
    STEP(pB0,pB1,pA0,pA1,t,true,true,true);     WAIT_BAR(2); RESC(); ROT();
    STEP(pA0,pA1,pB0,pB1,t+1,true,true,true);   WAIT_BAR(2); RESC(); ROT();
  }
  #undef CMASK
  #define CMASK(P0,P1,t) do{}while(0)
  #define ENDW(tt) do{ if((tt)+3<NT){WAIT_BAR(2);} else if((tt)+2<NT){WAIT_BAR(1);} else {WAIT_BAR(0);} }while(0)
  for(;t+1<NT;t+=2){
    STEP(pB0,pB1,pA0,pA1,t,(t+3<NT),(t+1<NT),(t+1<NT));       ENDW(t);   RESC(); ROT();
    STEP(pA0,pA1,pB0,pB1,t+1,(t+4<NT),(t+2<NT),(t+2<NT));     ENDW(t+1); RESC(); ROT();
  }
  STEP(pB0,pB1,pA0,pA1,NT-1,false,false,false); RESC();
  { float sacc=pB0[0]+pB0[1]; _Pragma("unroll") for(int r=2;r<16;++r)sacc+=pB0[r]; _Pragma("unroll") for(int r=0;r<16;++r)sacc+=pB1[r]; l_reg+=sacc;
    pw0=(u32x4){PKW(pB0,0),PKW(pB0,2),PKW(pB0,4),PKW(pB0,6)};pw1=(u32x4){PKW(pB0,8),PKW(pB0,10),PKW(pB0,12),PKW(pB0,14)};pw2=(u32x4){PKW(pB1,0),PKW(pB1,2),PKW(pB1,4),PKW(pB1,6)};pw3=(u32x4){PKW(pB1,8),PKW(pB1,10),PKW(pB1,12),PKW(pB1,14)};
    SBAR(); pv(o,vb0+sl_cur,PAF(0),PAF(1),PAF(2),PAF(3)); }
  #undef PKW
  #undef PAF
  #undef VFR
  #undef PIN
  #undef MX3
  #undef GAPA
  #undef GAPB
  #undef EX
  #undef VRD
  #undef KRD
  #undef STEP
  #undef ENDW
  {auto rr=__builtin_amdgcn_permlane32_swap(__float_as_uint(l_reg),__float_as_uint(l_reg),false,false);l_reg=__uint_as_float(rr[0])+__uint_as_float(rr[1]);}
  if(hi==0)wsf[32+r32]=l_reg;asm volatile("s_waitcnt lgkmcnt(0)":::"memory");
  float rli[16];
  #pragma unroll
  for(int r=0;r<16;++r)rli[r]=__builtin_amdgcn_rcpf(wsf[32+crow(r,hi)]);
  bf16*Ow=O+(rowbase+q0+wid*QBLK)*QP+h*D;
  { bf16*stg=(bf16*)(shm+LDS_OST)+wid*2048;
    #pragma unroll
    for(int r=0;r<16;++r){const int orow=crow(r,hi);
      #pragma unroll
      for(int d0=0;d0<2;++d0)stg[orow*64+d0*32+r32]=__float2bfloat16(o[d0][r]*rli[r]);}
    asm volatile("s_waitcnt lgkmcnt(0)":::"memory");
    #pragma unroll
    for(int i=0;i<4;++i){const int row=i*8+(lane>>3),ch=lane&7; const u32x4 v=*(const u32x4*)(stg+row*64+ch*8); ATTN_STORE16(Ow+(long)row*QP+ch*8,v);} }
  asm volatile("s_waitcnt lgkmcnt(0)\n\ts_barrier":::"memory");
  #undef DMA_K
  #undef DMA_V
  #undef CMASK
  #undef START
  #undef RESC
  #undef ROT
}
constexpr int ATTN_LDS_BYTES=LDS_BYTES;
struct AttnTensors { const bf16* Q; const bf16* K; const bf16* V; bf16* O; };
template<int THRL=8> __device__ __forceinline__ void attn_phase(char*lds,const AttnTensors&T,int vcu,int G){
  for(int i=0;;++i){
    int u;
    if(G==256){ if(i>=6)break; u=(i<4)?(4*vcu+i):(1024+2*vcu+(i-4)); }
    else{ u=vcu+i*G; if(u>=1536)break; }
    long rowbase; int h,qb,NT;
    if(u<1024){ const int bh=u>>5; qb=u&31; rowbase=(long)(bh>>3)*8192; h=bh&7; NT=128; }
    else { const int v=u-1024; const int bh=v>>4; qb=v&15; rowbase=32768+(long)(bh>>3)*4096; h=bh&7; NT=64; }
    attn_unit<THRL>(rowbase,h,qb,NT,T.Q,T.K,T.V,T.O,lds);
  }
}
#undef SBAR
#undef WAIT_BAR
}
#ifndef PH_MASK
#define PH_MASK 0x3ff
#endif
#define PH(k) if constexpr ((PH_MASK >> (k)) & 1)
constexpr int NWAVES = 8;
constexpr int RING_BYTES = 131072, LDS_BYTES = 147456;

#define LAS __attribute__((address_space(3)))
typedef unsigned short bf16;
typedef unsigned v4u __attribute__((ext_vector_type(4)));
typedef float f32x4 __attribute__((ext_vector_type(4)));
#define LDS_WAIT() asm volatile("s_waitcnt lgkmcnt(0)" ::: "memory")
__device__ __forceinline__ unsigned f2bf(float f) { unsigned u = __builtin_bit_cast(unsigned, f); return (u + 0x7fffu + ((u >> 16) & 1u)) >> 16; }
__device__ __forceinline__ unsigned pk2(float lo, float hi) { return f2bf(lo) | (f2bf(hi) << 16); }
__device__ __forceinline__ float wave_sum(float v) {
#pragma unroll
    for (int o = 1; o < 64; o <<= 1) v += __shfl_xor(v, o);
    return v;
}
__device__ __forceinline__ void transpose_item(const float* W, int ldw, int src_col0, int k0, bf16* WT, int K, int dst_row0, LAS float* scr, int lane, const float* gk = nullptr) {
    float tv[32];
    const float* wp = W + (size_t)(k0 + (lane >> 5)) * ldw + src_col0 + (lane & 31);
#pragma unroll
    for (int i = 0; i < 32; ++i) tv[i] = wp[(size_t)(2 * i) * ldw];
#pragma unroll
    for (int i = 0; i < 32; ++i) { const int kk = 2 * i + (lane >> 5); scr[kk * 33 + (lane & 31)] = gk ? tv[i] * gk[k0 + kk] : tv[i]; }
    LDS_WAIT(); asm volatile("" ::: "memory");
    const int c = lane & 7;
#pragma unroll
    for (int j = 0; j < 4; ++j) { const int n = (lane >> 3) + 8 * j; const LAS float* s = scr + (8 * c) * 33 + n;
        v4u o; o.x = pk2(s[0 * 33], s[1 * 33]); o.y = pk2(s[2 * 33], s[3 * 33]); o.z = pk2(s[4 * 33], s[5 * 33]); o.w = pk2(s[6 * 33], s[7 * 33]);
        *(v4u*)(WT + (size_t)(dst_row0 + n) * K + k0 + 8 * c) = o; }
    LDS_WAIT(); asm volatile("" ::: "memory");
}

typedef __attribute__((address_space(1))) unsigned gu32;
#define RLX_AGENT __ATOMIC_RELAXED, __HIP_MEMORY_SCOPE_AGENT
#define LDS_WAIT() asm volatile("s_waitcnt lgkmcnt(0)" ::: "memory")
#define VM_WAIT() asm volatile("s_waitcnt vmcnt(0)" ::: "memory")
#define XB_TMO      128
#define XB_XCNT(j)  (256  + 64 * (j))
#define XB_XSUB(j)  (1280 + 64 * (j))
#define XB_XGEN(j)  (2304 + 64 * (j))
#define XB_TOP      3328
#define XB_TOPGEN   3392
#define XCD_BAR_WORDS 3456
#define XB_SPIN_CAP (1u << 18)

__device__ __forceinline__ unsigned xb_ld(unsigned* p)              { return __hip_atomic_load(p, __ATOMIC_RELAXED, __HIP_MEMORY_SCOPE_AGENT); }
__device__ __forceinline__ unsigned xb_add(unsigned* p, unsigned v) { return __hip_atomic_fetch_add(p, v, __ATOMIC_RELAXED, __HIP_MEMORY_SCOPE_AGENT); }
__device__ __forceinline__ unsigned xb_xcc_id() { return (unsigned)__builtin_amdgcn_s_getreg((3 << 11) | 20) & 0xFu; }
#define XB_SPIN(cond, bar) do { unsigned _sp = 0; while (cond) { __builtin_amdgcn_s_sleep(1); \
    if ((++_sp & 255u) == 0u) { if (xb_ld(&(bar)[XB_TMO])) break; if (_sp > XB_SPIN_CAP) { atomicAdd(&(bar)[XB_TMO], 1u); break; } } } } while (0)

struct XcdBarrier {
    unsigned* bar; unsigned x;
    volatile LAS unsigned* st;
};

__device__ __forceinline__ XcdBarrier xcd_barrier_post(unsigned* bar, volatile LAS unsigned* st) {
    XcdBarrier b; b.bar = bar; b.x = xb_xcc_id(); b.st = st;
    if (threadIdx.x == 0) (void)xb_add(&bar[XB_XCNT(b.x)], 1u);
    return b;
}
__device__ __forceinline__ void xcd_barrier_complete(unsigned* bar, unsigned x, unsigned& nloc, unsigned& nx) {
    const unsigned G = gridDim.x * gridDim.y * gridDim.z;
    unsigned sum, cnt, mine, sp = 0u;
    for (;;) {
        sum = 0u; cnt = 0u; mine = 0u;
#pragma unroll
        for (unsigned j = 0; j < 16; ++j) { const unsigned c = xb_ld(&bar[XB_XCNT(j)]); sum += c; cnt += (c > 0u) ? 1u : 0u; mine = (j == x) ? c : mine; }
        if (sum == G) break;
        __builtin_amdgcn_s_sleep(1);
        if ((++sp & 255u) == 0u) { if (xb_ld(&bar[XB_TMO])) break; if (sp > XB_SPIN_CAP) { atomicAdd(&bar[XB_TMO], 1u); break; } }
    }
    nloc = mine > 0u ? mine : 1u; nx = cnt > 0u ? cnt : 1u;
}

__device__ __forceinline__ void xcd_barrier(const XcdBarrier& b) {
    asm volatile("s_waitcnt vmcnt(0)" ::: "memory");
    __syncthreads();
    if (threadIdx.x == 0) {
        unsigned* bar = b.bar;
        __builtin_amdgcn_s_waitcnt(0);
        unsigned nloc = b.st[0], nx = b.st[1];
        if (nloc == 0u) { xcd_barrier_complete(bar, b.x, nloc, nx); b.st[0] = nloc; b.st[1] = nx; }
        const unsigned old = xb_add(&bar[XB_XSUB(b.x)], 1u);
        const unsigned gen = old / nloc;
        if (old + 1u == (gen + 1u) * nloc) {
            __builtin_amdgcn_fence(__ATOMIC_RELEASE, "agent");
            asm volatile("s_waitcnt vmcnt(0)" ::: "memory");
            const unsigned og = xb_add(&bar[XB_TOP], 1u);
            const unsigned tg = og / nx;
            if (og + 1u == (tg + 1u) * nx) xb_add(&bar[XB_TOPGEN], 1u);
            else XB_SPIN(xb_ld(&bar[XB_TOPGEN]) == tg, bar);
            __builtin_amdgcn_fence(__ATOMIC_ACQUIRE, "agent");
            xb_add(&bar[XB_XGEN(b.x)], 1u);
            asm volatile("s_waitcnt vmcnt(0)" ::: "memory");
        } else {
            XB_SPIN(xb_ld(&bar[XB_XGEN(b.x)]) == gen, bar);
            __builtin_amdgcn_fence(__ATOMIC_ACQUIRE, "agent");
            asm volatile("s_waitcnt vmcnt(0)" ::: "memory");
        }
    }
    __syncthreads();
}

template <int W> __device__ __forceinline__ void pool_item(const bf16* Zb, bf16* PL, int row, int ch) {
    constexpr int left = W / 2;
    const int T = row < MP ? 8192 : 4096, t = row < MP ? (row & 8191) : ((row - MP) & 4095);
    const bf16* zp = Zb + (size_t)(row - t) * 512 + ch * 8;
    v4u q[W];
#pragma unroll
    for (int k = 0; k < W; ++k) { int tt = t - left + k; tt = tt < 0 ? 0 : (tt > T - 1 ? T - 1 : tt); q[k] = *(const v4u*)(zp + (size_t)tt * 512); }
    float a[8];
#pragma unroll
    for (int e = 0; e < 8; ++e) a[e] = 0.f;
#pragma unroll
    for (int k = 0; k < W; ++k) { const int tt = t - left + k; const float wv = (tt >= 0 && tt < T) ? 1.f : 0.f;
        a[0] += wv * pg8::bf_lo(q[k].x); a[1] += wv * pg8::bf_hi(q[k].x); a[2] += wv * pg8::bf_lo(q[k].y); a[3] += wv * pg8::bf_hi(q[k].y);
        a[4] += wv * pg8::bf_lo(q[k].z); a[5] += wv * pg8::bf_hi(q[k].z); a[6] += wv * pg8::bf_lo(q[k].w); a[7] += wv * pg8::bf_hi(q[k].w); }
    const int lo = (t - left) > 0 ? (t - left) : 0, hi = (t + W - 1 - left) < (T - 1) ? (t + W - 1 - left) : (T - 1);
    const float ic = 1.0f / (float)(hi - lo + 1); const v4u s = q[left];
    v4u o; o.x = pk2(a[0] * ic - pg8::bf_lo(s.x), a[1] * ic - pg8::bf_hi(s.x)); o.y = pk2(a[2] * ic - pg8::bf_lo(s.y), a[3] * ic - pg8::bf_hi(s.y));
    o.z = pk2(a[4] * ic - pg8::bf_lo(s.z), a[5] * ic - pg8::bf_hi(s.z)); o.w = pk2(a[6] * ic - pg8::bf_lo(s.w), a[7] * ic - pg8::bf_hi(s.w));
    *(v4u*)(PL + (size_t)row * 512 + ch * 8) = o;
}
struct Args { const float* in[25]; float* out; unsigned char* ws; };
static_assert(sizeof(Args) == 27 * 8, "Args has no padding");

__device__ __forceinline__ void gateup_items(int r, const float* Wg, const float* Wu, bf16* WT, LAS float* scr, int lane, const float* gk) {
    const int kb = r / 176, G = r % 176, tile = G >> 3, w = G & 7;
    transpose_item((w < 4) ? Wg : Wu, DFF, tile * 128 + (w & 3) * 32, kb * 64, WT, 1024, G * 32, scr, lane, gk);
}

constexpr int CV_I1 = 16 * 176, CV_I2 = 44 * 32, CV_I3 = 16 * 104, CV_I4 = 8 * 32, CV_I6 = 16 * 32, CV_I10 = 4 * 32;
constexpr int CV_NITEMS = 2 * CV_I1 + 2 * CV_I2 + CV_I3 + CV_I4 + 2 * CV_I6 + CV_I10;
__device__ __forceinline__ void convert_items(const Args& args, unsigned char* ws, LAS float* scr, int lane, int it_begin, int it_end, int skip_begin, int skip_len, int w, int nw) {
    bf16* W1 = (bf16*)(ws + WS_W1); bf16* WD1 = (bf16*)(ws + WS_WD1); bf16* WIN = (bf16*)(ws + WS_WIN); bf16* WUA = (bf16*)(ws + WS_WUA);
    bf16* WOUT = (bf16*)(ws + WS_WOUT); bf16* W2 = (bf16*)(ws + WS_W2); bf16* WD2 = (bf16*)(ws + WS_WD2); bf16* WPG = (bf16*)(ws + WS_WPG); bf16* WPP = (bf16*)(ws + WS_WPP);
    for (int it = it_begin + w; it < it_end; it += nw) {
        int r = it >= skip_begin ? it + skip_len : it;
        if (r < CV_I1) { gateup_items(r, args.in[5], args.in[6], W1, scr, lane, nullptr); continue; } r -= CV_I1;
        if (r < CV_I1) { gateup_items(r, args.in[18], args.in[19], W2, scr, lane, args.in[17]); continue; } r -= CV_I1;
        if (r < CV_I2) { transpose_item(args.in[7], 1024, (r % 32) * 32, (r / 32) * 64, WD1, DFF, (r % 32) * 32, scr, lane); continue; } r -= CV_I2;
        if (r < CV_I2) { transpose_item(args.in[20], 1024, (r % 32) * 32, (r / 32) * 64, WD2, DFF, (r % 32) * 32, scr, lane); continue; } r -= CV_I2;
        if (r < CV_I3) { const int kb = r / 104, Gp = r % 104; const int c0 = Gp < 24 ? ((Gp >> 3) * 256 + (Gp & 3) * 64 + ((Gp >> 2) & 1) * 32) : Gp * 32;
            transpose_item(args.in[9], INW, c0, kb * 64, WIN, 1024, Gp * 32, scr, lane, args.in[8]); continue; } r -= CV_I3;
        if (r < CV_I4) { transpose_item(args.in[12], 1024, (r % 32) * 32, (r / 32) * 64, WUA, 512, (r % 32) * 32, scr, lane); continue; } r -= CV_I4;
        if (r < CV_I6) { transpose_item(args.in[16], 1024, (r % 32) * 32, (r / 32) * 64, WOUT, 1024, (r % 32) * 32, scr, lane); continue; } r -= CV_I6;
        if (r < CV_I6) { transpose_item(args.in[22], 1024, (r % 32) * 32, (r / 32) * 64, WPG, 1024, (r % 32) * 32, scr, lane, args.in[21]); continue; } r -= CV_I6;
        transpose_item(args.in[23], 1024, (r % 32) * 32, (r / 32) * 64, WPP, PLE, (r % 32) * 32, scr, lane);
    }
}

__global__ void __launch_bounds__(NWAVES * 64, 2) fwd_mega(Args args) {
    extern __shared__ __attribute__((aligned(16))) unsigned char lds[];
    cg::grid_group grid = cg::this_grid();
    const int tid = threadIdx.x, lane = tid & 63, wave = __builtin_amdgcn_readfirstlane(tid >> 6);
    const int G = gridDim.x, bx = blockIdx.x, vcu = (G % 8 == 0) ? (bx % 8) * (G / 8) + bx / 8 : bx;
    unsigned char* ws = args.ws;
    LAS unsigned char* ldsp = (LAS unsigned char*)lds;
    const float* x_p = args.in[0]; const float* x_s = args.in[1]; const float* p_p = args.in[2]; const float* p_s = args.in[3];
    float* out = args.out;
    float* SS = (float*)(ws + WS_SS); float* SSE = (float*)(ws + WS_SSE);
    bf16* W1 = (bf16*)(ws + WS_W1); bf16* WD1 = (bf16*)(ws + WS_WD1); bf16* WIN = (bf16*)(ws + WS_WIN); bf16* WUA = (bf16*)(ws + WS_WUA); bf16* WPC = (bf16*)(ws + WS_WPC);
    bf16* WOUT = (bf16*)(ws + WS_WOUT); bf16* W2 = (bf16*)(ws + WS_W2); bf16* WD2 = (bf16*)(ws + WS_WD2); bf16* WPG = (bf16*)(ws + WS_WPG); bf16* WPP = (bf16*)(ws + WS_WPP);
    bf16* HB = (bf16*)(ws + WS_HB); bf16* ACT = (bf16*)(ws + WS_ACT); bf16* QO = (bf16*)(ws + WS_QO); bf16* Zb = (bf16*)(ws + WS_Z); bf16* PL = (bf16*)(ws + WS_PL);
    bf16* MX = (bf16*)(ws + WS_MX); bf16* KB = (bf16*)(ws + WS_K); bf16* VB = (bf16*)(ws + WS_V); bf16* PB = (bf16*)(ws + WS_PB); bf16* SGB = (bf16*)(ws + WS_SGB); bf16* EB = (bf16*)(ws + WS_E);
    volatile LAS unsigned* bst = (volatile LAS unsigned*)(ldsp + 139264);
    if (tid < 2) bst[tid] = 0u;
    __syncthreads();
    const XcdBarrier xbar = xcd_barrier_post((unsigned*)ws, bst);
    const int gw = vcu * NWAVES + wave, NGW = G * NWAVES;
    const int gt = bx * (NWAVES * 64) + tid, NGT = G * NWAVES * 64;

    PH(0) {
        LAS float* scr = (LAS float*)(ldsp + wave * 16384);
        const bool defer = (G == 256);
        if (defer) convert_items(args, ws, scr, lane, 0, CV_NITEMS - CV_I1, CV_I1, CV_I1, gw, NGW); else convert_items(args, ws, scr, lane, 0, CV_NITEMS, CV_NITEMS, 0, gw, NGW);
        if (gt < 128) ((float*)(ws + WS_GQK))[gt] = gt < 64 ? args.in[10][gt] : args.in[11][gt - 64];
        { const float* pw = args.in[13]; const float* psc = args.in[14]; const float* wup = args.in[15];
          for (int idx = gt; idx < 128 * 1024; idx += NGT) { const int d = idx & 1023, c0 = (idx >> 10) * 4, g0 = c0 & ~127; float a0 = 0.f, a1 = 0.f, a2 = 0.f, a3 = 0.f;
              const float* pr = pw + (size_t)c0 * 128; const float* bp = wup + (size_t)g0 * 1024 + d;
#pragma unroll 16
              for (int j = 0; j < 128; ++j) { const float b = bp[(size_t)j * 1024] * psc[g0 + j]; a0 += pr[j] * b; a1 += pr[128 + j] * b; a2 += pr[256 + j] * b; a3 += pr[384 + j] * b; }
              *(unsigned long long*)(WPC + (size_t)d * 512 + c0) = (unsigned long long)pk2(a0, a1) | ((unsigned long long)pk2(a2, a3) << 32); } }
        { const float* g1 = args.in[4]; f32x4 gv[4];
#pragma unroll
          for (int j = 0; j < 4; ++j) gv[j] = ((const f32x4*)g1)[lane + 64 * j];
          for (int m0 = gw * 4; m0 < MTOT; m0 += NGW * 4) { const float* xr = m0 < MP ? x_p + (size_t)m0 * 1024 : x_s + (size_t)(m0 - MP) * 1024;
              f32x4 v[4][4]; float s[4];
#pragma unroll
              for (int r = 0; r < 4; ++r)
#pragma unroll
                  for (int j = 0; j < 4; ++j) v[r][j] = ((const f32x4*)(xr + r * 1024))[lane + 64 * j];
#pragma unroll
              for (int r = 0; r < 4; ++r) { s[r] = 0.f;
#pragma unroll
                  for (int j = 0; j < 4; ++j) s[r] += (v[r][j].x * v[r][j].x + v[r][j].y * v[r][j].y) + (v[r][j].z * v[r][j].z + v[r][j].w * v[r][j].w); }
#pragma unroll
              for (int r = 0; r < 4; ++r) { const float rstd = rsqrtf(wave_sum(s[r]) * (1.f / 1024.f) + EPSN);
                  unsigned long long* o8 = (unsigned long long*)(HB + (size_t)(m0 + r) * 1024) + lane;
#pragma unroll
                  for (int j = 0; j < 4; ++j) { const f32x4 y = v[r][j] * rstd * gv[j]; o8[64 * j] = (unsigned long long)pk2(y.x, y.y) | ((unsigned long long)pk2(y.z, y.w) << 32); } } } }
    }
    grid.sync();

    PH(1) { pg8::Gemm g{HB, W1, MTOT, 2 * DFF, 1024, 0, 0}; pg8::StaticOrder S; S.init(MTOT, 2 * DFF, G, bx);
      pg8::EpiGateUp<false> E{ACT, DFF, nullptr};
      pg8::gemm_phase<pg8::EpiGateUp<false>, pg8::StaticOrder, true, true>(ldsp, g, S, E); }
    if (G == 256 && bx >= 128) {
        asm volatile("s_waitcnt vmcnt(0)" ::: "memory"); __syncthreads();
        LAS float* scr = (LAS float*)(ldsp + wave * 16384);
        convert_items(args, ws, scr, lane, CV_I1, 2 * CV_I1, CV_NITEMS, 0, (bx - 128) * NWAVES + wave, 128 * NWAVES);
    }
    xcd_barrier(xbar);
    PH(2) { pg8::Gemm g{ACT, WD1, MTOT, 1024, DFF, 0, 0}; pg8::StaticOrder S; S.init(MTOT, 1024, G, bx, 1);
      pg8::EpiResid<true> E{x_p, x_s, HB, SS, 0.5f};
      pg8::gemm_phase<pg8::EpiResid<true>, pg8::StaticOrder, true, true>(ldsp, g, S, E); }
    xcd_barrier(xbar);
    PH(3) { pg8::Gemm g{HB, WIN, MTOT, INW, 1024, 0, 0}; pg8::StaticOrder S; S.init(MTOT, INW, G, bx);
      pg8::EpiWin E{SS, (const float*)(ws + WS_GQK), ws, attn_body::C2};
      pg8::gemm_phase<pg8::EpiWin, pg8::StaticOrder, true, true>(ldsp, g, S, E); }
    xcd_barrier(xbar);
    PH(4) {
      for (int wi = gw; wi < MTOT; wi += NGW) { const int grp = wi & 3, row = (wi >> 2) * 4 + (lane >> 4), ch = grp * 16 + (lane & 15);
          if (grp == 0) pool_item<2>(Zb, PL, row, ch); else if (grp == 1) pool_item<4>(Zb, PL, row, ch); else if (grp == 2) pool_item<8>(Zb, PL, row, ch); else pool_item<16>(Zb, PL, row, ch); }
      asm volatile("s_waitcnt vmcnt(0)" ::: "memory"); __syncthreads();
      const attn_body::AttnTensors AT{(const attn_body::bf16*)QO, (const attn_body::bf16*)KB, (const attn_body::bf16*)VB, (attn_body::bf16*)QO};
      attn_body::attn_phase<8>((char*)lds, AT, vcu, G); }
    xcd_barrier(xbar);
    PH(5) { for (int idx = gt; idx < MTOT * 32; idx += NGT) { const int row = idx >> 5, ch = idx & 31; const float* pr = (row < MP ? p_p + (size_t)row * PLE : p_s + (size_t)(row - MP) * PLE) + ch * 8;
          const f32x4 a = *(const f32x4*)pr, b = *(const f32x4*)(pr + 4); v4u o; o.x = pk2(a.x, a.y); o.y = pk2(a.z, a.w); o.z = pk2(b.x, b.y); o.w = pk2(b.z, b.w);
          *(v4u*)(PB + (size_t)row * PLE + ch * 8) = o; }
      asm volatile("s_waitcnt vmcnt(0)" ::: "memory"); __syncthreads();
      pg8::SegOrder S; S.init(MTOT, 1024, G, bx);
      { pg8::Gemm g{QO, WUA, MTOT, 1024, 512, (long)((const char*)PL - (const char*)QO), (long)((const char*)WPC - (const char*)WUA)}; pg8::EpiGateMix E{MX, SGB}; pg8::gemm_phase<pg8::EpiGateMix, pg8::SegOrder, true, true>(ldsp, g, S, E); } }
    xcd_barrier(xbar);
    PH(6) { pg8::StaticOrder S; S.init(MTOT, 1024, G, bx);
      { pg8::Gemm g{MX, WOUT, MTOT, 1024, 1024, 0, 0}; pg8::EpiResid<false> E{nullptr, nullptr, HB, SS, 1.0f}; pg8::gemm_phase<pg8::EpiResid<false>, pg8::StaticOrder, true, true>(ldsp, g, S, E); }
 }
    asm volatile("s_waitcnt vmcnt(0)" ::: "memory"); __syncthreads();
    PH(6) { pg8::Gemm g{PB, WPP, MTOT, 1024, PLE, 0, 0}; pg8::StaticOrder S; S.init(MTOT, 1024, G, bx); pg8::EpiE E{EB, SSE};
      pg8::gemm_phase<pg8::EpiE, pg8::StaticOrder, true, true>(ldsp, g, S, E); }
    xcd_barrier(xbar);
    PH(7) { pg8::Gemm g{HB, W2, MTOT, 2 * DFF, 1024, 0, 0}; pg8::StaticOrder S; S.init(MTOT, 2 * DFF, G, bx);
      pg8::EpiGateUp<true> E{ACT, DFF, SS};
      pg8::gemm_phase<pg8::EpiGateUp<true>, pg8::StaticOrder, true, true>(ldsp, g, S, E); }
    xcd_barrier(xbar);
    PH(8) { pg8::Gemm g{ACT, WD2, MTOT, 1024, DFF, 0, 0}; pg8::StaticOrder S; S.init(MTOT, 1024, G, bx, 1);
      pg8::EpiResid<false> E{nullptr, nullptr, HB, SS, 0.5f};
      pg8::gemm_phase<pg8::EpiResid<false>, pg8::StaticOrder, true, true>(ldsp, g, S, E); }
    xcd_barrier(xbar);
    PH(9) { pg8::Gemm g{HB, WPG, MTOT, 1024, 1024, 0, 0}; pg8::StaticOrder S; S.init(MTOT, 1024, G, bx);
      pg8::EpiFinal E{out, HB, EB, SS, SSE, args.in[24]};
      pg8::gemm_phase<pg8::EpiFinal, pg8::StaticOrder, true, true>(ldsp, g, S, E); }
}

extern "C" void kernel_launch(void* const* d_in, const int* in_sizes, int n_in, void* d_out, int out_size, void* d_ws, size_t ws_size, hipStream_t stream) {
    static int grid = 0;
    if (grid == 0) {
        if (n_in != 25 || out_size != MTOT * 1024 || ws_size < WS_END) { fprintf(stderr, "kernel_launch: unexpected problem (n_in %d, out %d, ws %zu); nothing launched\n", n_in, out_size, ws_size); grid = -1; return; }
        int dev = 0, cus = 0, per_cu = 0;
        if (hipGetDevice(&dev) != hipSuccess || hipDeviceGetAttribute(&cus, hipDeviceAttributeMultiprocessorCount, dev) != hipSuccess) { grid = -1; return; }
        if (hipFuncSetAttribute((const void*)fwd_mega, hipFuncAttributeMaxDynamicSharedMemorySize, LDS_BYTES) != hipSuccess) { fprintf(stderr, "kernel_launch: hipFuncSetAttribute failed\n"); grid = -1; return; }
        if (hipOccupancyMaxActiveBlocksPerMultiprocessor(&per_cu, (const void*)fwd_mega, NWAVES * 64, LDS_BYTES) != hipSuccess || per_cu < 1) { fprintf(stderr, "kernel_launch: occupancy query says %d blocks per CU\n", per_cu); (void)hipGetLastError(); }
        grid = cus;
    }
    if (grid < 0) return;
    if (hipMemsetAsync(d_ws, 0, 16384, stream) != hipSuccess) { fprintf(stderr, "kernel_launch: memset failed\n"); return; }
    Args a{};
    for (int i = 0; i < 25; ++i) a.in[i] = (const float*)d_in[i];
    a.out = (float*)d_out; a.ws = (unsigned char*)d_ws;
    void* kargs[] = {&a};
    const hipError_t e = hipLaunchCooperativeKernel((const void*)fwd_mega, dim3(grid), dim3(NWAVES * 64), kargs, LDS_BYTES, stream);
    if (e != hipSuccess) fprintf(stderr, "kernel_launch: cooperative launch failed: %s (grid %d)\n", hipGetErrorString(e), grid);
}
```

```cpp
#include <hip/hip_runtime.h>
#include <hip/hip_cooperative_groups.h>
#include <hip/hip_bf16.h>
#include <cstdio>
#include <cstdint>
#include <cmath>
namespace cg = cooperative_groups;

constexpr int DMODEL = 1024, MP = 4 * 8192, MS = 4 * 4096, MTOT = MP + MS;
constexpr int DFF = 2816, INW = 3328, PLE = 256;
constexpr float EPSN = 1e-6f;
constexpr size_t HK = 512u * 1024u;
constexpr size_t WS_GQK = 1 * HK;
constexpr size_t WS_SS = 2 * HK, WS_SSE = 8 * HK;
constexpr size_t WS_W1 = 16 * HK, WS_WD1 = 38 * HK, WS_WIN = 49 * HK, WS_WUA = 62 * HK, WS_WPC = 64 * HK, WS_WOUT = 66 * HK, WS_W2 = 70 * HK, WS_WD2 = 92 * HK, WS_WPG = 103 * HK, WS_WPP = 107 * HK;
constexpr size_t WS_HB = 112 * HK;
constexpr size_t WS_ACT = 304 * HK;
constexpr size_t WS_QO = WS_ACT, WS_Z = WS_ACT + 96 * HK, WS_PL = WS_ACT + 192 * HK, WS_MX = WS_ACT + 288 * HK, WS_K = WS_ACT + 480 * HK, WS_V = WS_ACT + 504 * HK, WS_PB = WS_K;
constexpr size_t WS_SGB = 832 * HK, WS_E = WS_SGB, WS_END = 1024 * HK;
static_assert(WS_WPP + 1024 * 256 * 2 <= WS_HB && WS_HB + (size_t)MTOT * 1024 * 2 <= WS_ACT && WS_ACT + (size_t)MTOT * DFF * 2 <= WS_SGB && WS_V + (size_t)MTOT * 128 * 2 <= WS_SGB && WS_SGB + (size_t)MTOT * 1024 * 2 <= WS_END, "d_ws map");
static_assert(WS_W1 + 5632 * 1024 * 2 <= WS_WD1 && WS_WD1 + 1024 * 2816 * 2 <= WS_WIN && WS_WIN + 3328 * 1024 * 2 <= WS_WUA && WS_W2 + 5632 * 1024 * 2 <= WS_WD2 && WS_WD2 + 1024 * 2816 * 2 <= WS_WPG && WS_WPG + 1024 * 1024 * 2 <= WS_WPP, "weights map");


namespace pg8 {
#define PG8_LAS __attribute__((address_space(3)))
typedef unsigned short bf16_t;
typedef short bf16x8 __attribute__((ext_vector_type(8)));
typedef float f32x4 __attribute__((ext_vector_type(4)));
typedef unsigned u32x4 __attribute__((ext_vector_type(4)));
#ifndef PG8_PFD
#define PG8_PFD 3
#endif
constexpr int PFD = PG8_PFD;
constexpr int BM = 256, BK = 64, HALF = 128, HTB = HALF * BK * 2  , STAGE_BYTES = 8 * HTB, NXCD = 8, WGM = 8;

__host__ __device__ __forceinline__ int lds_byte(int r, int c) { const int st = (r >> 4) * 2 + (c >> 5), rr = r & 15, cc = c & 31, ob = rr * 64 + cc * 2; return st * 1024 + (ob ^ (((ob >> 9) & 1) << 5)); }
__host__ __device__ __forceinline__ void stage_rc(int b, int& R, int& C) { const int st = b / 1024, sb = b % 1024, swz = sb ^ (((sb >> 9) & 1) << 5); R = (st >> 1) * 16 + swz / 64; C = (st & 1) * 32 + (swz % 64) / 2; }
__host__ __device__ __forceinline__ int perm32(int rho) { const int n = rho >> 4, i = rho & 15; return 8 * (i >> 2) + 4 * n + (i & 3); }

struct Unit { int pm, pn, seg; };
struct Gemm { const bf16_t* A; const bf16_t* Bt; int M, N, K; long dA, dB; };

struct StaticOrder {
    int nM, nN, nwg, G, c, rev;
    __host__ __device__ void init(int M, int N, int G_, int c_, int rev_ = 0) { nM = M / BM; nN = N / BM; nwg = nM * nN; G = G_; c = c_; rev = rev_; }
    __host__ __device__ bool next(int i, Unit& u) const {
        const int nr = (nwg - c + G - 1) / G; if (i >= nr) return false;
        const long L = (long)(rev ? nr - 1 - i : i) * G + c;
        int wgid = (int)L; { const int q = nwg / NXCD, r = nwg % NXCD, xcd = wgid % NXCD, off = wgid / NXCD; wgid = (xcd < r ? xcd * (q + 1) : r * (q + 1) + (xcd - r) * q) + off; }
        const int nig = WGM * nN, gid = wgid / nig, fm = gid * WGM, gsz = (nM - fm) < WGM ? (nM - fm) : WGM;
        u.pm = fm + ((wgid % nig) % gsz); u.pn = (wgid % nig) / gsz; u.seg = 0; return true;
    }
    __device__ __forceinline__ void a_ready(const Unit&) const {}
    __device__ __forceinline__ void done(const Unit&) const {}
};
struct SegOrder : StaticOrder {
    __host__ __device__ bool next(int i, Unit& u) const { const bool ok = StaticOrder::next(i >> 1, u); u.seg = i & 1; return ok; }
};
__device__ __forceinline__ unsigned cvt_pk_bf16(float lo, float hi) { unsigned r; asm volatile("v_cvt_pk_bf16_f32 %0, %1, %2" : "=v"(r) : "v"(lo), "v"(hi)); return r; }
typedef unsigned u32x2 __attribute__((ext_vector_type(2)));
__device__ __forceinline__ float bf_lo(unsigned w) { return __uint_as_float(w << 16); }
__device__ __forceinline__ float bf_hi(unsigned w) { return __uint_as_float(w & 0xffff0000u); }
__device__ __forceinline__ float sigm(float x) { return __builtin_amdgcn_rcpf(1.0f + __builtin_amdgcn_exp2f(-1.4426950408889634f * x)); }
__device__ __forceinline__ float row_rstd(const float* ss, int row) {
    const f32x4* p = (const f32x4*)(ss + (size_t)row * 16);
    const f32x4 a = p[0], b = p[1], c = p[2], d = p[3];
    const float s = (((a.x + a.y) + (a.z + a.w)) + ((b.x + b.y) + (b.z + b.w))) + (((c.x + c.y) + (c.z + c.w)) + ((d.x + d.y) + (d.z + d.w)));
    return rsqrtf(s * (1.0f / 1024.0f) + EPSN);
}

__device__ __forceinline__ void load_rstd8(const float* ss, int row0, int fq, float (&rs)[2][4]) {
    f32x4 pv[2][4];
#pragma unroll
    for (int ai = 0; ai < 2; ++ai)
#pragma unroll
        for (int m = 0; m < 4; ++m) pv[ai][m] = *(const f32x4*)(ss + (size_t)(row0 + ai * HALF + m * 16) * 16 + 4 * fq);
#pragma unroll
    for (int ai = 0; ai < 2; ++ai)
#pragma unroll
        for (int m = 0; m < 4; ++m) { float s = (pv[ai][m].x + pv[ai][m].y) + (pv[ai][m].z + pv[ai][m].w); s += __shfl_xor(s, 16); s += __shfl_xor(s, 32); rs[ai][m] = rsqrtf(s * (1.0f / 1024.0f) + EPSN); }
}

template <bool ROWSCALE> struct EpiGateUp {
    static constexpr bool PERM = true, AFTER_DRAIN = false, SEG = false; static constexpr int NST = ROWSCALE ? 12 : 6;
    bf16_t* O; int ldc; const float* ss;
    __device__ __forceinline__ void operator()(const f32x4 (&acc)[2][2][4][2], const Unit& u, int wr, int wc, int fr, int fq) const {
        const int row0 = u.pm * BM + wr * 64 + fr, col0 = u.pn * HALF + wc * 32 + 8 * fq;
        float rs[2][4];
        if (ROWSCALE) load_rstd8(ss, row0, fq, rs);
#pragma unroll
        for (int ai = 0; ai < 2; ++ai)
#pragma unroll
            for (int m = 0; m < 4; ++m) { const int row = row0 + ai * HALF + m * 16; const float r = ROWSCALE ? rs[ai][m] : 1.0f;
                typedef float f32x2 __attribute__((ext_vector_type(2)));
                const float nk = -1.4426950408889634f * r, r2 = r * r; unsigned wv[4];
#pragma unroll
                for (int n = 0; n < 2; ++n)
#pragma unroll
                    for (int e = 0; e < 4; e += 2) { const f32x2 g = (f32x2){acc[ai][0][m][n][e], acc[ai][0][m][n][e + 1]}, up = (f32x2){acc[ai][1][m][n][e], acc[ai][1][m][n][e + 1]};
                        const f32x2 t = g * nk; f32x2 ex; ex.x = __builtin_amdgcn_exp2f(t.x); ex.y = __builtin_amdgcn_exp2f(t.y);
                        const f32x2 d = ex + 1.0f; f32x2 q; q.x = __builtin_amdgcn_rcpf(d.x); q.y = __builtin_amdgcn_rcpf(d.y);
                        f32x2 o = (g * up) * q; if (ROWSCALE) o = o * r2;
                        wv[n * 2 + (e >> 1)] = cvt_pk_bf16(o.x, o.y); }
                u32x4 w; w.x = wv[0]; w.y = wv[1]; w.z = wv[2]; w.w = wv[3];
                *(u32x4*)(O + (size_t)row * ldc + col0) = w; }
    }
};

template <bool F32BASE> struct EpiResid {
    static constexpr bool PERM = true, AFTER_DRAIN = false, SEG = false; static constexpr int NST = F32BASE ? 40 : 30;
    const float* base0; const float* base1; bf16_t* hb; float* ss; float alpha;
    __device__ __forceinline__ void operator()(const f32x4 (&acc)[2][2][4][2], const Unit& u, int wr, int wc, int fr, int fq) const {
        const int row0 = u.pm * BM + wr * 64 + fr, col0 = u.pn * BM + wc * 32 + 8 * fq;
#pragma unroll
        for (int ai = 0; ai < 2; ++ai) {
            f32x4 b[4][2][2];
#pragma unroll
            for (int m = 0; m < 4; ++m) { const int row = row0 + ai * HALF + m * 16;
#pragma unroll
                for (int bj = 0; bj < 2; ++bj) {
                    if (F32BASE) { const float* bp = (row < MP ? base0 + (size_t)row * DMODEL : base1 + (size_t)(row - MP) * DMODEL) + col0 + bj * HALF; b[m][bj][0] = *(const f32x4*)bp; b[m][bj][1] = *(const f32x4*)(bp + 4); }
                    else { const u32x4 w = *(const u32x4*)(hb + (size_t)row * DMODEL + col0 + bj * HALF); b[m][bj][0] = __builtin_bit_cast(f32x4, w); } } }
            asm volatile("" ::: "memory");
#pragma unroll
            for (int m = 0; m < 4; ++m) { const int row = row0 + ai * HALF + m * 16; const size_t off = (size_t)row * DMODEL + col0; float s = 0.f;
#pragma unroll
                for (int bj = 0; bj < 2; ++bj) { const f32x4 c0 = acc[ai][bj][m][0], c1 = acc[ai][bj][m][1]; f32x4 b0, b1;
                    if (F32BASE) { b0 = b[m][bj][0]; b1 = b[m][bj][1]; }
                    else { const u32x4 w = __builtin_bit_cast(u32x4, b[m][bj][0]); b0 = (f32x4){bf_lo(w.x), bf_hi(w.x), bf_lo(w.y), bf_hi(w.y)}; b1 = (f32x4){bf_lo(w.z), bf_hi(w.z), bf_lo(w.w), bf_hi(w.w)}; }
                    const f32x4 v0 = b0 + c0 * alpha, v1 = b1 + c1 * alpha;
                    s += ((v0.x * v0.x + v0.y * v0.y) + (v0.z * v0.z + v0.w * v0.w)) + ((v1.x * v1.x + v1.y * v1.y) + (v1.z * v1.z + v1.w * v1.w));
                    u32x4 o; o.x = cvt_pk_bf16(v0.x, v0.y); o.y = cvt_pk_bf16(v0.z, v0.w); o.z = cvt_pk_bf16(v1.x, v1.y); o.w = cvt_pk_bf16(v1.z, v1.w);
                    *(u32x4*)(hb + off + bj * HALF) = o; }
                s += __shfl_xor(s, 16); s += __shfl_xor(s, 32);
                if (fq == 0) ss[(size_t)row * 16 + u.pn * 4 + wc] = s; }
            asm volatile("" ::: "memory"); }
    }
};

struct EpiWin {
    static constexpr bool PERM = false, AFTER_DRAIN = false, SEG = false; static constexpr int NST = 30;
    const float* ss; const float* gqk; unsigned char* ws; float qscale;
    __device__ __forceinline__ void operator()(const f32x4 (&acc)[2][2][4][2], const Unit& u, int wr, int wc, int fr, int fq) const {
        const int row0 = u.pm * BM + wr * 64 + fr;
        const int pn = u.pn;
        const bool is_rope = (pn < 2) || (pn == 2 && wc < 2);
        float rs[2][4];
        load_rstd8(ss, row0, fq, rs);
        if (is_rope) {
            const float* g = gqk + ((pn < 2) ? 0 : 64); const float osc = (pn < 2) ? qscale : 1.0f;
            bf16_t* dst = (bf16_t*)(ws + ((pn < 2) ? (WS_QO + (size_t)(pn * 4 + wc) * 128) : (WS_K + (size_t)wc * 128))); const int ld = (pn < 2) ? 512 : 128;
            f32x4 gv[2][2]; float inv[4];
#pragma unroll
            for (int bj = 0; bj < 2; ++bj)
#pragma unroll
                for (int n = 0; n < 2; ++n) gv[bj][n] = *(const f32x4*)(g + bj * 32 + n * 16 + 4 * fq);
#pragma unroll
            for (int e = 0; e < 4; ++e) inv[e] = __builtin_amdgcn_exp2f(-(float)(4 * fq + e) * 0.8304820237218406f);
#pragma unroll
            for (int m = 0; m < 4; ++m)
#pragma unroll
                for (int ai = 0; ai < 2; ++ai) { const int row = row0 + ai * HALF + m * 16;
                    int t = row < MP ? (row & 8191) : ((row - MP) & 4095); asm volatile("" : "+v"(t));
                    float s = 0.f;
#pragma unroll
                    for (int bj = 0; bj < 2; ++bj)
#pragma unroll
                        for (int n = 0; n < 2; ++n) { const f32x4 a = acc[ai][bj][m][n]; s += (a.x * a.x + a.y * a.y) + (a.z * a.z + a.w * a.w); }
                    s += __shfl_xor(s, 16); s += __shfl_xor(s, 32);
                    const float rr = rs[ai][m];
                    s *= rr * rr;
                    const float r = rsqrtf(s * (1.0f / 64.0f) + EPSN) * rr * osc;
#pragma unroll
                    for (int bj = 0; bj < 2; ++bj) { const float pos = (float)(bj == 0 ? (t >> 6) : (t & 63));
                        const f32x4 x1 = acc[ai][bj][m][0] * r * gv[bj][0], x2 = acc[ai][bj][m][1] * r * gv[bj][1]; f32x4 o1, o2;
#pragma unroll
                        for (int e = 0; e < 4; ++e) { const float ang = pos * inv[e]; const float c = __cosf(ang), sn = __sinf(ang); o1[e] = x1[e] * c - x2[e] * sn; o2[e] = x2[e] * c + x1[e] * sn; }
                        u32x2 w1, w2; w1.x = cvt_pk_bf16(o1.x, o1.y); w1.y = cvt_pk_bf16(o1.z, o1.w); w2.x = cvt_pk_bf16(o2.x, o2.y); w2.y = cvt_pk_bf16(o2.z, o2.w);
                        bf16_t* p = dst + (size_t)row * ld + bj * 32 + 4 * fq; *(u32x2*)p = w1; *(u32x2*)(p + 16) = w2; }
                    __builtin_amdgcn_sched_barrier(0); }
        } else if (pn == 2) {
            bf16_t* dst = (bf16_t*)(ws + WS_V) + (wc - 2) * 64 + 4 * fq;
#pragma unroll
            for (int ai = 0; ai < 2; ++ai)
#pragma unroll
                for (int m = 0; m < 4; ++m) { const int row = row0 + ai * HALF + m * 16; const float r = rs[ai][m];
#pragma unroll
                    for (int bj = 0; bj < 2; ++bj)
#pragma unroll
                        for (int n = 0; n < 2; ++n) { const f32x4 v = acc[ai][bj][m][n] * r; u32x2 w; w.x = cvt_pk_bf16(v.x, v.y); w.y = cvt_pk_bf16(v.z, v.w); *(u32x2*)(dst + (size_t)row * 128 + bj * 32 + n * 16) = w; } }
        } else {
            const bool sg = pn >= 5; const int ld = sg ? 1024 : 512; const int ct = pn < 5 ? pn - 3 : (pn < 9 ? pn - 5 : pn - 9);
            bf16_t* dst = (bf16_t*)(ws + (pn < 5 ? WS_Z : (pn < 9 ? WS_MX : WS_SGB))) + ct * 256 + wc * 32 + 4 * fq;
#pragma unroll
            for (int ai = 0; ai < 2; ++ai)
#pragma unroll
                for (int m = 0; m < 4; ++m) { const int row = row0 + ai * HALF + m * 16; const float r = rs[ai][m];
#pragma unroll
                    for (int bj = 0; bj < 2; ++bj)
#pragma unroll
                        for (int n = 0; n < 2; ++n) { f32x4 v = acc[ai][bj][m][n] * r; if (sg) { v.x = sigm(v.x); v.y = sigm(v.y); v.z = sigm(v.z); v.w = sigm(v.w); }
                            u32x2 w; w.x = cvt_pk_bf16(v.x, v.y); w.y = cvt_pk_bf16(v.z, v.w); *(u32x2*)(dst + (size_t)row * ld + bj * HALF + n * 16) = w; } }
        }
    }
};

struct EpiGateMix {
    static constexpr bool PERM = true, AFTER_DRAIN = false, SEG = true; static constexpr int NST = 24;
    bf16_t* Mx; const bf16_t* SGB;
    __device__ __forceinline__ void operator()(f32x4 (&acc)[2][2][4][2], const Unit& u, int wr, int wc, int fr, int fq) const {
        const int row0 = u.pm * BM + wr * 64 + fr, col0 = u.pn * BM + wc * 32 + 8 * fq;
#pragma unroll
        for (int ai = 0; ai < 2; ++ai) {
            u32x4 gw[4][2], aw[4][2];
#pragma unroll
            for (int m = 0; m < 4; ++m)
#pragma unroll
                for (int bj = 0; bj < 2; ++bj) { const size_t off = (size_t)(row0 + ai * HALF + m * 16) * DMODEL + col0 + bj * HALF; gw[m][bj] = *(const u32x4*)(SGB + off); if (u.seg == 0) aw[m][bj] = *(const u32x4*)(Mx + off); }
            asm volatile("" ::: "memory");
#pragma unroll
            for (int m = 0; m < 4; ++m)
#pragma unroll
                for (int bj = 0; bj < 2; ++bj) { const size_t off = (size_t)(row0 + ai * HALF + m * 16) * DMODEL + col0 + bj * HALF; const u32x4 g = gw[m][bj];
                    const f32x4 g0 = (f32x4){bf_lo(g.x), bf_hi(g.x), bf_lo(g.y), bf_hi(g.y)}, g1 = (f32x4){bf_lo(g.z), bf_hi(g.z), bf_lo(g.w), bf_hi(g.w)};
                    if (u.seg == 0) { const u32x4 a = aw[m][bj];
                        const f32x4 a0 = (f32x4){bf_lo(a.x), bf_hi(a.x), bf_lo(a.y), bf_hi(a.y)}, a1 = (f32x4){bf_lo(a.z), bf_hi(a.z), bf_lo(a.w), bf_hi(a.w)};
#pragma unroll
                        for (int e = 0; e < 4; ++e) { acc[ai][bj][m][0][e] *= a0[e] * __builtin_amdgcn_rcpf(g0[e]); acc[ai][bj][m][1][e] *= a1[e] * __builtin_amdgcn_rcpf(g1[e]); } }
                    else { const f32x4 v0 = acc[ai][bj][m][0] * g0, v1 = acc[ai][bj][m][1] * g1;
                        u32x4 w; w.x = cvt_pk_bf16(v0.x, v0.y); w.y = cvt_pk_bf16(v0.z, v0.w); w.z = cvt_pk_bf16(v1.x, v1.y); w.w = cvt_pk_bf16(v1.z, v1.w);
                        *(u32x4*)(Mx + off) = w; } }
            asm volatile("" ::: "memory"); }
    }
};

struct EpiE {
    static constexpr bool PERM = true, AFTER_DRAIN = false, SEG = false; static constexpr int NST = 16;
    bf16_t* E; float* ss;
    __device__ __forceinline__ void operator()(const f32x4 (&acc)[2][2][4][2], const Unit& u, int wr, int wc, int fr, int fq) const {
        const int row0 = u.pm * BM + wr * 64 + fr, col0 = u.pn * BM + wc * 32 + 8 * fq;
#pragma unroll
        for (int ai = 0; ai < 2; ++ai)
#pragma unroll
            for (int m = 0; m < 4; ++m) { const int row = row0 + ai * HALF + m * 16; float s = 0.f;
#pragma unroll
                for (int bj = 0; bj < 2; ++bj) { const f32x4 c0 = acc[ai][bj][m][0], c1 = acc[ai][bj][m][1];
                    s += ((c0.x * c0.x + c0.y * c0.y) + (c0.z * c0.z + c0.w * c0.w)) + ((c1.x * c1.x + c1.y * c1.y) + (c1.z * c1.z + c1.w * c1.w));
                    u32x4 w; w.x = cvt_pk_bf16(c0.x, c0.y); w.y = cvt_pk_bf16(c0.z, c0.w); w.z = cvt_pk_bf16(c1.x, c1.y); w.w = cvt_pk_bf16(c1.z, c1.w);
                    *(u32x4*)(E + (size_t)row * DMODEL + col0 + bj * HALF) = w; }
                s += __shfl_xor(s, 16); s += __shfl_xor(s, 32);
                if (fq == 0) ss[(size_t)row * 16 + u.pn * 4 + wc] = s; }
    }
};

struct EpiFinal {
    static constexpr bool PERM = true, AFTER_DRAIN = false, SEG = false; static constexpr int NST = 40;
    float* out; const bf16_t* hb; const bf16_t* E; const float* ss; const float* sse; const float* gpost;
    __device__ __forceinline__ void operator()(const f32x4 (&acc)[2][2][4][2], const Unit& u, int wr, int wc, int fr, int fq) const {
        const int row0 = u.pm * BM + wr * 64 + fr, col0 = u.pn * BM + wc * 32 + 8 * fq;
        f32x4 gv[2][2]; float rs[2][4], re[2][4];
#pragma unroll
        for (int bj = 0; bj < 2; ++bj)
#pragma unroll
            for (int n = 0; n < 2; ++n) gv[bj][n] = *(const f32x4*)(gpost + col0 + bj * HALF + n * 4);
        load_rstd8(ss, row0, fq, rs); load_rstd8(sse, row0, fq, re);
#pragma unroll
        for (int ai = 0; ai < 2; ++ai)
#pragma unroll
        for (int mp = 0; mp < 2; ++mp) {
            u32x4 hw[2][2], ew[2][2];
#pragma unroll
            for (int mm = 0; mm < 2; ++mm)
#pragma unroll
                for (int bj = 0; bj < 2; ++bj) { const size_t off = (size_t)(row0 + ai * HALF + (2 * mp + mm) * 16) * DMODEL + col0 + bj * HALF; hw[mm][bj] = *(const u32x4*)(hb + off); ew[mm][bj] = *(const u32x4*)(E + off); }
            asm volatile("" ::: "memory");
#pragma unroll
            for (int mm = 0; mm < 2; ++mm) { const int m = 2 * mp + mm; const float r = rs[ai][m], q = re[ai][m];
#pragma unroll
                for (int bj = 0; bj < 2; ++bj) { const size_t off = (size_t)(row0 + ai * HALF + m * 16) * DMODEL + col0 + bj * HALF; const u32x4 h = hw[mm][bj], ee = ew[mm][bj];
                    const f32x4 h0 = (f32x4){bf_lo(h.x), bf_hi(h.x), bf_lo(h.y), bf_hi(h.y)}, h1 = (f32x4){bf_lo(h.z), bf_hi(h.z), bf_lo(h.w), bf_hi(h.w)};
                    const f32x4 e0 = (f32x4){bf_lo(ee.x), bf_hi(ee.x), bf_lo(ee.y), bf_hi(ee.y)} * q * gv[bj][0], e1 = (f32x4){bf_lo(ee.z), bf_hi(ee.z), bf_lo(ee.w), bf_hi(ee.w)} * q * gv[bj][1];
                    const f32x4 a0 = acc[ai][bj][m][0] * r, a1 = acc[ai][bj][m][1] * r; f32x4 y0, y1;
#pragma unroll
                    for (int e = 0; e < 4; ++e) { y0[e] = h0[e] + sigm(a0[e]) * e0[e]; y1[e] = h1[e] + sigm(a1[e]) * e1[e]; }
                    *(f32x4*)(out + off) = y0; *(f32x4*)(out + off + 4) = y1; } }
            asm volatile("" ::: "memory"); }
    }
};

template <class Epi, class Sched, bool ALIGN_EPI = false, bool SP2 = false>
__device__ __forceinline__ void gemm_phase(PG8_LAS unsigned char* lds, const Gemm g, const Sched& S, const Epi& E) {
    int tid = threadIdx.x; asm volatile("" : "+v"(tid));
    const int wid = __builtin_amdgcn_readfirstlane(tid >> 6), lane = tid & 63, wr = wid >> 2, wc = wid & 3, fr = lane & 15, fq = lane >> 4;
    const int K = g.K, nt = K / BK;
    unsigned voffA[2], voffB[2];
#pragma unroll
    for (int i = 0; i < 2; ++i) { int R, C; stage_rc(tid * 16 + i * 8192, R, C); const int Rb = Epi::PERM ? ((R & ~31) + perm32(R & 31)) : R;
        voffA[i] = (unsigned)(R * K + C) * 2u; voffB[i] = (unsigned)(Rb * K + C) * 2u; }
    const size_t kstep = (size_t)(BK * 2);
    const size_t hstep = (size_t)HALF * K * 2;
    const size_t tstep = 2 * hstep;
    const unsigned ldsw = (unsigned)wid * 1024u;
    const unsigned ldsb = (unsigned)__builtin_amdgcn_readfirstlane((int)((unsigned)(uintptr_t)lds + ldsw));
    const int aoff = lds_byte(wr * 64 + fr, fq * 8), boff = lds_byte(wc * 32 + fr, fq * 8);
#define PG8_SA(b, h) (((b) * 2 + (h)) * HTB)
#define PG8_SB(b, h) ((4 + (b) * 2 + (h)) * HTB)
#ifndef PG8_B_AUX
#define PG8_B_AUX 0
#endif
#define PG8_STAGE_X(bufoff, gbase, voff, AUX) do { _Pragma("unroll") for (int _i = 0; _i < 2; ++_i) { unsigned keep_; \
        asm volatile("s_mov_b32 %0, m0\n\ts_mov_b32 m0, %1\n\ts_nop 0\n\tglobal_load_lds_dwordx4 %2, %3\n\ts_mov_b32 m0, %0" : "=&s"(keep_) : "s"(ldsb + (unsigned)((bufoff) + _i * 8192)), "v"((voff)[_i]), "s"((const char*)(gbase)) : "memory"); } } while (0)
#define PG8_STAGE(bufoff, gbase, voff) PG8_STAGE_X(bufoff, gbase, voff, 0)
#define PG8_LDA(dst, b, h) do { _Pragma("unroll") for (int m = 0; m < 4; ++m) _Pragma("unroll") for (int k = 0; k < 2; ++k) dst[m][k] = *(const PG8_LAS bf16x8*)(lds + PG8_SA(b, h) + aoff + m * 2048 + k * 1024); } while (0)
#define PG8_LDB(dst, b, h) do { _Pragma("unroll") for (int n = 0; n < 2; ++n) _Pragma("unroll") for (int k = 0; k < 2; ++k) dst[n][k] = *(const PG8_LAS bf16x8*)(lds + PG8_SB(b, h) + boff + n * 2048 + k * 1024); } while (0)
#define PG8_MMA(ai, bj, At, Bt) do { __builtin_amdgcn_s_setprio(1); _Pragma("unroll") for (int m = 0; m < 4; ++m) _Pragma("unroll") for (int n = 0; n < 2; ++n) _Pragma("unroll") for (int k = 0; k < 2; ++k) \
        acc[ai][bj][m][n] = __builtin_amdgcn_mfma_f32_16x16x32_bf16(Bt[n][k], At[m][k], acc[ai][bj][m][n], 0, 0, 0); __builtin_amdgcn_s_setprio(0); } while (0)
#define PG8_WAIT_V(n) asm volatile("s_waitcnt vmcnt(" #n ")" ::: "memory")
#define PG8_WAIT_L(n) asm volatile("s_waitcnt lgkmcnt(" #n ")" ::: "memory")
#define PG8_WAIT_VN(n) asm volatile("s_waitcnt vmcnt(%0)" :: "n"(n) : "memory")
#define PG8_BAR __builtin_amdgcn_s_barrier()
#define PG8_SCHED __builtin_amdgcn_sched_barrier(0)
    Unit cur, nxt; int ui = 0;
    if (!S.next(0, cur)) return;
    f32x4 acc[2][2][4][2];
#pragma unroll
    for (int a = 0; a < 2; ++a)
#pragma unroll
        for (int b = 0; b < 2; ++b)
#pragma unroll
            for (int m = 0; m < 4; ++m)
#pragma unroll
                for (int n = 0; n < 2; ++n) acc[a][b][m][n] = (f32x4){0.f, 0.f, 0.f, 0.f};
    bf16x8 At[4][2], B0[2][2], B1[2][2];
    const char* cA = (const char*)g.A + (size_t)cur.pm * tstep + (size_t)cur.seg * g.dA; const char* cB = (const char*)g.Bt + (size_t)cur.pn * tstep + (size_t)cur.seg * g.dB;
    S.a_ready(cur);
    if constexpr (SP2) {
        PG8_STAGE_X(PG8_SB(0, 0), cB, voffB, PG8_B_AUX); PG8_STAGE_X(PG8_SB(0, 1), cB + hstep, voffB, PG8_B_AUX); PG8_STAGE(PG8_SA(0, 0), cA, voffA); PG8_STAGE(PG8_SA(0, 1), cA + hstep, voffA);
        if (wr == 1) PG8_BAR;
        PG8_WAIT_V(2); PG8_BAR;
        PG8_STAGE_X(PG8_SB(1, 0), cB + kstep, voffB, PG8_B_AUX); PG8_STAGE(PG8_SA(1, 0), cA + kstep, voffA); PG8_STAGE_X(PG8_SB(1, 1), cB + hstep + kstep, voffB, PG8_B_AUX);
        PG8_WAIT_V(6); PG8_BAR;
    } else {
        PG8_STAGE_X(PG8_SB(0, 0), cB, voffB, PG8_B_AUX); PG8_STAGE(PG8_SA(0, 0), cA, voffA); PG8_STAGE_X(PG8_SB(0, 1), cB + hstep, voffB, PG8_B_AUX); PG8_STAGE(PG8_SA(0, 1), cA + hstep, voffA);
        if (wr == 1) PG8_BAR;
        PG8_WAIT_V(4); PG8_BAR;
        PG8_STAGE_X(PG8_SB(1, 0), cB + kstep, voffB, PG8_B_AUX); PG8_STAGE(PG8_SA(1, 0), cA + kstep, voffA); PG8_STAGE_X(PG8_SB(1, 1), cB + hstep + kstep, voffB, PG8_B_AUX);
        PG8_WAIT_V(6); PG8_BAR;
    }
    for (;;) {
        const bool has_next = S.next(ui + 1, nxt);
        const char* nA = has_next ? (const char*)g.A + (size_t)nxt.pm * tstep + (size_t)nxt.seg * g.dA : cA; const char* nB = has_next ? (const char*)g.Bt + (size_t)nxt.pn * tstep + (size_t)nxt.seg * g.dB : cB;
#pragma unroll 1
        for (int t = 0; t < nt; t += 2) {
            const bool last = (t == nt - 2);
            const char* a1 = cA + (size_t)(t + 1) * kstep;
            const char* a2 = last ? nA : cA + (size_t)(t + 2) * kstep; const char* b2 = last ? nB : cB + (size_t)(t + 2) * kstep;
            const char* a3 = a2 + kstep; const char* b3 = b2 + kstep;
            if (last && has_next) S.a_ready(nxt);
            if constexpr (SP2) {
            const bool after_epi = (t == 0) && (ui > 0);
            PG8_LDB(B0, 0, 0); PG8_LDB(B1, 0, 1); PG8_SCHED; PG8_LDA(At, 0, 0); PG8_STAGE(PG8_SA(1, 1), a1 + hstep, voffA);
            if (after_epi) { PG8_WAIT_VN(8 + Epi::NST); } else { PG8_WAIT_V(8); } PG8_WAIT_L(0); PG8_BAR; PG8_MMA(0, 0, At, B0); PG8_MMA(0, 1, At, B1); PG8_BAR; PG8_SCHED;
            PG8_LDA(At, 0, 1); PG8_STAGE_X(PG8_SB(0, 0), b2, voffB, PG8_B_AUX); PG8_STAGE_X(PG8_SB(0, 1), b2 + hstep, voffB, PG8_B_AUX); PG8_STAGE(PG8_SA(0, 0), a2, voffA);
            if (after_epi) { PG8_WAIT_VN(8 + Epi::NST); } else { PG8_WAIT_V(8); } PG8_WAIT_L(0); PG8_BAR; PG8_MMA(1, 0, At, B0); PG8_MMA(1, 1, At, B1); PG8_BAR; PG8_SCHED;
            PG8_LDB(B0, 1, 0); PG8_LDB(B1, 1, 1); PG8_SCHED; PG8_LDA(At, 1, 0); PG8_STAGE(PG8_SA(0, 1), a2 + hstep, voffA);
            PG8_WAIT_V(8); PG8_WAIT_L(0); PG8_BAR; PG8_MMA(0, 0, At, B0); PG8_MMA(0, 1, At, B1); PG8_BAR; PG8_SCHED;
            PG8_LDA(At, 1, 1); PG8_STAGE_X(PG8_SB(1, 0), b3, voffB, PG8_B_AUX); PG8_STAGE_X(PG8_SB(1, 1), b3 + hstep, voffB, PG8_B_AUX); PG8_STAGE(PG8_SA(1, 0), a3, voffA);
            PG8_WAIT_V(8); PG8_WAIT_L(0); PG8_BAR; PG8_MMA(1, 0, At, B0); PG8_MMA(1, 1, At, B1); PG8_BAR; PG8_SCHED;
            } else {
            PG8_LDB(B0, 0, 0); PG8_SCHED; PG8_LDA(At, 0, 0); PG8_STAGE(PG8_SA(1, 1), a1 + hstep, voffA);
            PG8_WAIT_L(8); PG8_BAR; PG8_WAIT_L(0); PG8_MMA(0, 0, At, B0); PG8_BAR; PG8_SCHED;
            PG8_LDB(B1, 0, 1); PG8_STAGE_X(PG8_SB(0, 0), b2, voffB, PG8_B_AUX);
            PG8_BAR; PG8_WAIT_L(0); PG8_MMA(0, 1, At, B1); PG8_BAR;
            PG8_LDA(At, 0, 1); PG8_STAGE(PG8_SA(0, 0), a2, voffA);
            PG8_BAR; PG8_WAIT_L(0); PG8_MMA(1, 0, At, B0); PG8_BAR; PG8_SCHED;
            PG8_STAGE_X(PG8_SB(0, 1), b2 + hstep, voffB, PG8_B_AUX);
            PG8_WAIT_V(6); PG8_BAR; PG8_MMA(1, 1, At, B1); PG8_BAR;
            PG8_LDB(B0, 1, 0); PG8_SCHED; PG8_LDA(At, 1, 0); PG8_STAGE(PG8_SA(0, 1), a2 + hstep, voffA);
            PG8_WAIT_L(8); PG8_BAR; PG8_WAIT_L(0); PG8_MMA(0, 0, At, B0); PG8_BAR; PG8_SCHED;
            PG8_LDB(B1, 1, 1); PG8_STAGE_X(PG8_SB(1, 0), b3, voffB, PG8_B_AUX);
            PG8_BAR; PG8_WAIT_L(0); PG8_MMA(0, 1, At, B1); PG8_BAR;
            PG8_LDA(At, 1, 1); PG8_STAGE(PG8_SA(1, 0), a3, voffA);
            PG8_BAR; PG8_WAIT_L(0); PG8_MMA(1, 0, At, B0); PG8_BAR; PG8_SCHED;
            PG8_STAGE_X(PG8_SB(1, 1), b3 + hstep, voffB, PG8_B_AUX);
            PG8_WAIT_V(6); PG8_BAR; PG8_MMA(1, 1, At, B1); PG8_BAR;
            }
        }
        if constexpr (ALIGN_EPI) { if (wr == 0) PG8_BAR; }
        if constexpr (!Epi::AFTER_DRAIN) { E(acc, cur, wr, wc, fr, fq); S.done(cur); }
        if (!has_next) break;
        if (!(Epi::SEG && cur.seg == 0))
#pragma unroll
        for (int a = 0; a < 2; ++a)
#pragma unroll
            for (int b = 0; b < 2; ++b)
#pragma unroll
                for (int m = 0; m < 4; ++m)
#pragma unroll
                    for (int n = 0; n < 2; ++n) acc[a][b][m][n] = (f32x4){0.f, 0.f, 0.f, 0.f};
        cur = nxt; cA = nA; cB = nB; ++ui;
        if constexpr (ALIGN_EPI) { if (wr == 1) PG8_BAR; }
    }
    PG8_WAIT_V(0);
    if constexpr (!ALIGN_EPI) { if (wr == 0) PG8_BAR; }
    PG8_BAR;
    if constexpr (Epi::AFTER_DRAIN) { E.fused(acc, cur, wr, wc, fr, fq, lds, wid, lane); S.done(cur); }
#undef PG8_SA
#undef PG8_SB
#undef PG8_STAGE
#undef PG8_STAGE_X
#undef PG8_LDA
#undef PG8_LDB
#undef PG8_MMA
#undef PG8_WAIT_V
#undef PG8_WAIT_L
#undef PG8_WAIT_VN
#undef PG8_BAR
#undef PG8_SCHED
}
}
#include <hip/hip_bf16.h>
#include <cmath>
namespace attn_body {
using bf16=__hip_bfloat16;
using bf16x8=__attribute__((ext_vector_type(8)))short;
using s16x4=__attribute__((ext_vector_type(4)))short;
using f32x16=__attribute__((ext_vector_type(16)))float;
using u32x4=__attribute__((ext_vector_type(4)))unsigned;
constexpr int D=64,QP=512,KP=128;
constexpr int NW=8,QBLK=32,QB=QBLK*NW,KVBLK=64;
constexpr int ATTN_UNIT_ROWS=QB;
__device__ __forceinline__ int crow(int r,int hi){return (r&3)+8*(r>>2)+4*hi;}
#define SBAR() __builtin_amdgcn_sched_barrier(0)
__device__ __forceinline__ void cmask(f32x16&p0,f32x16&p1,int jb,int qrel,int hi){
  const float NEG=-INFINITY; int kb=64*jb+4*hi;
  #pragma unroll
  for(int r=0;r<16;++r){int kv=kb+(r&3)+8*(r>>2); if(kv>qrel)p0[r]=NEG; if(kv+32>qrel)p1[r]=NEG;}
}

constexpr int NSLOT=3, SLOTB=8192;
constexpr int LDS_K=0, LDS_V=NSLOT*SLOTB, LDS_WS=2*NSLOT*SLOTB, LDS_OST=LDS_WS+NW*64*4, LDS_BYTES=LDS_OST+NW*4096;
constexpr float C2=0.125f*1.4426950408889634f;
__device__ __forceinline__ void glds16s(const char*gbase,unsigned off32,unsigned lds_dst){unsigned keep;
  asm volatile("s_mov_b32 %0, m0\n\ts_mov_b32 m0, %3\n\ts_nop 0\n\tglobal_load_lds_dwordx4 %1, %2\n\ts_mov_b32 m0, %0":"=&s"(keep):"v"(off32),"s"(gbase),"s"(lds_dst):"memory");}
__device__ __forceinline__ void glds16(const void*gsrc,unsigned lds_dst){unsigned keep;
  asm volatile("s_mov_b32 %0, m0\n\ts_mov_b32 m0, %2\n\ts_nop 0\n\tglobal_load_lds_dwordx4 %1, off\n\ts_mov_b32 m0, %0":"=&s"(keep):"v"(gsrc),"s"(lds_dst):"memory");}
__device__ __forceinline__ float max3f(float a,float b,float c){float r;asm("v_max3_f32 %0, %1, %2, %3":"=v"(r):"v"(a),"v"(b),"v"(c));return r;}
__device__ __forceinline__ float max2f(float a,float b){float r;asm("v_max_f32_e32 %0, %1, %2":"=v"(r):"v"(a),"v"(b));return r;}
__device__ __forceinline__ float fadd_s(float a,float b){float r;asm("v_add_f32_e32 %0, %1, %2":"=v"(r):"v"(a),"v"(b));return r;}
__device__ __forceinline__ float fsub_s(float a,float b){float r;asm("v_sub_f32_e32 %0, %1, %2":"=v"(r):"v"(a),"v"(b));return r;}
typedef float f32x2_t __attribute__((ext_vector_type(2))); typedef __bf16 bf16x2_t __attribute__((ext_vector_type(2)));
__device__ __forceinline__ unsigned cvtpk_s(float lo,float hi){f32x2_t v={lo,hi};bf16x2_t b=__builtin_convertvector(v,bf16x2_t);return __builtin_bit_cast(unsigned,b);}
#define WAIT_BAR(N) asm volatile("s_waitcnt vmcnt(" #N ") lgkmcnt(0)\n\ts_barrier":::"memory")

__device__ __forceinline__ void qkt(f32x16&p0,f32x16&p1,const char*Kslot,const bf16x8*qr,const f32x16&negm,int r32,int hi){
  const char*kb=Kslot+hi*1024+r32*16;
  #pragma unroll
  for(int d0=0;d0<4;++d0){
    const bf16x8 b0=*reinterpret_cast<const bf16x8*>(kb+d0*2048);
    const bf16x8 b1=*reinterpret_cast<const bf16x8*>(kb+d0*2048+512);
    if(d0==0){p0=__builtin_amdgcn_mfma_f32_32x32x16_bf16(b0,qr[0],negm,0,0,0);p1=__builtin_amdgcn_mfma_f32_32x32x16_bf16(b1,qr[0],negm,0,0,0);}
    else{p0=__builtin_amdgcn_mfma_f32_32x32x16_bf16(b0,qr[d0],p0,0,0,0);p1=__builtin_amdgcn_mfma_f32_32x32x16_bf16(b1,qr[d0],p1,0,0,0);}}
}
typedef __attribute__((address_space(3))) const char* lds_cptr;
typedef short v4i16_t __attribute__((ext_vector_type(4)));
__device__ __forceinline__ void kload8(bf16x8*kf,lds_cptr kp){
  kf[0]=*(const __attribute__((address_space(3))) bf16x8*)(kp);      kf[1]=*(const __attribute__((address_space(3))) bf16x8*)(kp+512);
  kf[2]=*(const __attribute__((address_space(3))) bf16x8*)(kp+2048); kf[3]=*(const __attribute__((address_space(3))) bf16x8*)(kp+2560);
  kf[4]=*(const __attribute__((address_space(3))) bf16x8*)(kp+4096); kf[5]=*(const __attribute__((address_space(3))) bf16x8*)(kp+4608);
  kf[6]=*(const __attribute__((address_space(3))) bf16x8*)(kp+6144); kf[7]=*(const __attribute__((address_space(3))) bf16x8*)(kp+6656);
}
__device__ __forceinline__ void kload2(bf16x8*kf,lds_cptr kp,int j){ kf[2*j]=*(const __attribute__((address_space(3))) bf16x8*)(kp+j*2048); kf[2*j+1]=*(const __attribute__((address_space(3))) bf16x8*)(kp+j*2048+512); }
__device__ __forceinline__ s16x4 vtr(lds_cptr p){ return __builtin_bit_cast(s16x4,__builtin_amdgcn_ds_read_tr16_b64_v4i16((__attribute__((address_space(3))) v4i16_t*)p)); }
__device__ __forceinline__ float rowmax(const f32x16&p0,const f32x16&p1){
  float a=max3f(p0[0],p0[1],p1[0]),b=max3f(p0[2],p0[3],p1[1]);a=max3f(a,p1[2],p1[3]);
  #pragma unroll
  for(int r=4;r<16;r+=4){a=max3f(a,p0[r],p0[r+1]);b=max3f(b,p0[r+2],p0[r+3]);a=max3f(a,p1[r],p1[r+1]);b=max3f(b,p1[r+2],p1[r+3]);}
  const float m=max2f(a,b);
  auto rr=__builtin_amdgcn_permlane32_swap(__float_as_uint(m),__float_as_uint(m),false,false);
  return max2f(__uint_as_float(rr[0]),__uint_as_float(rr[1]));
}
__device__ __forceinline__ void pv(f32x16*o,int vb,bf16x8 pa0,bf16x8 pa1,bf16x8 pa2,bf16x8 pa3){
  #pragma unroll
  for(int d0=0;d0<2;++d0){s16x4 lo[4],hi[4];
    #pragma unroll
    for(int ks=0;ks<4;++ks){
      asm volatile("ds_read_b64_tr_b16 %0,%1 offset:%c2":"=&v"(lo[ks]):"v"(vb),"i"(d0*4096+ks*1024):"memory");
      asm volatile("ds_read_b64_tr_b16 %0,%1 offset:%c2":"=&v"(hi[ks]):"v"(vb),"i"(d0*4096+ks*1024+512):"memory");}
    asm volatile("s_waitcnt lgkmcnt(0)":::"memory");SBAR();
    #define PK(k) (bf16x8){lo[k][0],lo[k][1],lo[k][2],lo[k][3],hi[k][0],hi[k][1],hi[k][2],hi[k][3]}
    o[d0]=__builtin_amdgcn_mfma_f32_32x32x16_bf16(pa0,PK(0),o[d0],0,0,0);
    o[d0]=__builtin_amdgcn_mfma_f32_32x32x16_bf16(pa1,PK(1),o[d0],0,0,0);
    o[d0]=__builtin_amdgcn_mfma_f32_32x32x16_bf16(pa2,PK(2),o[d0],0,0,0);
    o[d0]=__builtin_amdgcn_mfma_f32_32x32x16_bf16(pa3,PK(3),o[d0],0,0,0);
    #undef PK
  }
}

#ifndef ATTN_STORE16
#define ATTN_STORE16(p,v) (*(u32x4*)(p)=(v))
#endif
template<int THRL> __device__ __forceinline__ void attn_unit(long rowbase,int h,int qb,int NT,const bf16*Q,const bf16*__restrict__ K,const bf16*__restrict__ V,bf16*O,char*shm){
  int tid=threadIdx.x; asm volatile("":"+v"(tid)); const int lane=tid&63,r32=lane&31,hi=lane>>5; const int wid=__builtin_amdgcn_readfirstlane(tid>>6);
  const int q0=qb*QB;
  const bf16*Qw=Q+(rowbase+q0+wid*QBLK)*QP+h*D;
  const bf16*Kh=K+rowbase*KP+(h>>2)*D,*Vh=V+rowbase*KP+(h>>2)*D;
  const unsigned lds0=(unsigned)(uintptr_t)shm;
  float*wsf=(float*)(shm+LDS_WS)+wid*64;
  const unsigned koff=(unsigned)(lane*KP+wid*8)*2u;
  const unsigned voff=(unsigned)((16*(wid&3)+(lane>>2))*KP+(wid>>2)*32+(lane&3)*8)*2u;
  const unsigned kdst=lds0+LDS_K+wid*1024, vdst=lds0+LDS_V+wid*1024;
  #define DMA_K(t,slot) glds16s((const char*)Kh+(size_t)(t)*(KVBLK*KP*2),koff,(unsigned)__builtin_amdgcn_readfirstlane(kdst+(slot)))
  #define DMA_V(t,slot) glds16s((const char*)Vh+(size_t)(t)*(KVBLK*KP*2),voff,(unsigned)__builtin_amdgcn_readfirstlane(vdst+(slot)))
  const int vb0=(int)(lds0+LDS_V)+((lane>>4)&1)*32+(lane&3)*8+(4*hi+((lane&15)>>2))*64;
  const char*Kbase=shm+LDS_K; bf16x8 kf[8];
  const lds_cptr shm3=(lds_cptr)shm; const lds_cptr kp0=shm3+LDS_K+hi*1024+r32*16; const lds_cptr vp0=shm3+LDS_V+((lane>>4)&1)*32+(lane&3)*8+(4*hi+((lane&15)>>2))*64;
  DMA_K(0,0);DMA_V(0,0);DMA_K(1,SLOTB);
  bf16x8 qr[4];
  #pragma unroll
  for(int d0=0;d0<4;++d0)qr[d0]=*reinterpret_cast<const bf16x8*>(&Qw[(long)r32*QP+d0*16+hi*8]);
  float mhat=0.f,l_reg=0.f;f32x16 o[2];o[0]=f32x16{};o[1]=f32x16{};f32x16 negm=f32x16{};asm volatile("":"+v"(negm));
    #define CMASK(P0,P1,t) do{}while(0)
  bool resc=false;
  #define START(P0,P1) do{ const float rm=rowmax(P0,P1); resc=false; \
    { const float dl=rm; mhat=fadd_s(mhat,dl); \
      _Pragma("unroll") for(int r=0;r<16;++r){P0[r]=fsub_s(P0[r],dl);P1[r]=fsub_s(P1[r],dl);} \
      _Pragma("unroll") for(int r=0;r<16;++r)negm[r]=-mhat; asm volatile("":"+v"(negm)); } \
    _Pragma("unroll") for(int r=0;r<16;++r)P0[r]=__builtin_amdgcn_exp2f(P0[r]); }while(0)
  #define RESC() do{ if(resc){ asm volatile("s_waitcnt lgkmcnt(0)":::"memory"); \
      _Pragma("unroll") for(int d_=0;d_<2;++d_) _Pragma("unroll") for(int r=0;r<16;++r)o[d_][r]*=wsf[crow(r,hi)]; } }while(0)
  f32x16 pA0,pA1,pB0,pB1;
  int sl_prev=0,sl_cur=0,sl_next=SLOTB;
  #define ROT() do{sl_prev=sl_cur;sl_cur=sl_next;sl_next=(sl_next==(NSLOT-1)*SLOTB)?0:sl_next+SLOTB;}while(0)
  DMA_K(2,2*SLOTB);
  WAIT_BAR(3);
  qkt(pA0,pA1,Kbase,qr,negm,r32,hi);asm volatile("s_nop 15\n\ts_nop 7":"+v"(pA0),"+v"(pA1));CMASK(pA0,pA1,0);
  START(pA0,pA1);
  _Pragma("unroll") for(int r=0;r<16;++r)pA1[r]=__builtin_amdgcn_exp2f(pA1[r]);
  WAIT_BAR(0);
  DMA_K(3,0);DMA_V(1,SLOTB);
  ROT();
  kload8(kf,kp0+sl_cur);
  WAIT_BAR(2);
  s16x4 vlo[8],vhi[8]; u32x4 pw0,pw1,pw2,pw3;
  #define PKW(P,B) cvtpk_s(P[B],P[B+1])
  #define PAF(k) __builtin_bit_cast(bf16x8,pw##k)
  #define VFR(i) (bf16x8){vlo[i][0],vlo[i][1],vlo[i][2],vlo[i][3],vhi[i][0],vhi[i][1],vhi[i][2],vhi[i][3]}
  #define PIN(x) asm volatile("":"+v"(x))
  #define MX3(a,b,c) __builtin_fmaxf(__builtin_fmaxf((a),(b)),(c))
  #define GAPA(MF,A0,A1,A2,A3,W0,W1,PW) do{ MF; sacc+=A0; sacc+=A1; sacc+=A2; sacc+=A3; PIN(sacc); W0; W1; PIN(PW); SBAR(); }while(0)
  #define EX(v) __builtin_amdgcn_exp2f(v)
  #define GAPB(MF,X,B) do{ MF; X[B]=EX(X[B]); X[B+1]=EX(X[B+1]); X[B+2]=EX(X[B+2]); X[B+3]=EX(X[B+3]); PIN(X); SBAR(); }while(0)
  #define VRD(i) do{ vlo[i]=vtr(vp_+(((i)>>2)*4096+((i)&3)*1024)); vhi[i]=vtr(vp_+(((i)>>2)*4096+((i)&3)*1024+512)); }while(0)
  #define KRD(G,j) do{ if(G){ kload2(kf,kp0+sl_next,j); SBAR(); } }while(0)
  #define STEP(C0,C1,P0,P1,t,GK,GV,GL) do{ SBAR(); \
    const lds_cptr vp_=vp0+sl_prev; \
    VRD(0); SBAR(); float sacc=(P0[0]+P0[1]); \
    GAPA(C0=__builtin_amdgcn_mfma_f32_32x32x16_bf16(kf[0],qr[0],negm,0,0,0), P0[2],P0[3],P0[4],P0[5],     pw0[0]=PKW(P0,0), pw0[1]=PKW(P0,2), pw0); \
    VRD(4); SBAR(); GAPA(C1=__builtin_amdgcn_mfma_f32_32x32x16_bf16(kf[1],qr[0],negm,0,0,0), P0[6],P0[7],P0[8],P0[9],     pw0[2]=PKW(P0,4), pw0[3]=PKW(P0,6), pw0); \
    VRD(1); SBAR(); GAPA(C0=__builtin_amdgcn_mfma_f32_32x32x16_bf16(kf[2],qr[1],C0,0,0,0),   P0[10],P0[11],P0[12],P0[13], pw1[0]=PKW(P0,8), pw1[1]=PKW(P0,10), pw1); \
    VRD(5); SBAR(); GAPA(C1=__builtin_amdgcn_mfma_f32_32x32x16_bf16(kf[3],qr[1],C1,0,0,0),   P0[14],P0[15],P1[0],P1[1],   pw1[2]=PKW(P0,12),pw1[3]=PKW(P0,14), pw1); \
    VRD(2); SBAR(); GAPA(C0=__builtin_amdgcn_mfma_f32_32x32x16_bf16(kf[4],qr[2],C0,0,0,0),   P1[2],P1[3],P1[4],P1[5],     pw2[0]=PKW(P1,0), pw2[1]=PKW(P1,2), pw2); \
    VRD(6); SBAR(); GAPA(C1=__builtin_amdgcn_mfma_f32_32x32x16_bf16(kf[5],qr[2],C1,0,0,0),   P1[6],P1[7],P1[8],P1[9],     pw2[2]=PKW(P1,4), pw2[3]=PKW(P1,6), pw2); \
    VRD(3); SBAR(); GAPA(C0=__builtin_amdgcn_mfma_f32_32x32x16_bf16(kf[6],qr[3],C0,0,0,0),   P1[10],P1[11],P1[12],P1[13], pw3[0]=PKW(P1,8), pw3[1]=PKW(P1,10), pw3); \
    VRD(7); SBAR(); GAPA(C1=__builtin_amdgcn_mfma_f32_32x32x16_bf16(kf[7],qr[3],C1,0,0,0),   P1[14],P1[15],0.f,0.f,       pw3[2]=PKW(P1,12),pw3[3]=PKW(P1,14), pw3); \
    l_reg+=sacc; \
    if(GK){DMA_K((t)+3,sl_cur);} if(GV){DMA_V((t)+1,sl_next);} \
    CMASK(C0,C1,t); \
    { float a=MX3(C0[0],C0[1],C1[0]),b=MX3(C0[2],C0[3],C1[1]); a=MX3(a,C1[2],C1[3]); \
      _Pragma("unroll") for(int r=4;r<16;r+=4){a=MX3(a,C0[r],C0[r+1]);b=MX3(b,C0[r+2],C0[r+3]);a=MX3(a,C1[r],C1[r+1]);b=MX3(b,C1[r+2],C1[r+3]);} \
      float rm=__builtin_fmaxf(a,b); { auto rr=__builtin_amdgcn_permlane32_swap(__float_as_uint(rm),__float_as_uint(rm),false,false); rm=__builtin_fmaxf(__uint_as_float(rr[0]),__uint_as_float(rr[1])); } \
      resc=false; \
      if(__builtin_expect(__any(rm>(float)THRL),0)){ const float dl=__builtin_fmaxf(rm,0.f); mhat+=dl; \
        _Pragma("unroll") for(int r=0;r<16;++r){C0[r]-=dl;C1[r]-=dl;} \
        _Pragma("unroll") for(int r=0;r<16;++r)negm[r]=-mhat; asm volatile("":"+v"(negm)); \
        const float f=__builtin_amdgcn_exp2f(-dl); l_reg*=f; if(hi==0)wsf[r32]=f; resc=true; } } \
    SBAR(); \
    GAPB(o[0]=__builtin_amdgcn_mfma_f32_32x32x16_bf16(PAF(0),VFR(0),o[0],0,0,0), C0,0); \
    GAPB(o[1]=__builtin_amdgcn_mfma_f32_32x32x16_bf16(PAF(0),VFR(4),o[1],0,0,0), C0,4); \
    KRD(GL,0); GAPB(o[0]=__builtin_amdgcn_mfma_f32_32x32x16_bf16(PAF(1),VFR(1),o[0],0,0,0), C0,8); \
    KRD(GL,1); GAPB(o[1]=__builtin_amdgcn_mfma_f32_32x32x16_bf16(PAF(1),VFR(5),o[1],0,0,0), C0,12); \
    KRD(GL,2); GAPB(o[0]=__builtin_amdgcn_mfma_f32_32x32x16_bf16(PAF(2),VFR(2),o[0],0,0,0), C1,0); \
    KRD(GL,3); GAPB(o[1]=__builtin_amdgcn_mfma_f32_32x32x16_bf16(PAF(2),VFR(6),o[1],0,0,0), C1,4); \
    GAPB(o[0]=__builtin_amdgcn_mfma_f32_32x32x16_bf16(PAF(3),VFR(3),o[0],0,0,0), C1,8); \
    GAPB(o[1]=__builtin_amdgcn_mfma_f32_32x32x16_bf16(PAF(3),VFR(7),o[1],0,0,0), C1,12); \
    }while(0)
  int t=1;
  #undef CMASK
  #define CMASK(P0,P1,t) do{}while(0)
  for(;t+5<NT;t+=2){
    STEP(pB0,pB1,pA0,pA1,t,true,true,true);     WAIT_BAR(2); RESC(); ROT();
    STEP(pA0,pA1,pB0,pB1,t+1,true,true,true);   WAIT_BAR(2); RESC(); ROT();
  }
  #undef CMASK
  #define CMASK(P0,P1,t) do{}while(0)
  #define ENDW(tt) do{ if((tt)+3<NT){WAIT_BAR(2);} else if((tt)+2<NT){WAIT_BAR(1);} else {WAIT_BAR(0);} }while(0)
  for(;t+1<NT;t+=2){
    STEP(pB0,pB1,pA0,pA1,t,(t+3<NT),(t+1<NT),(t+1<NT));       ENDW(t);   RESC(); ROT();
    STEP(pA0,pA1,pB0,pB1,t+1,(t+4<NT),(t+2<NT),(t+2<NT));     ENDW(t+1); RESC(); ROT();
  }
  STEP(pB0,pB1,pA0,pA1,NT-1,false,false,false); RESC();
  { float sacc=pB0[0]+pB0[1]; _Pragma("unroll") for(int r=2;r<16;++r)sacc+=pB0[r]; _Pragma("unroll") for(int r=0;r<16;++r)sacc+=pB1[r]; l_reg+=sacc;
    pw0=(u32x4){PKW(pB0,0),PKW(pB0,2),PKW(pB0,4),PKW(pB0,6)};pw1=(u32x4){PKW(pB0,8),PKW(pB0,10),PKW(pB0,12),PKW(pB0,14)};pw2=(u32x4){PKW(pB1,0),PKW(pB1,2),PKW(pB1,4),PKW(pB1,6)};pw3=(u32x4){PKW(pB1,8),PKW(pB1,10),PKW(pB1,12),PKW(pB1,14)};
    SBAR(); pv(o,vb0+sl_cur,PAF(0),PAF(1),PAF(2),PAF(3)); }
  #undef PKW
  #undef PAF
  #undef VFR
  #undef PIN
  #undef MX3
  #undef GAPA
  #undef GAPB
  #undef EX
  #undef VRD
  #undef KRD
  #undef STEP
  #undef ENDW
  {auto rr=__builtin_amdgcn_permlane32_swap(__float_as_uint(l_reg),__float_as_uint(l_reg),false,false);l_reg=__uint_as_float(rr[0])+__uint_as_float(rr[1]);}
  if(hi==0)wsf[32+r32]=l_reg;asm volatile("s_waitcnt lgkmcnt(0)":::"memory");
  float rli[16];
  #pragma unroll
  for(int r=0;r<16;++r)rli[r]=__builtin_amdgcn_rcpf(wsf[32+crow(r,hi)]);
  bf16*Ow=O+(rowbase+q0+wid*QBLK)*QP+h*D;
  { bf16*stg=(bf16*)(shm+LDS_OST)+wid*2048;
    #pragma unroll
    for(int r=0;r<16;++r){const int orow=crow(r,hi);
      #pragma unroll
      for(int d0=0;d0<2;++d0)stg[orow*64+d0*32+r32]=__float2bfloat16(o[d0][r]*rli[r]);}
    asm volatile("s_waitcnt lgkmcnt(0)":::"memory");
    #pragma unroll
    for(int i=0;i<4;++i){const int row=i*8+(lane>>3),ch=lane&7; const u32x4 v=*(const u32x4*)(stg+row*64+ch*8); ATTN_STORE16(Ow+(long)row*QP+ch*8,v);} }
  asm volatile("s_waitcnt lgkmcnt(0)\n\ts_barrier":::"memory");
  #undef DMA_K
  #undef DMA_V
  #undef CMASK
  #undef START
  #undef RESC
  #undef ROT
}
constexpr int ATTN_LDS_BYTES=LDS_BYTES;
struct AttnTensors { const bf16* Q; const bf16* K; const bf16* V; bf16* O; };
template<int THRL=8> __device__ __forceinline__ void attn_phase(char*lds,const AttnTensors&T,int vcu,int G){
  for(int i=0;;++i){
    int u;
    if(G==256){ if(i>=6)break; u=(i<4)?(4*vcu+i):(1024+2*vcu+(i-4)); }
    else{ u=vcu+i*G; if(u>=1536)break; }
    long rowbase; int h,qb,NT;
    if(u<1024){ const int bh=u>>5; qb=u&31; rowbase=(long)(bh>>3)*8192; h=bh&7; NT=128; }
    else { const int v=u-1024; const int bh=v>>4; qb=v&15; rowbase=32768+(long)(bh>>3)*4096; h=bh&7; NT=64; }
    attn_unit<THRL>(rowbase,h,qb,NT,T.Q,T.K,T.V,T.O,lds);
  }
}
#undef SBAR
#undef WAIT_BAR
}
#ifndef PH_MASK
#define PH_MASK 0x3ff
#endif
#define PH(k) if constexpr ((PH_MASK >> (k)) & 1)
constexpr int NWAVES = 8;
constexpr int RING_BYTES = 131072, LDS_BYTES = 147456;

#define LAS __attribute__((address_space(3)))
typedef unsigned short bf16;
typedef unsigned v4u __attribute__((ext_vector_type(4)));
typedef float f32x4 __attribute__((ext_vector_type(4)));
#define LDS_WAIT() asm volatile("s_waitcnt lgkmcnt(0)" ::: "memory")
__device__ __forceinline__ unsigned f2bf(float f) { unsigned u = __builtin_bit_cast(unsigned, f); return (u + 0x7fffu + ((u >> 16) & 1u)) >> 16; }
__device__ __forceinline__ unsigned pk2(float lo, float hi) { return f2bf(lo) | (f2bf(hi) << 16); }
__device__ __forceinline__ float wave_sum(float v) {
#pragma unroll
    for (int o = 1; o < 64; o <<= 1) v += __shfl_xor(v, o);
    return v;
}
__device__ __forceinline__ void transpose_item(const float* W, int ldw, int src_col0, int k0, bf16* WT, int K, int dst_row0, LAS float* scr, int lane, const float* gk = nullptr) {
    float tv[32];
    const float* wp = W + (size_t)(k0 + (lane >> 5)) * ldw + src_col0 + (lane & 31);
#pragma unroll
    for (int i = 0; i < 32; ++i) tv[i] = wp[(size_t)(2 * i) * ldw];
#pragma unroll
    for (int i = 0; i < 32; ++i) { const int kk = 2 * i + (lane >> 5); scr[kk * 33 + (lane & 31)] = gk ? tv[i] * gk[k0 + kk] : tv[i]; }
    LDS_WAIT(); asm volatile("" ::: "memory");
    const int c = lane & 7;
#pragma unroll
    for (int j = 0; j < 4; ++j) { const int n = (lane >> 3) + 8 * j; const LAS float* s = scr + (8 * c) * 33 + n;
        v4u o; o.x = pk2(s[0 * 33], s[1 * 33]); o.y = pk2(s[2 * 33], s[3 * 33]); o.z = pk2(s[4 * 33], s[5 * 33]); o.w = pk2(s[6 * 33], s[7 * 33]);
        *(v4u*)(WT + (size_t)(dst_row0 + n) * K + k0 + 8 * c) = o; }
    LDS_WAIT(); asm volatile("" ::: "memory");
}

typedef __attribute__((address_space(1))) unsigned gu32;
#define RLX_AGENT __ATOMIC_RELAXED, __HIP_MEMORY_SCOPE_AGENT
#define LDS_WAIT() asm volatile("s_waitcnt lgkmcnt(0)" ::: "memory")
#define VM_WAIT() asm volatile("s_waitcnt vmcnt(0)" ::: "memory")
#define XB_TMO      128
#define XB_XCNT(j)  (256  + 64 * (j))
#define XB_XSUB(j)  (1280 + 64 * (j))
#define XB_XGEN(j)  (2304 + 64 * (j))
#define XB_TOP      3328
#define XB_TOPGEN   3392
#define XCD_BAR_WORDS 3456
#define XB_SPIN_CAP (1u << 18)

__device__ __forceinline__ unsigned xb_ld(unsigned* p)              { return __hip_atomic_load(p, __ATOMIC_RELAXED, __HIP_MEMORY_SCOPE_AGENT); }
__device__ __forceinline__ unsigned xb_add(unsigned* p, unsigned v) { return __hip_atomic_fetch_add(p, v, __ATOMIC_RELAXED, __HIP_MEMORY_SCOPE_AGENT); }
__device__ __forceinline__ unsigned xb_xcc_id() { return (unsigned)__builtin_amdgcn_s_getreg((3 << 11) | 20) & 0xFu; }
#define XB_SPIN(cond, bar) do { unsigned _sp = 0; while (cond) { __builtin_amdgcn_s_sleep(1); \
    if ((++_sp & 255u) == 0u) { if (xb_ld(&(bar)[XB_TMO])) break; if (_sp > XB_SPIN_CAP) { atomicAdd(&(bar)[XB_TMO], 1u); break; } } } } while (0)

struct XcdBarrier {
    unsigned* bar; unsigned x;
    volatile LAS unsigned* st;
};

__device__ __forceinline__ XcdBarrier xcd_barrier_post(unsigned* bar, volatile LAS unsigned* st) {
    XcdBarrier b; b.bar = bar; b.x = xb_xcc_id(); b.st = st;
    if (threadIdx.x == 0) (void)xb_add(&bar[XB_XCNT(b.x)], 1u);
    return b;
}
__device__ __forceinline__ void xcd_barrier_complete(unsigned* bar, unsigned x, unsigned& nloc, unsigned& nx) {
    const unsigned G = gridDim.x * gridDim.y * gridDim.z;
    unsigned sum, cnt, mine, sp = 0u;
    for (;;) {
        sum = 0u; cnt = 0u; mine = 0u;
#pragma unroll
        for (unsigned j = 0; j < 16; ++j) { const unsigned c = xb_ld(&bar[XB_XCNT(j)]); sum += c; cnt += (c > 0u) ? 1u : 0u; mine = (j == x) ? c : mine; }
        if (sum == G) break;
        __builtin_amdgcn_s_sleep(1);
        if ((++sp & 255u) == 0u) { if (xb_ld(&bar[XB_TMO])) break; if (sp > XB_SPIN_CAP) { atomicAdd(&bar[XB_TMO], 1u); break; } }
    }
    nloc = mine > 0u ? mine : 1u; nx = cnt > 0u ? cnt : 1u;
}

__device__ __forceinline__ void xcd_barrier(const XcdBarrier& b) {
    asm volatile("s_waitcnt vmcnt(0)" ::: "memory");
    __syncthreads();
    if (threadIdx.x == 0) {
        unsigned* bar = b.bar;
        __builtin_amdgcn_s_waitcnt(0);
        unsigned nloc = b.st[0], nx = b.st[1];
        if (nloc == 0u) { xcd_barrier_complete(bar, b.x, nloc, nx); b.st[0] = nloc; b.st[1] = nx; }
        const unsigned old = xb_add(&bar[XB_XSUB(b.x)], 1u);
        const unsigned gen = old / nloc;
        if (old + 1u == (gen + 1u) * nloc) {
            __builtin_amdgcn_fence(__ATOMIC_RELEASE, "agent");
            asm volatile("s_waitcnt vmcnt(0)" ::: "memory");
            const unsigned og = xb_add(&bar[XB_TOP], 1u);
            const unsigned tg = og / nx;
            if (og + 1u == (tg + 1u) * nx) xb_add(&bar[XB_TOPGEN], 1u);
            else XB_SPIN(xb_ld(&bar[XB_TOPGEN]) == tg, bar);
            __builtin_amdgcn_fence(__ATOMIC_ACQUIRE, "agent");
            xb_add(&bar[XB_XGEN(b.x)], 1u);
            asm volatile("s_waitcnt vmcnt(0)" ::: "memory");
        } else {
            XB_SPIN(xb_ld(&bar[XB_XGEN(b.x)]) == gen, bar);
            __builtin_amdgcn_fence(__ATOMIC_ACQUIRE, "agent");
            asm volatile("s_waitcnt vmcnt(0)" ::: "memory");
        }
    }
    __syncthreads();
}

template <int W> __device__ __forceinline__ void pool_item(const bf16* Zb, bf16* PL, int row, int ch) {
    constexpr int left = W / 2;
    const int T = row < MP ? 8192 : 4096, t = row < MP ? (row & 8191) : ((row - MP) & 4095);
    const bf16* zp = Zb + (size_t)(row - t) * 512 + ch * 8;
    v4u q[W];
#pragma unroll
    for (int k = 0; k < W; ++k) { int tt = t - left + k; tt = tt < 0 ? 0 : (tt > T - 1 ? T - 1 : tt); q[k] = *(const v4u*)(zp + (size_t)tt * 512); }
    float a[8];
#pragma unroll
    for (int e = 0; e < 8; ++e) a[e] = 0.f;
#pragma unroll
    for (int k = 0; k < W; ++k) { const int tt = t - left + k; const float wv = (tt >= 0 && tt < T) ? 1.f : 0.f;
        a[0] += wv * pg8::bf_lo(q[k].x); a[1] += wv * pg8::bf_hi(q[k].x); a[2] += wv * pg8::bf_lo(q[k].y); a[3] += wv * pg8::bf_hi(q[k].y);
        a[4] += wv * pg8::bf_lo(q[k].z); a[5] += wv * pg8::bf_hi(q[k].z); a[6] += wv * pg8::bf_lo(q[k].w); a[7] += wv * pg8::bf_hi(q[k].w); }
    const int lo = (t - left) > 0 ? (t - left) : 0, hi = (t + W - 1 - left) < (T - 1) ? (t + W - 1 - left) : (T - 1);
    const float ic = 1.0f / (float)(hi - lo + 1); const v4u s = q[left];
    v4u o; o.x = pk2(a[0] * ic - pg8::bf_lo(s.x), a[1] * ic - pg8::bf_hi(s.x)); o.y = pk2(a[2] * ic - pg8::bf_lo(s.y), a[3] * ic - pg8::bf_hi(s.y));
    o.z = pk2(a[4] * ic - pg8::bf_lo(s.z), a[5] * ic - pg8::bf_hi(s.z)); o.w = pk2(a[6] * ic - pg8::bf_lo(s.w), a[7] * ic - pg8::bf_hi(s.w));
    *(v4u*)(PL + (size_t)row * 512 + ch * 8) = o;
}
struct Args { const float* in[25]; float* out; unsigned char* ws; };
static_assert(sizeof(Args) == 27 * 8, "Args has no padding");

__device__ __forceinline__ void gateup_items(int r, const float* Wg, const float* Wu, bf16* WT, LAS float* scr, int lane, const float* gk) {
    const int kb = r / 176, G = r % 176, tile = G >> 3, w = G & 7;
    transpose_item((w < 4) ? Wg : Wu, DFF, tile * 128 + (w & 3) * 32, kb * 64, WT, 1024, G * 32, scr, lane, gk);
}

constexpr int CV_I1 = 16 * 176, CV_I2 = 44 * 32, CV_I3 = 16 * 104, CV_I4 = 8 * 32, CV_I6 = 16 * 32, CV_I10 = 4 * 32;
constexpr int CV_NITEMS = 2 * CV_I1 + 2 * CV_I2 + CV_I3 + CV_I4 + 2 * CV_I6 + CV_I10;
__device__ __forceinline__ void convert_items(const Args& args, unsigned char* ws, LAS float* scr, int lane, int it_begin, int it_end, int skip_begin, int skip_len, int w, int nw) {
    bf16* W1 = (bf16*)(ws + WS_W1); bf16* WD1 = (bf16*)(ws + WS_WD1); bf16* WIN = (bf16*)(ws + WS_WIN); bf16* WUA = (bf16*)(ws + WS_WUA);
    bf16* WOUT = (bf16*)(ws + WS_WOUT); bf16* W2 = (bf16*)(ws + WS_W2); bf16* WD2 = (bf16*)(ws + WS_WD2); bf16* WPG = (bf16*)(ws + WS_WPG); bf16* WPP = (bf16*)(ws + WS_WPP);
    for (int it = it_begin + w; it < it_end; it += nw) {
        int r = it >= skip_begin ? it + skip_len : it;
        if (r < CV_I1) { gateup_items(r, args.in[5], args.in[6], W1, scr, lane, nullptr); continue; } r -= CV_I1;
        if (r < CV_I1) { gateup_items(r, args.in[18], args.in[19], W2, scr, lane, args.in[17]); continue; } r -= CV_I1;
        if (r < CV_I2) { transpose_item(args.in[7], 1024, (r % 32) * 32, (r / 32) * 64, WD1, DFF, (r % 32) * 32, scr, lane); continue; } r -= CV_I2;
        if (r < CV_I2) { transpose_item(args.in[20], 1024, (r % 32) * 32, (r / 32) * 64, WD2, DFF, (r % 32) * 32, scr, lane); continue; } r -= CV_I2;
        if (r < CV_I3) { const int kb = r / 104, Gp = r % 104; const int c0 = Gp < 24 ? ((Gp >> 3) * 256 + (Gp & 3) * 64 + ((Gp >> 2) & 1) * 32) : Gp * 32;
            transpose_item(args.in[9], INW, c0, kb * 64, WIN, 1024, Gp * 32, scr, lane, args.in[8]); continue; } r -= CV_I3;
        if (r < CV_I4) { transpose_item(args.in[12], 1024, (r % 32) * 32, (r / 32) * 64, WUA, 512, (r % 32) * 32, scr, lane); continue; } r -= CV_I4;
        if (r < CV_I6) { transpose_item(args.in[16], 1024, (r % 32) * 32, (r / 32) * 64, WOUT, 1024, (r % 32) * 32, scr, lane); continue; } r -= CV_I6;
        if (r < CV_I6) { transpose_item(args.in[22], 1024, (r % 32) * 32, (r / 32) * 64, WPG, 1024, (r % 32) * 32, scr, lane, args.in[21]); continue; } r -= CV_I6;
        transpose_item(args.in[23], 1024, (r % 32) * 32, (r / 32) * 64, WPP, PLE, (r % 32) * 32, scr, lane);
    }
}

__global__ void __launch_bounds__(NWAVES * 64, 2) fwd_mega(Args args) {
    extern __shared__ __attribute__((aligned(16))) unsigned char lds[];
    cg::grid_group grid = cg::this_grid();
    const int tid = threadIdx.x, lane = tid & 63, wave = __builtin_amdgcn_readfirstlane(tid >> 6);
    const int G = gridDim.x, bx = blockIdx.x, vcu = (G % 8 == 0) ? (bx % 8) * (G / 8) + bx / 8 : bx;
    unsigned char* ws = args.ws;
    LAS unsigned char* ldsp = (LAS unsigned char*)lds;
    const float* x_p = args.in[0]; const float* x_s = args.in[1]; const float* p_p = args.in[2]; const float* p_s = args.in[3];
    float* out = args.out;
    float* SS = (float*)(ws + WS_SS); float* SSE = (float*)(ws + WS_SSE);
    bf16* W1 = (bf16*)(ws + WS_W1); bf16* WD1 = (bf16*)(ws + WS_WD1); bf16* WIN = (bf16*)(ws + WS_WIN); bf16* WUA = (bf16*)(ws + WS_WUA); bf16* WPC = (bf16*)(ws + WS_WPC);
    bf16* WOUT = (bf16*)(ws + WS_WOUT); bf16* W2 = (bf16*)(ws + WS_W2); bf16* WD2 = (bf16*)(ws + WS_WD2); bf16* WPG = (bf16*)(ws + WS_WPG); bf16* WPP = (bf16*)(ws + WS_WPP);
    bf16* HB = (bf16*)(ws + WS_HB); bf16* ACT = (bf16*)(ws + WS_ACT); bf16* QO = (bf16*)(ws + WS_QO); bf16* Zb = (bf16*)(ws + WS_Z); bf16* PL = (bf16*)(ws + WS_PL);
    bf16* MX = (bf16*)(ws + WS_MX); bf16* KB = (bf16*)(ws + WS_K); bf16* VB = (bf16*)(ws + WS_V); bf16* PB = (bf16*)(ws + WS_PB); bf16* SGB = (bf16*)(ws + WS_SGB); bf16* EB = (bf16*)(ws + WS_E);
    volatile LAS unsigned* bst = (volatile LAS unsigned*)(ldsp + 139264);
    if (tid < 2) bst[tid] = 0u;
    __syncthreads();
    const XcdBarrier xbar = xcd_barrier_post((unsigned*)ws, bst);
    const int gw = vcu * NWAVES + wave, NGW = G * NWAVES;
    const int gt = bx * (NWAVES * 64) + tid, NGT = G * NWAVES * 64;

    PH(0) {
        LAS float* scr = (LAS float*)(ldsp + wave * 16384);
        const bool defer = (G == 256);
        if (defer) convert_items(args, ws, scr, lane, 0, CV_NITEMS - CV_I1, CV_I1, CV_I1, gw, NGW); else convert_items(args, ws, scr, lane, 0, CV_NITEMS, CV_NITEMS, 0, gw, NGW);
        if (gt < 128) ((float*)(ws + WS_GQK))[gt] = gt < 64 ? args.in[10][gt] : args.in[11][gt - 64];
        { const float* pw = args.in[13]; const float* psc = args.in[14]; const float* wup = args.in[15];
          for (int idx = gt; idx < 128 * 1024; idx += NGT) { const int d = idx & 1023, c0 = (idx >> 10) * 4, g0 = c0 & ~127; float a0 = 0.f, a1 = 0.f, a2 = 0.f, a3 = 0.f;
              const float* pr = pw + (size_t)c0 * 128; const float* bp = wup + (size_t)g0 * 1024 + d;
#pragma unroll 16
              for (int j = 0; j < 128; ++j) { const float b = bp[(size_t)j * 1024] * psc[g0 + j]; a0 += pr[j] * b; a1 += pr[128 + j] * b; a2 += pr[256 + j] * b; a3 += pr[384 + j] * b; }
              *(unsigned long long*)(WPC + (size_t)d * 512 + c0) = (unsigned long long)pk2(a0, a1) | ((unsigned long long)pk2(a2, a3) << 32); } }
        { const float* g1 = args.in[4]; f32x4 gv[4];
#pragma unroll
          for (int j = 0; j < 4; ++j) gv[j] = ((const f32x4*)g1)[lane + 64 * j];
          for (int m0 = gw * 4; m0 < MTOT; m0 += NGW * 4) { const float* xr = m0 < MP ? x_p + (size_t)m0 * 1024 : x_s + (size_t)(m0 - MP) * 1024;
              f32x4 v[4][4]; float s[4];
#pragma unroll
              for (int r = 0; r < 4; ++r)
#pragma unroll
                  for (int j = 0; j < 4; ++j) v[r][j] = ((const f32x4*)(xr + r * 1024))[lane + 64 * j];
#pragma unroll
              for (int r = 0; r < 4; ++r) { s[r] = 0.f;
#pragma unroll
                  for (int j = 0; j < 4; ++j) s[r] += (v[r][j].x * v[r][j].x + v[r][j].y * v[r][j].y) + (v[r][j].z * v[r][j].z + v[r][j].w * v[r][j].w); }
#pragma unroll
              for (int r = 0; r < 4; ++r) { const float rstd = rsqrtf(wave_sum(s[r]) * (1.f / 1024.f) + EPSN);
                  unsigned long long* o8 = (unsigned long long*)(HB + (size_t)(m0 + r) * 1024) + lane;
#pragma unroll
                  for (int j = 0; j < 4; ++j) { const f32x4 y = v[r][j] * rstd * gv[j]; o8[64 * j] = (unsigned long long)pk2(y.x, y.y) | ((unsigned long long)pk2(y.z, y.w) << 32); } } } }
    }
    grid.sync();

    PH(1) { pg8::Gemm g{HB, W1, MTOT, 2 * DFF, 1024, 0, 0}; pg8::StaticOrder S; S.init(MTOT, 2 * DFF, G, bx);
      pg8::EpiGateUp<false> E{ACT, DFF, nullptr};
      pg8::gemm_phase<pg8::EpiGateUp<false>, pg8::StaticOrder, true, true>(ldsp, g, S, E); }
    if (G == 256 && bx >= 128) {
        asm volatile("s_waitcnt vmcnt(0)" ::: "memory"); __syncthreads();
        LAS float* scr = (LAS float*)(ldsp + wave * 16384);
        convert_items(args, ws, scr, lane, CV_I1, 2 * CV_I1, CV_NITEMS, 0, (bx - 128) * NWAVES + wave, 128 * NWAVES);
    }
    xcd_barrier(xbar);
    PH(2) { pg8::Gemm g{ACT, WD1, MTOT, 1024, DFF, 0, 0}; pg8::StaticOrder S; S.init(MTOT, 1024, G, bx, 1);
      pg8::EpiResid<true> E{x_p, x_s, HB, SS, 0.5f};
      pg8::gemm_phase<pg8::EpiResid<true>, pg8::StaticOrder, true, true>(ldsp, g, S, E); }
    xcd_barrier(xbar);
    PH(3) { pg8::Gemm g{HB, WIN, MTOT, INW, 1024, 0, 0}; pg8::StaticOrder S; S.init(MTOT, INW, G, bx);
      pg8::EpiWin E{SS, (const float*)(ws + WS_GQK), ws, attn_body::C2};
      pg8::gemm_phase<pg8::EpiWin, pg8::StaticOrder, true, true>(ldsp, g, S, E); }
    xcd_barrier(xbar);
    PH(4) {
      for (int wi = gw; wi < MTOT; wi += NGW) { const int grp = wi & 3, row = (wi >> 2) * 4 + (lane >> 4), ch = grp * 16 + (lane & 15);
          if (grp == 0) pool_item<2>(Zb, PL, row, ch); else if (grp == 1) pool_item<4>(Zb, PL, row, ch); else if (grp == 2) pool_item<8>(Zb, PL, row, ch); else pool_item<16>(Zb, PL, row, ch); }
      asm volatile("s_waitcnt vmcnt(0)" ::: "memory"); __syncthreads();
      const attn_body::AttnTensors AT{(const attn_body::bf16*)QO, (const attn_body::bf16*)KB, (const attn_body::bf16*)VB, (attn_body::bf16*)QO};
      attn_body::attn_phase<8>((char*)lds, AT, vcu, G); }
    xcd_barrier(xbar);
    PH(5) { for (int idx = gt; idx < MTOT * 32; idx += NGT) { const int row = idx >> 5, ch = idx & 31; const float* pr = (row < MP ? p_p + (size_t)row * PLE : p_s + (size_t)(row - MP) * PLE) + ch * 8;
          const f32x4 a = *(const f32x4*)pr, b = *(const f32x4*)(pr + 4); v4u o; o.x = pk2(a.x, a.y); o.y = pk2(a.z, a.w); o.z = pk2(b.x, b.y); o.w = pk2(b.z, b.w);
          *(v4u*)(PB + (size_t)row * PLE + ch * 8) = o; }
      asm volatile("s_waitcnt vmcnt(0)" ::: "memory"); __syncthreads();
      pg8::SegOrder S; S.init(MTOT, 1024, G, bx);
      { pg8::Gemm g{QO, WUA, MTOT, 1024, 512, (long)((const char*)PL - (const char*)QO), (long)((const char*)WPC - (const char*)WUA)}; pg8::EpiGateMix E{MX, SGB}; pg8::gemm_phase<pg8::EpiGateMix, pg8::SegOrder, true, true>(ldsp, g, S, E); } }
    xcd_barrier(xbar);
    PH(6) { pg8::StaticOrder S; S.init(MTOT, 1024, G, bx);
      { pg8::Gemm g{MX, WOUT, MTOT, 1024, 1024, 0, 0}; pg8::EpiResid<false> E{nullptr, nullptr, HB, SS, 1.0f}; pg8::gemm_phase<pg8::EpiResid<false>, pg8::StaticOrder, true, true>(ldsp, g, S, E); }
 }
    asm volatile("s_waitcnt vmcnt(0)" ::: "memory"); __syncthreads();
    PH(6) { pg8::Gemm g{PB, WPP, MTOT, 1024, PLE, 0, 0}; pg8::StaticOrder S; S.init(MTOT, 1024, G, bx); pg8::EpiE E{EB, SSE};
      pg8::gemm_phase<pg8::EpiE, pg8::StaticOrder, true, true>(ldsp, g, S, E); }
    xcd_barrier(xbar);
    PH(7) { pg8::Gemm g{HB, W2, MTOT, 2 * DFF, 1024, 0, 0}; pg8::StaticOrder S; S.init(MTOT, 2 * DFF, G, bx);
      pg8::EpiGateUp<true> E{ACT, DFF, SS};
      pg8::gemm_phase<pg8::EpiGateUp<true>, pg8::StaticOrder, true, true>(ldsp, g, S, E); }
    xcd_barrier(xbar);
    PH(8) { pg8::Gemm g{ACT, WD2, MTOT, 1024, DFF, 0, 0}; pg8::StaticOrder S; S.init(MTOT, 1024, G, bx, 1);
      pg8::EpiResid<false> E{nullptr, nullptr, HB, SS, 0.5f};
      pg8::gemm_phase<pg8::EpiResid<false>, pg8::StaticOrder, true, true>(ldsp, g, S, E); }
    xcd_barrier(xbar);
    PH(9) { pg8::Gemm g{HB, WPG, MTOT, 1024, 1024, 0, 0}; pg8::StaticOrder S; S.init(MTOT, 1024, G, bx);
      pg8::EpiFinal E{out, HB, EB, SS, SSE, args.in[24]};
      pg8::gemm_phase<pg8::EpiFinal, pg8::StaticOrder, true, true>(ldsp, g, S, E); }
}

extern "C" void kernel_launch(void* const* d_in, const int* in_sizes, int n_in, void* d_out, int out_size, void* d_ws, size_t ws_size, hipStream_t stream) {
    static int grid = 0;
    if (grid == 0) {
        if (n_in != 25 || out_size != MTOT * 1024 || ws_size < WS_END) { fprintf(stderr, "kernel_launch: unexpected problem (n_in %d, out %d, ws %zu); nothing launched\n", n_in, out_size, ws_size); grid = -1; return; }
        int dev = 0, cus = 0, per_cu = 0;
        if (hipGetDevice(&dev) != hipSuccess || hipDeviceGetAttribute(&cus, hipDeviceAttributeMultiprocessorCount, dev) != hipSuccess) { grid = -1; return; }
        if (hipFuncSetAttribute((const void*)fwd_mega, hipFuncAttributeMaxDynamicSharedMemorySize, LDS_BYTES) != hipSuccess) { fprintf(stderr, "kernel_launch: hipFuncSetAttribute failed\n"); grid = -1; return; }
        if (hipOccupancyMaxActiveBlocksPerMultiprocessor(&per_cu, (const void*)fwd_mega, NWAVES * 64, LDS_BYTES) != hipSuccess || per_cu < 1) { fprintf(stderr, "kernel_launch: occupancy query says %d blocks per CU\n", per_cu); (void)hipGetLastError(); }
        grid = cus;
    }
    if (grid < 0) return;
    if (hipMemsetAsync(d_ws, 0, 16384, stream) != hipSuccess) { fprintf(stderr, "kernel_launch: memset failed\n"); return; }
    Args a{};
    for (int i = 0; i < 25; ++i) a.in[i] = (const float*)d_in[i];
    a.out = (float*)d_out; a.ws = (unsigned char*)d_ws;
    void* kargs[] = {&a};
    const hipError_t e = hipLaunchCooperativeKernel((const void*)fwd_mega, dim3(grid), dim3(NWAVES * 64), kargs, LDS_BYTES, stream);
    if (e != hipSuccess) fprintf(stderr, "kernel_launch: cooperative launch failed: %s (grid %d)\n", hipGetErrorString(e), grid);
}
```
